# Optimizing an MI355X kernel written in HIP

```python
import math
import jax, jax.numpy as jnp
from jax import lax
import numpy as np

D_MODEL = 1024
BATCH = 16
SEQ = 2048
DEPTH = 2
DEC_BATCH = 2
DEC_SEQ = 8192
PAST_LEN = 128

GRID_W = 64
HEAD_DIM = 64
ATT_HEADS = 8
ATT_KV_HEADS = 2
ATT_GROUPS = ATT_HEADS // ATT_KV_HEADS
Q_BLOCK = 128
ROPE_THETA = 10000.0
GLA_HEADS = 4
GLA_DK = 64
GLA_DV = 128
GLA_GATE_RANK = 16
GLA_GATE_TAU = 16.0
GLA_CHUNK = 64
RET_HEADS = 4
RET_DK = 64
RET_DV = 128
RET_CHUNK = 128
BRANCH_W = 512
N_BRANCH = 3
D_FF = 4 * D_MODEL
EPS = 1e-6

IN_SPLITS = (ATT_HEADS * HEAD_DIM, ATT_KV_HEADS * HEAD_DIM, ATT_KV_HEADS * HEAD_DIM,
             GLA_HEADS * GLA_DK, GLA_HEADS * GLA_DK, GLA_HEADS * GLA_DV, 2 * GLA_GATE_RANK, GLA_HEADS * GLA_DV,
             RET_HEADS * RET_DK, RET_HEADS * RET_DK, RET_HEADS * RET_DV, RET_HEADS * RET_DV)
IN_WIDTH = sum(IN_SPLITS)

kernel_name = "hybrid_gqa_gla_retention_encoder"


def rms_norm(x, g):
    xf = x.astype(jnp.float32)
    y = xf * lax.rsqrt(jnp.mean(xf * xf, axis=-1, keepdims=True) + EPS)
    return (y * g.astype(jnp.float32)).astype(x.dtype)


def head_group_norm(x):
    xf = x.astype(jnp.float32)
    mu = jnp.mean(xf, axis=-1, keepdims=True)
    xc = xf - mu
    return xc * lax.rsqrt(jnp.mean(xc * xc, axis=-1, keepdims=True) + EPS)


def split_columns(p):
    out, start = [], 0
    for w in IN_SPLITS:
        out.append(p[..., start:start + w])
        start += w
    return out


def axial_rope_tables(seq_len):
    rows = seq_len // GRID_W
    row_ids = jnp.repeat(jnp.arange(rows), GRID_W).astype(jnp.float32)
    col_ids = jnp.tile(jnp.arange(GRID_W), rows).astype(jnp.float32)
    axis_dim = HEAD_DIM // 2
    inv = ROPE_THETA ** (-jnp.arange(0, axis_dim, 2, dtype=jnp.float32) / axis_dim)
    ang_r = row_ids[:, None] * inv[None, :]
    ang_c = col_ids[:, None] * inv[None, :]
    ang_r = jnp.concatenate([ang_r, ang_r], axis=-1)
    ang_c = jnp.concatenate([ang_c, ang_c], axis=-1)
    return (jnp.cos(ang_r), jnp.sin(ang_r), jnp.cos(ang_c), jnp.sin(ang_c))


def _rotate(x, cos, sin):
    x1, x2 = jnp.split(x, 2, axis=-1)
    rot = jnp.concatenate([-x2, x1], axis=-1)
    return x * cos[:, None, :] + rot * sin[:, None, :]


def apply_axial_rope(x, rope):
    cos_r, sin_r, cos_c, sin_c = rope
    xr, xc = jnp.split(x, 2, axis=-1)
    return jnp.concatenate([_rotate(xr, cos_r, sin_r), _rotate(xc, cos_c, sin_c)], axis=-1).astype(x.dtype)


def gqa_attention(q, k, v):
    B, S = q.shape[0], q.shape[1]
    nb = S // Q_BLOCK
    qb = q.reshape(B, nb, Q_BLOCK, ATT_KV_HEADS, ATT_GROUPS, HEAD_DIM).transpose(1, 0, 2, 3, 4, 5)
    scale = HEAD_DIM ** -0.5

    def block(qi):
        s = jnp.einsum('bqhgd,bkhd->bhgqk', qi, k, preferred_element_type=jnp.float32) * scale
        p = jax.nn.softmax(s, axis=-1)
        return jnp.einsum('bhgqk,bkhd->bqhgd', p.astype(v.dtype), v)

    o = lax.map(block, qb)
    return o.transpose(1, 0, 2, 3, 4, 5).reshape(B, S, ATT_HEADS * HEAD_DIM)


def gla_scan(q, k, v, log_a):
    B, H, S, dk = q.shape
    dv = v.shape[-1]
    C = GLA_CHUNK
    n = S // C
    chunk = lambda t: t.reshape(B, H, n, C, t.shape[-1]).transpose(2, 0, 1, 3, 4)
    causal = jnp.tril(jnp.ones((C, C), dtype=bool))
    mid = C // 2 - 1

    def step(state, inp):
        qi, ki, vi, ai = inp
        qf, kf, vf = qi.astype(jnp.float32), ki.astype(jnp.float32), vi.astype(jnp.float32)
        b = jnp.cumsum(ai, axis=-2)
        b_ref = b[..., mid:mid + 1, :]
        q_in = qf * jnp.exp(b - b_ref)
        k_in = kf * jnp.exp(b_ref - b)
        s = jnp.where(causal, jnp.einsum('bhid,bhjd->bhij', q_in, k_in), 0.0)
        intra = jnp.einsum('bhij,bhjv->bhiv', s, vf)
        inter = jnp.einsum('bhid,bhdv->bhiv', qf * jnp.exp(b), state)
        b_last = b[..., -1:, :]
        new = state * jnp.exp(b_last[..., 0, :])[..., :, None] + jnp.einsum(
            'bhjd,bhjv->bhdv', kf * jnp.exp(b_last - b), vf)
        return new, intra + inter

    state0 = jnp.zeros((B, H, dk, dv), jnp.float32)
    _, o = lax.scan(step, state0, (chunk(q), chunk(k), chunk(v), chunk(log_a)))
    return o.transpose(1, 2, 0, 3, 4).reshape(B, H, S, dv)


def retention_scan(q, k, v, log_gamma):
    B, H, S, dk = q.shape
    dv = v.shape[-1]
    C = RET_CHUNK
    n = S // C
    chunk = lambda t: t.reshape(B, H, n, C, t.shape[-1]).transpose(2, 0, 1, 3, 4)
    idx = jnp.arange(C, dtype=jnp.float32)
    diff = idx[:, None] - idx[None, :]
    lg = log_gamma[:, None, None]
    decay_mask = jnp.where(diff >= 0, jnp.exp(lg * jnp.maximum(diff, 0.0)), 0.0)
    q_decay = jnp.exp(log_gamma[:, None] * (idx + 1.0))[:, :, None]
    k_decay = jnp.exp(log_gamma[:, None] * (C - 1.0 - idx))[:, :, None]
    chunk_decay = jnp.exp(log_gamma * C)[:, None, None]

    def step(state, inp):
        qi, ki, vi = inp
        qf, kf, vf = qi.astype(jnp.float32), ki.astype(jnp.float32), vi.astype(jnp.float32)
        s = jnp.einsum('bhid,bhjd->bhij', qf, kf) * decay_mask
        intra = jnp.einsum('bhij,bhjv->bhiv', s, vf)
        inter = jnp.einsum('bhid,bhdv->bhiv', qf, state) * q_decay
        new = state * chunk_decay + jnp.einsum('bhjd,bhjv->bhdv', kf * k_decay, vf)
        return new, intra + inter

    state0 = jnp.zeros((B, H, dk, dv), jnp.float32)
    _, o = lax.scan(step, state0, (chunk(q), chunk(k), chunk(v)))
    return o.transpose(1, 2, 0, 3, 4).reshape(B, H, S, dv)


def _flip(t):
    return jnp.flip(t, axis=2)


def mixer(xn, w_in, q_gain, k_gain, gla_w_gate, gla_b_gate, gla_gain, w_branch, w_merge, w_out, rope):
    B, S, D = xn.shape
    f32 = jnp.float32
    aq, ak, av, gq, gk, gv, ga, gg, rq, rk, rv, rg = split_columns(xn @ w_in)
    to_heads = lambda t, h: t.reshape(B, S, h, -1).transpose(0, 2, 1, 3)

    q = apply_axial_rope(rms_norm(aq.reshape(B, S, ATT_HEADS, HEAD_DIM), q_gain), rope)
    k = apply_axial_rope(rms_norm(ak.reshape(B, S, ATT_KV_HEADS, HEAD_DIM), k_gain), rope)
    v = av.reshape(B, S, ATT_KV_HEADS, HEAD_DIM)
    o_att = gqa_attention(q, k, v)

    gq_h = to_heads(gq, GLA_HEADS) * (GLA_DK ** -0.5)
    gk_h = to_heads(gk, GLA_HEADS)
    gv_h = to_heads(gv, GLA_HEADS)
    z = ga.astype(f32)
    la_f = jax.nn.log_sigmoid(z[..., :GLA_GATE_RANK] @ gla_w_gate[0].astype(f32)
                              + gla_b_gate[0].astype(f32)) / GLA_GATE_TAU
    la_b = jax.nn.log_sigmoid(z[..., GLA_GATE_RANK:] @ gla_w_gate[1].astype(f32)
                              + gla_b_gate[1].astype(f32)) / GLA_GATE_TAU
    la_f, la_b = to_heads(la_f, GLA_HEADS), to_heads(la_b, GLA_HEADS)
    o_g = gla_scan(gq_h, gk_h, gv_h, la_f) + _flip(
        gla_scan(_flip(gq_h), _flip(gk_h), _flip(gv_h), _flip(la_b)))
    o_g = rms_norm(o_g, gla_gain).transpose(0, 2, 1, 3).reshape(B, S, GLA_HEADS * GLA_DV)
    o_gla = (o_g * jax.nn.silu(gg.astype(f32))).astype(xn.dtype)

    rq_h = to_heads(apply_axial_rope(rq.reshape(B, S, RET_HEADS, RET_DK), rope), RET_HEADS)
    rk_h = to_heads(apply_axial_rope(rk.reshape(B, S, RET_HEADS, RET_DK), rope), RET_HEADS) * (RET_DK ** -0.5)
    rv_h = to_heads(rv, RET_HEADS)
    lg_f = jnp.log(1.0 - 2.0 ** (-5.0 - jnp.arange(RET_HEADS, dtype=f32)))
    lg_b = lg_f[::-1]
    o_r = retention_scan(rq_h, rk_h, rv_h, lg_f) + _flip(
        retention_scan(_flip(rq_h), _flip(rk_h), _flip(rv_h), lg_b))
    o_r = head_group_norm(o_r).transpose(0, 2, 1, 3).reshape(B, S, RET_HEADS * RET_DV)
    o_ret = (o_r * jax.nn.silu(rg.astype(f32))).astype(xn.dtype)

    gates = jax.nn.sigmoid((xn @ w_merge).astype(f32)).reshape(B, S, N_BRANCH, D)
    branches = (o_att, o_gla, o_ret)
    merged = gates[:, :, 0] * (branches[0] @ w_branch[0]).astype(f32)
    for i in range(1, N_BRANCH):
        merged = merged + gates[:, :, i] * (branches[i] @ w_branch[i]).astype(f32)
    return merged.astype(xn.dtype) @ w_out


def squared_relu_mlp(x, w_up, w_down):
    h = jax.nn.relu(x @ w_up)
    return (h * h) @ w_down


def trunk(x, norm_mix, norm_mlp, w_in, attn_q_norm, attn_k_norm, gla_w_gate, gla_b_gate,
          gla_out_norm, w_branch, w_merge, w_out, w_up, w_down, norm_final):
    rope = axial_rope_tables(x.shape[1])
    for l in range(DEPTH):
        h = x + mixer(rms_norm(x, norm_mix[l]), w_in[l], attn_q_norm[l], attn_k_norm[l],
                      gla_w_gate[l], gla_b_gate[l], gla_out_norm[l], w_branch[l], w_merge[l], w_out[l], rope)
        x = h + squared_relu_mlp(rms_norm(h, norm_mlp[l]), w_up[l], w_down[l])
    return rms_norm(x, norm_final)


def setup_inputs(seed: int = 0) -> dict:
    key = jax.random.key(seed)
    ks = jax.random.split(key, 20)
    f32 = jnp.float32
    nrm = lambda k, shape, scale: jax.random.normal(k, shape, f32) * scale
    gain = lambda k, shape: 1.0 + 0.02 * jax.random.normal(k, shape, f32)
    return {
        "x_prompt": jax.random.normal(ks[0], (BATCH, SEQ, D_MODEL), f32),
        "x_sample": jax.random.normal(ks[1], (DEC_BATCH, DEC_SEQ, D_MODEL), f32),
        "norm_mix": gain(ks[2], (DEPTH, D_MODEL)),
        "norm_mlp": gain(ks[3], (DEPTH, D_MODEL)),
        "w_in": nrm(ks[4], (DEPTH, D_MODEL, IN_WIDTH), D_MODEL ** -0.5),
        "attn_q_norm": gain(ks[5], (DEPTH, HEAD_DIM)),
        "attn_k_norm": gain(ks[6], (DEPTH, HEAD_DIM)),
        "gla_w_gate": nrm(ks[7], (DEPTH, 2, GLA_GATE_RANK, GLA_HEADS * GLA_DK), GLA_GATE_RANK ** -0.5),
        "gla_b_gate": nrm(ks[8], (DEPTH, 2, GLA_HEADS * GLA_DK), 0.1),
        "gla_out_norm": gain(ks[9], (DEPTH, GLA_DV)),
        "w_branch": nrm(ks[10], (DEPTH, N_BRANCH, BRANCH_W, D_MODEL), BRANCH_W ** -0.5),
        "w_merge": nrm(ks[11], (DEPTH, D_MODEL, N_BRANCH * D_MODEL), D_MODEL ** -0.5),
        "w_out": nrm(ks[12], (DEPTH, D_MODEL, D_MODEL), D_MODEL ** -0.5),
        "w_up": nrm(ks[13], (DEPTH, D_MODEL, D_FF), D_MODEL ** -0.5),
        "w_down": nrm(ks[14], (DEPTH, D_FF, D_MODEL), D_FF ** -0.5),
        "norm_final": gain(ks[15], (D_MODEL,)),
    }


def reference(x_prompt, x_sample, norm_mix, norm_mlp, w_in, attn_q_norm, attn_k_norm, gla_w_gate,
              gla_b_gate, gla_out_norm, w_branch, w_merge, w_out, w_up, w_down, norm_final):
    y_prompt = trunk(x_prompt, norm_mix, norm_mlp, w_in, attn_q_norm, attn_k_norm, gla_w_gate, gla_b_gate,
                     gla_out_norm, w_branch, w_merge, w_out, w_up, w_down, norm_final)
    y_sample = trunk(x_sample, norm_mix, norm_mlp, w_in, attn_q_norm, attn_k_norm, gla_w_gate, gla_b_gate,
                     gla_out_norm, w_branch, w_merge, w_out, w_up, w_down, norm_final)
    return (y_prompt, y_sample)
```

```cpp
#include <hip/hip_runtime.h>
#include <hip/hip_cooperative_groups.h>
#include <cstdio>
#include <cstdint>
namespace cg = cooperative_groups;
namespace pg8 {
#define PG8_LAS __attribute__((address_space(3)))
typedef unsigned short bf16_t;
typedef short bf16x8 __attribute__((ext_vector_type(8)));
typedef float f32x4 __attribute__((ext_vector_type(4)));
typedef unsigned u32x4 __attribute__((ext_vector_type(4)));
constexpr int BM = 256, BK = 64, HALF = 128, HTB = HALF * BK * 2  , STAGE_BYTES = 8 * HTB, NXCD = 8, WGM = 8;

__host__ __device__ __forceinline__ int lds_byte(int r, int c) { const int st = (r >> 4) * 2 + (c >> 5), rr = r & 15, cc = c & 31, ob = rr * 64 + cc * 2; return st * 1024 + (ob ^ (((ob >> 9) & 1) << 5)); }
__host__ __device__ __forceinline__ void stage_rc(int b, int& R, int& C) { const int st = b / 1024, sb = b % 1024, swz = sb ^ (((sb >> 9) & 1) << 5); R = (st >> 1) * 16 + swz / 64; C = (st & 1) * 32 + (swz % 64) / 2; }
__host__ __device__ __forceinline__ int perm32(int rho) { const int n = rho >> 4, i = rho & 15; return 8 * (i >> 2) + 4 * n + (i & 3); }

struct Unit { int pm, pn; };
struct Gemm { const bf16_t* A; const bf16_t* Bt; int M, N, K; int a_grp; size_t a_grp_bytes; };

struct StaticOrder {
    int nM, nN, nwg, G, c;
    __host__ __device__ void init(int M, int N, int G_, int c_) { nM = M / BM; nN = N / BM; nwg = nM * nN; G = G_; c = c_; }
    __host__ __device__ bool next(int i, Unit& u) const {
        const long L = (long)i * G + c; if (L >= nwg) return false;
        int wgid = (int)L; { const int q = nwg / NXCD, r = nwg % NXCD, xcd = wgid % NXCD, off = wgid / NXCD; wgid = (xcd < r ? xcd * (q + 1) : r * (q + 1) + (xcd - r) * q) + off; }
        const int nig = WGM * nN, gid = wgid / nig, fm = gid * WGM, gsz = (nM - fm) < WGM ? (nM - fm) : WGM;
        u.pm = fm + ((wgid % nig) % gsz); u.pn = (wgid % nig) / gsz; return true;
    }
    __device__ __forceinline__ void a_ready(const Unit&) const {}
    __device__ __forceinline__ void done(const Unit&) const {}
};

__device__ __forceinline__ unsigned cvt_pk_bf16(float lo, float hi) { unsigned r; asm volatile("v_cvt_pk_bf16_f32 %0, %1, %2" : "=v"(r) : "v"(lo), "v"(hi)); return r; }
typedef float f32x2 __attribute__((ext_vector_type(2)));
__device__ __forceinline__ float bflo(unsigned w) { return __builtin_bit_cast(float, w << 16); }
__device__ __forceinline__ float bfhi(unsigned w) { return __builtin_bit_cast(float, w & 0xffff0000u); }
template <int ACT> struct EpiBf16 {
    static constexpr bool PERM = true, AFTER_DRAIN = false;
    bf16_t* O; int ldc; int split_cols; size_t split_stride;
    __device__ __forceinline__ void operator()(const f32x4 (&acc)[2][2][4][2], const Unit& u, int wr, int wc, int fr, int fq) const {
        const int row0 = u.pm * BM + wr * 64 + fr; int colt = u.pn * BM; bf16_t* base = O;
        if (split_cols) { const int t = colt / split_cols; base += (size_t)t * split_stride; colt -= t * split_cols; }
        const int col0 = colt + wc * 32 + 8 * fq;
#pragma unroll
        for (int ai = 0; ai < 2; ++ai)
#pragma unroll
            for (int m = 0; m < 4; ++m) { bf16_t* rowp = base + (size_t)(row0 + ai * HALF + m * 16) * ldc + col0;
#pragma unroll
                for (int bj = 0; bj < 2; ++bj) { f32x4 v0 = acc[ai][bj][m][0], v1 = acc[ai][bj][m][1];
                    if (ACT == 2) {
#pragma unroll
                        for (int j = 0; j < 4; ++j) { const float a = fmaxf(v0[j], 0.f), b = fmaxf(v1[j], 0.f); v0[j] = a * a; v1[j] = b * b; } }
                    u32x4 w; w.x = cvt_pk_bf16(v0[0], v0[1]); w.y = cvt_pk_bf16(v0[2], v0[3]); w.z = cvt_pk_bf16(v1[0], v1[1]); w.w = cvt_pk_bf16(v1[2], v1[3]);
                    *(u32x4*)(rowp + bj * HALF) = w; } }
    }
};
struct EpiMerge {
    static constexpr bool PERM = true, AFTER_DRAIN = false;
    const bf16_t* Y; size_t ystride; float* accf; bf16_t* merged;
    __device__ __forceinline__ void operator()(const f32x4 (&acc)[2][2][4][2], const Unit& u, int wr, int wc, int fr, int fq) const {
        const int b = u.pn >> 2, ct = u.pn & 3;
        const int row0 = u.pm * BM + wr * 64 + fr, col0 = ct * BM + wc * 32 + 8 * fq;
        const bf16_t* Yb = Y + (size_t)b * ystride;
#pragma unroll
        for (int ai = 0; ai < 2; ++ai)
#pragma unroll
            for (int m = 0; m < 4; ++m) {
#pragma unroll
                for (int bj = 0; bj < 2; ++bj) { const size_t o = (size_t)(row0 + ai * HALF + m * 16) * 1024 + col0 + bj * HALF;
                    const u32x4 yv = *(const u32x4*)(Yb + o);
                    float y[8] = {bflo(yv.x), bfhi(yv.x), bflo(yv.y), bfhi(yv.y), bflo(yv.z), bfhi(yv.z), bflo(yv.w), bfhi(yv.w)};
                    float p[8];
#pragma unroll
                    for (int j = 0; j < 8; ++j) { const float a = j < 4 ? acc[ai][bj][m][0][j & 3] : acc[ai][bj][m][1][j & 3];
                        const float g = __builtin_amdgcn_rcpf(1.0f + __builtin_amdgcn_exp2f(-1.4426950408889634f * a)); p[j] = g * y[j]; }
                    if (b > 0) { const f32x4 c0 = *(const f32x4*)(accf + o), c1 = *(const f32x4*)(accf + o + 4);
#pragma unroll
                        for (int j = 0; j < 4; ++j) { p[j] += c0[j]; p[4 + j] += c1[j]; } }
                    if (b < 2) { *(f32x4*)(accf + o) = (f32x4){p[0], p[1], p[2], p[3]}; *(f32x4*)(accf + o + 4) = (f32x4){p[4], p[5], p[6], p[7]}; }
                    else { u32x4 w; w.x = cvt_pk_bf16(p[0], p[1]); w.y = cvt_pk_bf16(p[2], p[3]); w.z = cvt_pk_bf16(p[4], p[5]); w.w = cvt_pk_bf16(p[6], p[7]); *(u32x4*)(merged + o) = w; } } }
    }
};
struct EpiRes {
    static constexpr bool PERM = false, AFTER_DRAIN = false;
    const float* base_p; const float* base_s; float* out_p; float* out_s;
    __device__ __forceinline__ void operator()(const f32x4 (&acc)[2][2][4][2], const Unit& u, int wr, int wc, int fr, int fq) const {
        const bool smp = u.pm >= 64; const float* bs = smp ? base_s : base_p; float* ot = smp ? out_s : out_p;
        const int r0 = (smp ? u.pm - 64 : u.pm) * BM + wr * 64 + fr, col0 = u.pn * BM + wc * 32 + 4 * fq;
#pragma unroll
        for (int ai = 0; ai < 2; ++ai)
#pragma unroll
            for (int m = 0; m < 4; ++m) { const size_t off = (size_t)(r0 + ai * HALF + m * 16) * 1024 + col0;
#pragma unroll
                for (int bj = 0; bj < 2; ++bj)
#pragma unroll
                    for (int n = 0; n < 2; ++n) { const size_t o = off + bj * HALF + n * 16; const f32x4 v = *(const f32x4*)(bs + o) + acc[ai][bj][m][n]; *(f32x4*)(ot + o) = v; } }
    }
};
struct MergeOrder {
    int nM, nwg, G, c;
    __host__ __device__ void init(int M, int G_, int c_) { nM = M / BM; nwg = nM * 4; G = G_; c = c_; }
    __host__ __device__ bool next(int i, Unit& u) const {
        const int j = i / 3, b = i - 3 * j; const long L = (long)j * G + c; if (L >= nwg) return false;
        int wgid = (int)L; { const int q = nwg / NXCD, r = nwg % NXCD, xcd = wgid % NXCD, off = wgid / NXCD; wgid = (xcd < r ? xcd * (q + 1) : r * (q + 1) + (xcd - r) * q) + off; }
        const int nN = 4, nig = WGM * nN, gid = wgid / nig, fm = gid * WGM, gsz = (nM - fm) < WGM ? (nM - fm) : WGM;
        u.pm = fm + ((wgid % nig) % gsz); u.pn = b * 4 + (wgid % nig) / gsz; return true;
    }
    __device__ __forceinline__ void a_ready(const Unit&) const {}
    __device__ __forceinline__ void done(const Unit&) const {}
};
template <class Epi, class Sched, bool ALIGN_EPI = false, bool SP2 = false>
__device__ __forceinline__ void gemm_phase(PG8_LAS unsigned char* lds, const Gemm g, const Sched& S, const Epi& E) {
    int tid_ = threadIdx.x; asm volatile("" : "+v"(tid_)); const int tid = tid_, wid = __builtin_amdgcn_readfirstlane(tid >> 6), lane = tid & 63, wr = wid >> 2, wc = wid & 3, fr = lane & 15, fq = lane >> 4;
    const int K = g.K, nt = K / BK;
    unsigned voffA[2], voffB[2];
#pragma unroll
    for (int i = 0; i < 2; ++i) { int R, C; stage_rc(tid * 16 + i * 8192, R, C); const int Rb = Epi::PERM ? ((R & ~31) + perm32(R & 31)) : R;
        voffA[i] = (unsigned)(R * K + C) * 2u; voffB[i] = (unsigned)(Rb * K + C) * 2u; }
    const size_t kstep = (size_t)(BK * 2);
    const size_t hstep = (size_t)HALF * K * 2;
    const size_t tstep = 2 * hstep;
    const unsigned ldsw = (unsigned)wid * 1024u;
    const int aoff = lds_byte(wr * 64 + fr, fq * 8), boff = lds_byte(wc * 32 + fr, fq * 8);
#define PG8_SA(b, h) (((b) * 2 + (h)) * HTB)
#define PG8_SB(b, h) ((4 + (b) * 2 + (h)) * HTB)
#define PG8_STAGE(bufoff, gbase, voff) do { _Pragma("unroll") for (int _i = 0; _i < 2; ++_i) \
        __builtin_amdgcn_global_load_lds((const unsigned*)((const char*)(gbase) + (voff)[_i]), (PG8_LAS unsigned*)(lds + (bufoff) + ldsw + _i * 8192), 16, 0, 0); } while (0)
#define PG8_LDA(dst, b, h) do { _Pragma("unroll") for (int m = 0; m < 4; ++m) _Pragma("unroll") for (int k = 0; k < 2; ++k) dst[m][k] = *(const PG8_LAS bf16x8*)(lds + PG8_SA(b, h) + aoff + m * 2048 + k * 1024); } while (0)
#define PG8_LDB(dst, b, h) do { _Pragma("unroll") for (int n = 0; n < 2; ++n) _Pragma("unroll") for (int k = 0; k < 2; ++k) dst[n][k] = *(const PG8_LAS bf16x8*)(lds + PG8_SB(b, h) + boff + n * 2048 + k * 1024); } while (0)
#define PG8_MMA(ai, bj, At, Bt) do { __builtin_amdgcn_s_setprio(1); _Pragma("unroll") for (int m = 0; m < 4; ++m) _Pragma("unroll") for (int n = 0; n < 2; ++n) _Pragma("unroll") for (int k = 0; k < 2; ++k) \
        acc[ai][bj][m][n] = __builtin_amdgcn_mfma_f32_16x16x32_bf16(Bt[n][k], At[m][k], acc[ai][bj][m][n], 0, 0, 0); __builtin_amdgcn_s_setprio(0); } while (0)
#define PG8_WAIT_V(n) asm volatile("s_waitcnt vmcnt(" #n ")" ::: "memory")
#define PG8_WAIT_L(n) asm volatile("s_waitcnt lgkmcnt(" #n ")" ::: "memory")
#define PG8_BAR __builtin_amdgcn_s_barrier()
#define PG8_SCHED __builtin_amdgcn_sched_barrier(0)
    Unit cur, nxt; int ui = 0;
    if (!S.next(0, cur)) return;
    f32x4 acc[2][2][4][2];
#pragma unroll
    for (int a = 0; a < 2; ++a)
#pragma unroll
        for (int b = 0; b < 2; ++b)
#pragma unroll
            for (int m = 0; m < 4; ++m)
#pragma unroll
                for (int n = 0; n < 2; ++n) acc[a][b][m][n] = (f32x4){0.f, 0.f, 0.f, 0.f};
    bf16x8 At[4][2], B0[2][2], B1[2][2];
    const char* cA = (const char*)g.A + (size_t)(cur.pn / g.a_grp) * g.a_grp_bytes + (size_t)cur.pm * tstep; const char* cB = (const char*)g.Bt + (size_t)cur.pn * tstep;
    S.a_ready(cur);
    if constexpr (SP2) {
        PG8_STAGE(PG8_SB(0, 0), cB, voffB); PG8_STAGE(PG8_SB(0, 1), cB + hstep, voffB); PG8_STAGE(PG8_SA(0, 0), cA, voffA); PG8_STAGE(PG8_SA(0, 1), cA + hstep, voffA);
        if (wr == 1) PG8_BAR;
        PG8_WAIT_V(2); PG8_BAR;
        PG8_STAGE(PG8_SB(1, 0), cB + kstep, voffB); PG8_STAGE(PG8_SA(1, 0), cA + kstep, voffA); PG8_STAGE(PG8_SB(1, 1), cB + hstep + kstep, voffB);
        PG8_WAIT_V(6); PG8_BAR;
    } else {
        PG8_STAGE(PG8_SB(0, 0), cB, voffB); PG8_STAGE(PG8_SA(0, 0), cA, voffA); PG8_STAGE(PG8_SB(0, 1), cB + hstep, voffB); PG8_STAGE(PG8_SA(0, 1), cA + hstep, voffA);
        if (wr == 1) PG8_BAR;
        PG8_WAIT_V(4); PG8_BAR;
        PG8_STAGE(PG8_SB(1, 0), cB + kstep, voffB); PG8_STAGE(PG8_SA(1, 0), cA + kstep, voffA); PG8_STAGE(PG8_SB(1, 1), cB + hstep + kstep, voffB);
        PG8_WAIT_V(6); PG8_BAR;
    }
    for (;;) {
        const bool has_next = S.next(ui + 1, nxt);
        const char* nA = has_next ? (const char*)g.A + (size_t)(nxt.pn / g.a_grp) * g.a_grp_bytes + (size_t)nxt.pm * tstep : cA; const char* nB = has_next ? (const char*)g.Bt + (size_t)nxt.pn * tstep : cB;
        for (int t = 0; t < nt; t += 2) {
            const bool last = (t == nt - 2);
            const char* a1 = cA + (size_t)(t + 1) * kstep;
            const char* a2 = last ? nA : cA + (size_t)(t + 2) * kstep; const char* b2 = last ? nB : cB + (size_t)(t + 2) * kstep;
            const char* a3 = a2 + kstep; const char* b3 = b2 + kstep;
            if (last && has_next) S.a_ready(nxt);
            if constexpr (SP2) {
            PG8_LDB(B0, 0, 0); PG8_LDB(B1, 0, 1); PG8_SCHED; PG8_LDA(At, 0, 0); PG8_STAGE(PG8_SA(1, 1), a1 + hstep, voffA);
            PG8_WAIT_V(8); PG8_WAIT_L(0); PG8_BAR; PG8_MMA(0, 0, At, B0); PG8_MMA(0, 1, At, B1); PG8_BAR; PG8_SCHED;
            PG8_LDA(At, 0, 1); PG8_STAGE(PG8_SB(0, 0), b2, voffB); PG8_STAGE(PG8_SB(0, 1), b2 + hstep, voffB); PG8_STAGE(PG8_SA(0, 0), a2, voffA);
            PG8_WAIT_V(8); PG8_WAIT_L(0); PG8_BAR; PG8_MMA(1, 0, At, B0); PG8_MMA(1, 1, At, B1); PG8_BAR; PG8_SCHED;
            PG8_LDB(B0, 1, 0); PG8_LDB(B1, 1, 1); PG8_SCHED; PG8_LDA(At, 1, 0); PG8_STAGE(PG8_SA(0, 1), a2 + hstep, voffA);
            PG8_WAIT_V(8); PG8_WAIT_L(0); PG8_BAR; PG8_MMA(0, 0, At, B0); PG8_MMA(0, 1, At, B1); PG8_BAR; PG8_SCHED;
            PG8_LDA(At, 1, 1); PG8_STAGE(PG8_SB(1, 0), b3, voffB); PG8_STAGE(PG8_SB(1, 1), b3 + hstep, voffB); PG8_STAGE(PG8_SA(1, 0), a3, voffA);
            PG8_WAIT_V(8); PG8_WAIT_L(0); PG8_BAR; PG8_MMA(1, 0, At, B0); PG8_MMA(1, 1, At, B1); PG8_BAR; PG8_SCHED;
            } else {
            PG8_LDB(B0, 0, 0); PG8_SCHED; PG8_LDA(At, 0, 0); PG8_STAGE(PG8_SA(1, 1), a1 + hstep, voffA);
            PG8_WAIT_L(8); PG8_BAR; PG8_WAIT_L(0); PG8_MMA(0, 0, At, B0); PG8_BAR; PG8_SCHED;
            PG8_LDB(B1, 0, 1); PG8_STAGE(PG8_SB(0, 0), b2, voffB);
            PG8_BAR; PG8_WAIT_L(0); PG8_MMA(0, 1, At, B1); PG8_BAR;
            PG8_LDA(At, 0, 1); PG8_STAGE(PG8_SA(0, 0), a2, voffA);
            PG8_BAR; PG8_WAIT_L(0); PG8_MMA(1, 0, At, B0); PG8_BAR; PG8_SCHED;
            PG8_STAGE(PG8_SB(0, 1), b2 + hstep, voffB);
            PG8_WAIT_V(6); PG8_BAR; PG8_MMA(1, 1, At, B1); PG8_BAR;
            PG8_LDB(B0, 1, 0); PG8_SCHED; PG8_LDA(At, 1, 0); PG8_STAGE(PG8_SA(0, 1), a2 + hstep, voffA);
            PG8_WAIT_L(8); PG8_BAR; PG8_WAIT_L(0); PG8_MMA(0, 0, At, B0); PG8_BAR; PG8_SCHED;
            PG8_LDB(B1, 1, 1); PG8_STAGE(PG8_SB(1, 0), b3, voffB);
            PG8_BAR; PG8_WAIT_L(0); PG8_MMA(0, 1, At, B1); PG8_BAR;
            PG8_LDA(At, 1, 1); PG8_STAGE(PG8_SA(1, 0), a3, voffA);
            PG8_BAR; PG8_WAIT_L(0); PG8_MMA(1, 0, At, B0); PG8_BAR; PG8_SCHED;
            PG8_STAGE(PG8_SB(1, 1), b3 + hstep, voffB);
            PG8_WAIT_V(6); PG8_BAR; PG8_MMA(1, 1, At, B1); PG8_BAR;
            }
        }
        if constexpr (ALIGN_EPI) { if (wr == 0) PG8_BAR; }
        if constexpr (!Epi::AFTER_DRAIN) { E(acc, cur, wr, wc, fr, fq); S.done(cur); }
        if (!has_next) break;
#pragma unroll
        for (int a = 0; a < 2; ++a)
#pragma unroll
            for (int b = 0; b < 2; ++b)
#pragma unroll
                for (int m = 0; m < 4; ++m)
#pragma unroll
                    for (int n = 0; n < 2; ++n) acc[a][b][m][n] = (f32x4){0.f, 0.f, 0.f, 0.f};
        cur = nxt; cA = nA; cB = nB; ++ui;
        if constexpr (ALIGN_EPI) { if (wr == 1) PG8_BAR; }
    }
    PG8_WAIT_V(0);
    if constexpr (!ALIGN_EPI) { if (wr == 0) PG8_BAR; }
    PG8_BAR;
    if constexpr (Epi::AFTER_DRAIN) { E.fused(acc, cur, wr, wc, fr, fq, lds, wid, lane); S.done(cur); }
#undef PG8_SA
#undef PG8_SB
#undef PG8_STAGE
#undef PG8_LDA
#undef PG8_LDB
#undef PG8_MMA
#undef PG8_WAIT_V
#undef PG8_WAIT_L
#undef PG8_BAR
#undef PG8_SCHED
}
}
#include <hip/hip_bf16.h>
#include <cmath>
namespace attn_body {
using bf16=__hip_bfloat16;
using bf16x8=__attribute__((ext_vector_type(8)))short;
using s16x4=__attribute__((ext_vector_type(4)))short;
using f32x16=__attribute__((ext_vector_type(16)))float;
using u32x4=__attribute__((ext_vector_type(4)))unsigned;
constexpr int D=64,PQ=4096,PO=512;
constexpr int NW=8,QBLK=32,QB=QBLK*NW,KVBLK=64;
__device__ __forceinline__ int crow(int r,int hi){return (r&3)+8*(r>>2)+4*hi;}
#define SBAR() __builtin_amdgcn_sched_barrier(0)
constexpr int NSLOT=3, SLOTB=8192;
constexpr int LDS_K=0, LDS_V=NSLOT*SLOTB, LDS_WS=2*NSLOT*SLOTB, LDS_OST=LDS_WS+NW*64*4, LDS_BYTES=LDS_OST+NW*4096;
constexpr float C2=0.125f*1.4426950408889634f;
__device__ __forceinline__ void glds16(const void*gsrc,unsigned lds_dst){unsigned keep;
  asm volatile("s_mov_b32 %0, m0\n\ts_mov_b32 m0, %2\n\ts_nop 0\n\tglobal_load_lds_dwordx4 %1, off\n\ts_mov_b32 m0, %0":"=&s"(keep):"v"(gsrc),"s"(lds_dst):"memory");}
__device__ __forceinline__ float max3f(float a,float b,float c){float r;asm("v_max3_f32 %0, %1, %2, %3":"=v"(r):"v"(a),"v"(b),"v"(c));return r;}
__device__ __forceinline__ float max2f(float a,float b){float r;asm("v_max_f32_e32 %0, %1, %2":"=v"(r):"v"(a),"v"(b));return r;}
__device__ __forceinline__ float fadd_s(float a,float b){float r;asm("v_add_f32_e32 %0, %1, %2":"=v"(r):"v"(a),"v"(b));return r;}
__device__ __forceinline__ float fsub_s(float a,float b){float r;asm("v_sub_f32_e32 %0, %1, %2":"=v"(r):"v"(a),"v"(b));return r;}
typedef float f32x2_t __attribute__((ext_vector_type(2))); typedef __bf16 bf16x2_t __attribute__((ext_vector_type(2)));
__device__ __forceinline__ unsigned cvtpk_s(float lo,float hi){f32x2_t v={lo,hi};bf16x2_t b=__builtin_convertvector(v,bf16x2_t);return __builtin_bit_cast(unsigned,b);}
#define WAIT_BAR(N) asm volatile("s_waitcnt vmcnt(" #N ") lgkmcnt(0)\n\ts_barrier":::"memory")

__device__ __forceinline__ void qkt(f32x16&p0,f32x16&p1,const char*Kslot,const bf16x8*qr,const f32x16&negm,int r32,int hi){
  const char*kb=Kslot+hi*1024+r32*16;
  #pragma unroll
  for(int d0=0;d0<4;++d0){
    const bf16x8 b0=*reinterpret_cast<const bf16x8*>(kb+d0*2048);
    const bf16x8 b1=*reinterpret_cast<const bf16x8*>(kb+d0*2048+512);
    if(d0==0){p0=__builtin_amdgcn_mfma_f32_32x32x16_bf16(b0,qr[0],negm,0,0,0);p1=__builtin_amdgcn_mfma_f32_32x32x16_bf16(b1,qr[0],negm,0,0,0);}
    else{p0=__builtin_amdgcn_mfma_f32_32x32x16_bf16(b0,qr[d0],p0,0,0,0);p1=__builtin_amdgcn_mfma_f32_32x32x16_bf16(b1,qr[d0],p1,0,0,0);}}
}
typedef __attribute__((address_space(3))) const char* lds_cptr;
typedef short v4i16_t __attribute__((ext_vector_type(4)));
__device__ __forceinline__ void kload8(bf16x8*kf,lds_cptr kp){
  kf[0]=*(const __attribute__((address_space(3))) bf16x8*)(kp);      kf[1]=*(const __attribute__((address_space(3))) bf16x8*)(kp+512);
  kf[2]=*(const __attribute__((address_space(3))) bf16x8*)(kp+2048); kf[3]=*(const __attribute__((address_space(3))) bf16x8*)(kp+2560);
  kf[4]=*(const __attribute__((address_space(3))) bf16x8*)(kp+4096); kf[5]=*(const __attribute__((address_space(3))) bf16x8*)(kp+4608);
  kf[6]=*(const __attribute__((address_space(3))) bf16x8*)(kp+6144); kf[7]=*(const __attribute__((address_space(3))) bf16x8*)(kp+6656);
}
__device__ __forceinline__ void kload2(bf16x8*kf,lds_cptr kp,int j){ kf[2*j]=*(const __attribute__((address_space(3))) bf16x8*)(kp+j*2048); kf[2*j+1]=*(const __attribute__((address_space(3))) bf16x8*)(kp+j*2048+512); }
__device__ __forceinline__ s16x4 vtr(lds_cptr p){ return __builtin_bit_cast(s16x4,__builtin_amdgcn_ds_read_tr16_b64_v4i16((__attribute__((address_space(3))) v4i16_t*)p)); }
__device__ __forceinline__ float rowmax(const f32x16&p0,const f32x16&p1){
  float a=max3f(p0[0],p0[1],p1[0]),b=max3f(p0[2],p0[3],p1[1]);a=max3f(a,p1[2],p1[3]);
  #pragma unroll
  for(int r=4;r<16;r+=4){a=max3f(a,p0[r],p0[r+1]);b=max3f(b,p0[r+2],p0[r+3]);a=max3f(a,p1[r],p1[r+1]);b=max3f(b,p1[r+2],p1[r+3]);}
  const float m=max2f(a,b);
  auto rr=__builtin_amdgcn_permlane32_swap(__float_as_uint(m),__float_as_uint(m),false,false);
  return max2f(__uint_as_float(rr[0]),__uint_as_float(rr[1]));
}
__device__ __forceinline__ void pv(f32x16*o,int vb,bf16x8 pa0,bf16x8 pa1,bf16x8 pa2,bf16x8 pa3){
  #pragma unroll
  for(int d0=0;d0<2;++d0){s16x4 lo[4],hi[4];
    #pragma unroll
    for(int ks=0;ks<4;++ks){
      asm volatile("ds_read_b64_tr_b16 %0,%1 offset:%c2":"=&v"(lo[ks]):"v"(vb),"i"(d0*4096+ks*1024):"memory");
      asm volatile("ds_read_b64_tr_b16 %0,%1 offset:%c2":"=&v"(hi[ks]):"v"(vb),"i"(d0*4096+ks*1024+512):"memory");}
    asm volatile("s_waitcnt lgkmcnt(0)":::"memory");SBAR();
    #define PK(k) (bf16x8){lo[k][0],lo[k][1],lo[k][2],lo[k][3],hi[k][0],hi[k][1],hi[k][2],hi[k][3]}
    o[d0]=__builtin_amdgcn_mfma_f32_32x32x16_bf16(pa0,PK(0),o[d0],0,0,0);
    o[d0]=__builtin_amdgcn_mfma_f32_32x32x16_bf16(pa1,PK(1),o[d0],0,0,0);
    o[d0]=__builtin_amdgcn_mfma_f32_32x32x16_bf16(pa2,PK(2),o[d0],0,0,0);
    o[d0]=__builtin_amdgcn_mfma_f32_32x32x16_bf16(pa3,PK(3),o[d0],0,0,0);
    #undef PK
  }
}

#ifndef ATTN_STORE16
#define ATTN_STORE16(p,v) (*(u32x4*)(p)=(v))
#endif
template<int THRL> __device__ __forceinline__ void attn_unit(const bf16*Qu,const bf16*__restrict__ Kh,const bf16*__restrict__ Vh,bf16*Ou,const int NT,char*shm){
  int tid_=threadIdx.x; asm volatile("":"+v"(tid_)); const int tid=tid_,lane=tid&63,r32=lane&31,hi=lane>>5; const int wid=__builtin_amdgcn_readfirstlane(tid>>6);
  const bf16*Qw=Qu+(long)(wid*QBLK)*PQ;
  const unsigned lds0=(unsigned)(uintptr_t)shm;
  float*wsf=(float*)(shm+LDS_WS)+wid*64;
  const bf16*ksrc=Kh+(long)lane*PQ+wid*8;
  const bf16*vsrc=Vh+(long)(16*(wid&3)+(lane>>2))*PQ+(wid>>2)*32+(lane&3)*8;
  const unsigned kdst=lds0+LDS_K+wid*1024, vdst=lds0+LDS_V+wid*1024;
  #define DMA_K(t,slot) glds16(ksrc+(long)(t)*KVBLK*PQ,(unsigned)__builtin_amdgcn_readfirstlane(kdst+(slot)))
  #define DMA_V(t,slot) glds16(vsrc+(long)(t)*KVBLK*PQ,(unsigned)__builtin_amdgcn_readfirstlane(vdst+(slot)))
  const int vb0=(int)(lds0+LDS_V)+((lane>>4)&1)*32+(lane&3)*8+(4*hi+((lane&15)>>2))*64;
  const char*Kbase=shm+LDS_K; bf16x8 kf[8];
  const lds_cptr shm3=(lds_cptr)shm; const lds_cptr kp0=shm3+LDS_K+hi*1024+r32*16; const lds_cptr vp0=shm3+LDS_V+((lane>>4)&1)*32+(lane&3)*8+(4*hi+((lane&15)>>2))*64;
  DMA_K(0,0);DMA_V(0,0);DMA_K(1,SLOTB);
  bf16x8 qr[4];
  #pragma unroll
  for(int d0=0;d0<4;++d0)qr[d0]=*reinterpret_cast<const bf16x8*>(&Qw[(long)r32*PQ+d0*16+hi*8]);
  float mhat=0.f,l_reg=0.f;f32x16 o[2];o[0]=f32x16{};o[1]=f32x16{};f32x16 negm=f32x16{};asm volatile("":"+v"(negm));
  #define CMASK(P0,P1,t) do{}while(0)
  bool resc=false;
  #define START(P0,P1) do{ const float rm=rowmax(P0,P1); resc=false; \
    { const float dl=rm; mhat=fadd_s(mhat,dl); \
      _Pragma("unroll") for(int r=0;r<16;++r){P0[r]=fsub_s(P0[r],dl);P1[r]=fsub_s(P1[r],dl);} \
      _Pragma("unroll") for(int r=0;r<16;++r)negm[r]=-mhat; asm volatile("":"+v"(negm)); } \
    _Pragma("unroll") for(int r=0;r<16;++r)P0[r]=__builtin_amdgcn_exp2f(P0[r]); }while(0)
  #define RESC() do{ if(resc){ asm volatile("s_waitcnt lgkmcnt(0)":::"memory"); \
      _Pragma("unroll") for(int d_=0;d_<2;++d_) _Pragma("unroll") for(int r=0;r<16;++r)o[d_][r]*=wsf[crow(r,hi)]; } }while(0)
  f32x16 pA0,pA1,pB0,pB1;
  int sl_prev=0,sl_cur=0,sl_next=SLOTB;
  #define ROT() do{sl_prev=sl_cur;sl_cur=sl_next;sl_next=(sl_next==(NSLOT-1)*SLOTB)?0:sl_next+SLOTB;}while(0)
  DMA_K(2,2*SLOTB);
  WAIT_BAR(3);
  qkt(pA0,pA1,Kbase,qr,negm,r32,hi);asm volatile("s_nop 15\n\ts_nop 7":"+v"(pA0),"+v"(pA1));CMASK(pA0,pA1,0);
  START(pA0,pA1);
  _Pragma("unroll") for(int r=0;r<16;++r)pA1[r]=__builtin_amdgcn_exp2f(pA1[r]);
  WAIT_BAR(0);
  DMA_K(3,0);DMA_V(1,SLOTB);
  ROT();
  kload8(kf,kp0+sl_cur);
  WAIT_BAR(2);
  s16x4 vlo[8],vhi[8]; u32x4 pw0,pw1,pw2,pw3;
  #define PKW(P,B) cvtpk_s(P[B],P[B+1])
  #define PAF(k) __builtin_bit_cast(bf16x8,pw##k)
  #define VFR(i) (bf16x8){vlo[i][0],vlo[i][1],vlo[i][2],vlo[i][3],vhi[i][0],vhi[i][1],vhi[i][2],vhi[i][3]}
  #define PIN(x) asm volatile("":"+v"(x))
  #define MX3(a,b,c) __builtin_fmaxf(__builtin_fmaxf((a),(b)),(c))
  #define GAPA(MF,A0,A1,A2,A3,W0,W1,PW) do{ MF; sacc+=A0; sacc+=A1; sacc+=A2; sacc+=A3; PIN(sacc); W0; W1; PIN(PW); SBAR(); }while(0)
  #define EX(v) __builtin_amdgcn_exp2f(v)
  #define GAPB(MF,X,B) do{ MF; X[B]=EX(X[B]); X[B+1]=EX(X[B+1]); X[B+2]=EX(X[B+2]); X[B+3]=EX(X[B+3]); PIN(X); SBAR(); }while(0)
  #define VRD(i) do{ vlo[i]=vtr(vp_+(((i)>>2)*4096+((i)&3)*1024)); vhi[i]=vtr(vp_+(((i)>>2)*4096+((i)&3)*1024+512)); }while(0)
  #define KRD(G,j) do{ if(G){ kload2(kf,kp0+sl_next,j); SBAR(); } }while(0)
  #define STEP(C0,C1,P0,P1,t,GK,GV,GL) do{ SBAR(); \
    const lds_cptr vp_=vp0+sl_prev; \
    VRD(0); SBAR(); float sacc=(P0[0]+P0[1]); \
    GAPA(C0=__builtin_amdgcn_mfma_f32_32x32x16_bf16(kf[0],qr[0],negm,0,0,0), P0[2],P0[3],P0[4],P0[5],     pw0[0]=PKW(P0,0), pw0[1]=PKW(P0,2), pw0); \
    VRD(4); SBAR(); GAPA(C1=__builtin_amdgcn_mfma_f32_32x32x16_bf16(kf[1],qr[0],negm,0,0,0), P0[6],P0[7],P0[8],P0[9],     pw0[2]=PKW(P0,4), pw0[3]=PKW(P0,6), pw0); \
    VRD(1); SBAR(); GAPA(C0=__builtin_amdgcn_mfma_f32_32x32x16_bf16(kf[2],qr[1],C0,0,0,0),   P0[10],P0[11],P0[12],P0[13], pw1[0]=PKW(P0,8), pw1[1]=PKW(P0,10), pw1); \
    VRD(5); SBAR(); GAPA(C1=__builtin_amdgcn_mfma_f32_32x32x16_bf16(kf[3],qr[1],C1,0,0,0),   P0[14],P0[15],P1[0],P1[1],   pw1[2]=PKW(P0,12),pw1[3]=PKW(P0,14), pw1); \
    VRD(2); SBAR(); GAPA(C0=__builtin_amdgcn_mfma_f32_32x32x16_bf16(kf[4],qr[2],C0,0,0,0),   P1[2],P1[3],P1[4],P1[5],     pw2[0]=PKW(P1,0), pw2[1]=PKW(P1,2), pw2); \
    VRD(6); SBAR(); GAPA(C1=__builtin_amdgcn_mfma_f32_32x32x16_bf16(kf[5],qr[2],C1,0,0,0),   P1[6],P1[7],P1[8],P1[9],     pw2[2]=PKW(P1,4), pw2[3]=PKW(P1,6), pw2); \
    VRD(3); SBAR(); GAPA(C0=__builtin_amdgcn_mfma_f32_32x32x16_bf16(kf[6],qr[3],C0,0,0,0),   P1[10],P1[11],P1[12],P1[13], pw3[0]=PKW(P1,8), pw3[1]=PKW(P1,10), pw3); \
    VRD(7); SBAR(); GAPA(C1=__builtin_amdgcn_mfma_f32_32x32x16_bf16(kf[7],qr[3],C1,0,0,0),   P1[14],P1[15],0.f,0.f,       pw3[2]=PKW(P1,12),pw3[3]=PKW(P1,14), pw3); \
    l_reg+=sacc; \
    if(GK){DMA_K((t)+3,sl_cur);} if(GV){DMA_V((t)+1,sl_next);} \
    CMASK(C0,C1,t); \
    { float a=MX3(C0[0],C0[1],C1[0]),b=MX3(C0[2],C0[3],C1[1]); a=MX3(a,C1[2],C1[3]); \
      _Pragma("unroll") for(int r=4;r<16;r+=4){a=MX3(a,C0[r],C0[r+1]);b=MX3(b,C0[r+2],C0[r+3]);a=MX3(a,C1[r],C1[r+1]);b=MX3(b,C1[r+2],C1[r+3]);} \
      float rm=__builtin_fmaxf(a,b); { auto rr=__builtin_amdgcn_permlane32_swap(__float_as_uint(rm),__float_as_uint(rm),false,false); rm=__builtin_fmaxf(__uint_as_float(rr[0]),__uint_as_float(rr[1])); } \
      resc=false; \
      if(__builtin_expect(__any(rm>(float)THRL),0)){ const float dl=__builtin_fmaxf(rm,0.f); mhat+=dl; \
        _Pragma("unroll") for(int r=0;r<16;++r){C0[r]-=dl;C1[r]-=dl;} \
        _Pragma("unroll") for(int r=0;r<16;++r)negm[r]=-mhat; asm volatile("":"+v"(negm)); \
        const float f=__builtin_amdgcn_exp2f(-dl); l_reg*=f; if(hi==0)wsf[r32]=f; resc=true; } } \
    SBAR(); \
    GAPB(o[0]=__builtin_amdgcn_mfma_f32_32x32x16_bf16(PAF(0),VFR(0),o[0],0,0,0), C0,0); \
    GAPB(o[1]=__builtin_amdgcn_mfma_f32_32x32x16_bf16(PAF(0),VFR(4),o[1],0,0,0), C0,4); \
    KRD(GL,0); GAPB(o[0]=__builtin_amdgcn_mfma_f32_32x32x16_bf16(PAF(1),VFR(1),o[0],0,0,0), C0,8); \
    KRD(GL,1); GAPB(o[1]=__builtin_amdgcn_mfma_f32_32x32x16_bf16(PAF(1),VFR(5),o[1],0,0,0), C0,12); \
    KRD(GL,2); GAPB(o[0]=__builtin_amdgcn_mfma_f32_32x32x16_bf16(PAF(2),VFR(2),o[0],0,0,0), C1,0); \
    KRD(GL,3); GAPB(o[1]=__builtin_amdgcn_mfma_f32_32x32x16_bf16(PAF(2),VFR(6),o[1],0,0,0), C1,4); \
    GAPB(o[0]=__builtin_amdgcn_mfma_f32_32x32x16_bf16(PAF(3),VFR(3),o[0],0,0,0), C1,8); \
    GAPB(o[1]=__builtin_amdgcn_mfma_f32_32x32x16_bf16(PAF(3),VFR(7),o[1],0,0,0), C1,12); \
    }while(0)
  int t=1;
  #undef CMASK
  #define CMASK(P0,P1,t) do{}while(0)
  for(;t+5<NT;t+=2){
    STEP(pB0,pB1,pA0,pA1,t,true,true,true);     WAIT_BAR(2); RESC(); ROT();
    STEP(pA0,pA1,pB0,pB1,t+1,true,true,true);   WAIT_BAR(2); RESC(); ROT();
  }
  #undef CMASK
  #define CMASK(P0,P1,t) do{}while(0)
  #define ENDW(tt) do{ if((tt)+3<NT){WAIT_BAR(2);} else if((tt)+2<NT){WAIT_BAR(1);} else {WAIT_BAR(0);} }while(0)
  for(;t+1<NT;t+=2){
    STEP(pB0,pB1,pA0,pA1,t,(t+3<NT),(t+1<NT),(t+1<NT));       ENDW(t);   RESC(); ROT();
    STEP(pA0,pA1,pB0,pB1,t+1,(t+4<NT),(t+2<NT),(t+2<NT));     ENDW(t+1); RESC(); ROT();
  }
  STEP(pB0,pB1,pA0,pA1,NT-1,false,false,false); RESC();
  { float sacc=pB0[0]+pB0[1]; _Pragma("unroll") for(int r=2;r<16;++r)sacc+=pB0[r]; _Pragma("unroll") for(int r=0;r<16;++r)sacc+=pB1[r]; l_reg+=sacc;
    pw0=(u32x4){PKW(pB0,0),PKW(pB0,2),PKW(pB0,4),PKW(pB0,6)};pw1=(u32x4){PKW(pB0,8),PKW(pB0,10),PKW(pB0,12),PKW(pB0,14)};pw2=(u32x4){PKW(pB1,0),PKW(pB1,2),PKW(pB1,4),PKW(pB1,6)};pw3=(u32x4){PKW(pB1,8),PKW(pB1,10),PKW(pB1,12),PKW(pB1,14)};
    SBAR(); pv(o,vb0+sl_cur,PAF(0),PAF(1),PAF(2),PAF(3)); }
  #undef PKW
  #undef PAF
  #undef VFR
  #undef PIN
  #undef MX3
  #undef GAPA
  #undef GAPB
  #undef EX
  #undef VRD
  #undef KRD
  #undef STEP
  #undef ENDW
  {auto rr=__builtin_amdgcn_permlane32_swap(__float_as_uint(l_reg),__float_as_uint(l_reg),false,false);l_reg=__uint_as_float(rr[0])+__uint_as_float(rr[1]);}
  if(hi==0)wsf[32+r32]=l_reg;asm volatile("s_waitcnt lgkmcnt(0)":::"memory");
  float rli[16];
  #pragma unroll
  for(int r=0;r<16;++r)rli[r]=__builtin_amdgcn_rcpf(wsf[32+crow(r,hi)]);
  bf16*Ow=Ou+(long)(wid*QBLK)*PO;
  { bf16*stg=(bf16*)(shm+LDS_OST)+wid*2048;
    #pragma unroll
    for(int r=0;r<16;++r){const int orow=crow(r,hi);
      #pragma unroll
      for(int d0=0;d0<2;++d0)stg[orow*64+d0*32+r32]=__float2bfloat16(o[d0][r]*rli[r]);}
    asm volatile("s_waitcnt lgkmcnt(0)":::"memory");
    #pragma unroll
    for(int i=0;i<4;++i){const int row=i*8+(lane>>3),ch=lane&7; const u32x4 v=*(const u32x4*)(stg+row*64+ch*8); ATTN_STORE16(Ow+(long)row*PO+ch*8,v);} }
  asm volatile("s_waitcnt lgkmcnt(0)\n\ts_barrier":::"memory");
  #undef DMA_K
  #undef DMA_V
  #undef CMASK
  #undef START
  #undef RESC
  #undef ROT
}
constexpr int ATTN_LDS_BYTES=LDS_BYTES;
#undef SBAR
#undef WAIT_BAR
}
#define GAS __attribute__((address_space(1)))
#define LAS __attribute__((address_space(3)))
typedef unsigned short bf16;
typedef unsigned v4u __attribute__((ext_vector_type(4)));
typedef unsigned v2u __attribute__((ext_vector_type(2)));
typedef float f32x4 __attribute__((ext_vector_type(4)));
typedef short bf16x8 __attribute__((ext_vector_type(8)));
#define LDS_WAIT() asm volatile("s_waitcnt lgkmcnt(0)" ::: "memory")

constexpr int NWAVES = 8;
constexpr int DM = 1024, FF = 4096, DEPTH = 2;
constexpr int MH = 24576, MP = 16384;
constexpr int SP = 2048, SS = 8192;
constexpr int PW = 4096, INW = 3872;
constexpr int C_AQ = 0, C_AK = 512, C_AV = 640, C_GQ = 768, C_GK = 1024, C_GV = 1280, C_GA = 1792, C_GG = 1824, C_RQ = 2336, C_RK = 2592, C_RV = 2848, C_RG = 3360;
constexpr float EPS = 1e-6f;
constexpr float ATT_C2 = 0.125f * 1.4426950408889634f;

constexpr size_t MiB = 1u << 20;
constexpr size_t WS_CTL = 0, CTL_ZERO_BYTES = 4096;
constexpr size_t WS_W = 1 * MiB, LW = 35 * MiB;
constexpr size_t OW_IN = 0, OW_MERGE = 8 * MiB, OW_BR = 14 * MiB, OW_OUT = 17 * MiB, OW_UP = 19 * MiB, OW_DOWN = 27 * MiB;
constexpr size_t WS_XN = 71 * MiB;
constexpr size_t WS_PROJ = 119 * MiB;
constexpr size_t WS_MERGED = WS_PROJ + 144 * MiB;
constexpr size_t WS_OBUF = 311 * MiB;
constexpr size_t OB1 = (size_t)MH * 512;
constexpr size_t WS_END = 431 * MiB;

constexpr int RING_BYTES = 131072, MISC_OFF = RING_BYTES + 320, LDS_BYTES = 147456;

__device__ __forceinline__ unsigned f2bf(float f) { unsigned u = __builtin_bit_cast(unsigned, f); return (u + 0x7fffu + ((u >> 16) & 1u)) >> 16; }
__device__ __forceinline__ unsigned pk2(float lo, float hi) { return f2bf(lo) | (f2bf(hi) << 16); }
__device__ __forceinline__ float bf_lo(unsigned w) { return __builtin_bit_cast(float, w << 16); }
__device__ __forceinline__ float bf_hi(unsigned w) { return __builtin_bit_cast(float, w & 0xffff0000u); }
__device__ __forceinline__ float bf1(unsigned short h) { return __builtin_bit_cast(float, (unsigned)h << 16); }
__device__ __forceinline__ void unpack8(const v4u w, float (&v)[8]) { v[0] = bf_lo(w.x); v[1] = bf_hi(w.x); v[2] = bf_lo(w.y); v[3] = bf_hi(w.y); v[4] = bf_lo(w.z); v[5] = bf_hi(w.z); v[6] = bf_lo(w.w); v[7] = bf_hi(w.w); }
__device__ __forceinline__ v4u pack8(const float (&v)[8]) { v4u w; w.x = pk2(v[0], v[1]); w.y = pk2(v[2], v[3]); w.z = pk2(v[4], v[5]); w.w = pk2(v[6], v[7]); return w; }
__device__ __forceinline__ float wave_sum(float v) {
#pragma unroll
    for (int o = 1; o < 64; o <<= 1) v += __shfl_xor(v, o);
    return v;
}
__device__ __forceinline__ float sigmoidf_fast(float a) { return __builtin_amdgcn_rcpf(1.0f + __builtin_amdgcn_exp2f(-1.4426950408889634f * a)); }

__device__ __forceinline__ void p0_transpose_item(const float* W, int K, int N, bf16* WT, int row_off, LAS float* scr, int item, int lane) {
    const int nblk = N / 32, kb = item / nblk, nb = item % nblk, k0 = 64 * kb, n0 = 32 * nb;
#pragma unroll 8
    for (int i = 0; i < 32; ++i) { const int kk = 2 * i + (lane >> 5); scr[kk * 33 + (lane & 31)] = W[(size_t)(k0 + kk) * N + n0 + (lane & 31)]; }
    LDS_WAIT(); asm volatile("" ::: "memory");
    const int c = lane & 7;
#pragma unroll
    for (int j = 0; j < 4; ++j) { const int n = (lane >> 3) + 8 * j; const LAS float* s = scr + (8 * c) * 33 + n;
        v4u o; o.x = pk2(s[0 * 33], s[1 * 33]); o.y = pk2(s[2 * 33], s[3 * 33]); o.z = pk2(s[4 * 33], s[5 * 33]); o.w = pk2(s[6 * 33], s[7 * 33]);
        *(v4u*)(WT + (size_t)(row_off + n0 + n) * K + k0 + 8 * c) = o; }
    LDS_WAIT(); asm volatile("" ::: "memory");
}

__device__ __forceinline__ void norm_rows(const float* xp, const float* xs, const float* gain, bf16* XN, int gw, int NGW, int lane_in) {
    int lane = lane_in; asm volatile("" : "+v"(lane)); asm volatile("" : "+s"(gw));
    f32x4 g[4];
#pragma unroll
    for (int j = 0; j < 4; ++j) g[j] = *((const f32x4*)gain + lane + 64 * j);
    for (int m = gw; m < MH; m += NGW) {
        const float* xrow = m < MP ? xp + (size_t)m * DM : xs + (size_t)(m - MP) * DM;
        const f32x4* xr = (const f32x4*)xrow + lane;
        f32x4 v[4]; float s = 0.f;
#pragma unroll
        for (int j = 0; j < 4; ++j) { v[j] = xr[64 * j]; s += (v[j].x * v[j].x + v[j].y * v[j].y) + (v[j].z * v[j].z + v[j].w * v[j].w); }
        const float rstd = 1.0f / sqrtf(wave_sum(s) * (1.f / DM) + EPS);
        unsigned long long* o8 = (unsigned long long*)(XN + (size_t)m * DM) + lane;
#pragma unroll
        for (int j = 0; j < 4; ++j) { const f32x4 y = v[j] * rstd * g[j]; o8[64 * j] = (unsigned long long)pk2(y.x, y.y) | ((unsigned long long)pk2(y.z, y.w) << 32); }
    }
}
__device__ __forceinline__ void final_norm(float* out, const float* gain, int gw, int NGW, int lane_in) {
    int lane = lane_in; asm volatile("" : "+v"(lane)); asm volatile("" : "+s"(gw));
    f32x4 g[4];
#pragma unroll
    for (int j = 0; j < 4; ++j) g[j] = *((const f32x4*)gain + lane + 64 * j);
    for (int m = gw; m < 2 * MH; m += NGW) {
        f32x4* xr = (f32x4*)(out + (size_t)m * DM) + lane;
        f32x4 v[4]; float s = 0.f;
#pragma unroll
        for (int j = 0; j < 4; ++j) { v[j] = xr[64 * j]; s += (v[j].x * v[j].x + v[j].y * v[j].y) + (v[j].z * v[j].z + v[j].w * v[j].w); }
        const float rstd = 1.0f / sqrtf(wave_sum(s) * (1.f / DM) + EPS);
#pragma unroll
        for (int j = 0; j < 4; ++j) xr[64 * j] = v[j] * rstd * g[j];
    }
}

__device__ __forceinline__ void rope8(float (&v)[8], int lane, int t) {
    const int sub = lane & 7;
    const float pos = (float)((sub & 4) ? (t & 63) : (t >> 6));
    const bool upper = (sub & 2) != 0;
    const int i0 = 8 * (sub & 1);
#pragma unroll
    for (int e = 0; e < 8; ++e) {
        const float partner = __shfl_xor(v[e], 2);
        const float inv = __builtin_amdgcn_exp2f(-(float)(i0 + e) * 0.8304820237218406f);
        const float ang = pos * inv, s = __sinf(ang), c = __cosf(ang);
        v[e] = v[e] * c + (upper ? partner : -partner) * s;
    }
}
__device__ __forceinline__ float sum8lanes(float s) { s += __shfl_xor(s, 1); s += __shfl_xor(s, 2); s += __shfl_xor(s, 4); return s; }
__device__ __forceinline__ void e1_rows(bf16* proj, const float* qg, const float* kg, int gw, int NGW, int lane_in) {
    int lane = lane_in; asm volatile("" : "+v"(lane)); asm volatile("" : "+s"(gw));
    float gq[8], gk[8];
#pragma unroll
    for (int e = 0; e < 8; ++e) { gq[e] = qg[8 * (lane & 7) + e]; gk[e] = kg[8 * (lane & 7) + e]; }
    for (int m = gw; m < MH; m += NGW) {
        const int t = m < MP ? (m & (SP - 1)) : (m - MP);
        bf16* row = proj + (size_t)m * PW;
        { v4u w = *(const v4u*)(row + C_AQ + 8 * lane); float v[8]; unpack8(w, v);
          float s = 0.f;
#pragma unroll
          for (int e = 0; e < 8; ++e) s += v[e] * v[e];
          const float rstd = 1.0f / sqrtf(sum8lanes(s) * (1.f / 64.f) + EPS);
#pragma unroll
          for (int e = 0; e < 8; ++e) v[e] = v[e] * rstd * gq[e];
          rope8(v, lane, t);
#pragma unroll
          for (int e = 0; e < 8; ++e) v[e] *= ATT_C2;
          *(v4u*)(row + C_AQ + 8 * lane) = pack8(v); }
        { const int l2 = lane & 15; v4u w = *(const v4u*)(row + C_AK + 8 * l2); float v[8]; unpack8(w, v);
          float s = 0.f;
#pragma unroll
          for (int e = 0; e < 8; ++e) s += v[e] * v[e];
          const float rstd = 1.0f / sqrtf(sum8lanes(s) * (1.f / 64.f) + EPS);
#pragma unroll
          for (int e = 0; e < 8; ++e) v[e] = v[e] * rstd * gk[e];
          rope8(v, lane, t);
          if (lane < 16) *(v4u*)(row + C_AK + 8 * l2) = pack8(v); }
        { const int l2 = lane & 31;
          if (lane < 32) { v4u w = *(const v4u*)(row + C_GQ + 8 * l2); float v[8]; unpack8(w, v);
#pragma unroll
              for (int e = 0; e < 8; ++e) v[e] *= 0.125f;
              *(v4u*)(row + C_GQ + 8 * l2) = pack8(v); }
          bf16* p = row + (lane < 32 ? C_RQ : C_RK) + 8 * l2;
          v4u w = *(const v4u*)p; float v[8]; unpack8(w, v);
          rope8(v, lane, t);
          const float sc = lane < 32 ? 1.0f : 0.125f;
#pragma unroll
          for (int e = 0; e < 8; ++e) v[e] *= sc;
          *(v4u*)p = pack8(v); }
    }
}

__device__ __forceinline__ float sum16lanes(float s) { s += __shfl_xor(s, 1); s += __shfl_xor(s, 2); s += __shfl_xor(s, 4); s += __shfl_xor(s, 8); return s; }
__device__ __forceinline__ void e2_rows(const bf16* proj, bf16* obuf, const float* ggain, int gw, int NGW, int lane_in) {
    int lane = lane_in; asm volatile("" : "+v"(lane)); asm volatile("" : "+s"(gw));
    float gn[8];
#pragma unroll
    for (int e = 0; e < 8; ++e) gn[e] = ggain[8 * (lane & 15) + e];
    for (int m = gw; m < MH; m += NGW) {
        const bf16* prow = proj + (size_t)m * PW; const size_t o = (size_t)m * 512 + 8 * lane;
        { float a[8], b[8], g[8]; unpack8(*(const v4u*)(obuf + 1 * OB1 + o), a); unpack8(*(const v4u*)(obuf + 3 * OB1 + o), b); unpack8(*(const v4u*)(prow + C_GG + 8 * lane), g);
          float s = 0.f;
#pragma unroll
          for (int e = 0; e < 8; ++e) { a[e] += b[e]; s += a[e] * a[e]; }
          const float rstd = 1.0f / sqrtf(sum16lanes(s) * (1.f / 128.f) + EPS);
#pragma unroll
          for (int e = 0; e < 8; ++e) a[e] = a[e] * rstd * gn[e] * (g[e] * sigmoidf_fast(g[e]));
          *(v4u*)(obuf + 1 * OB1 + o) = pack8(a); }
        { float a[8], b[8], g[8]; unpack8(*(const v4u*)(obuf + 2 * OB1 + o), a); unpack8(*(const v4u*)(obuf + 4 * OB1 + o), b); unpack8(*(const v4u*)(prow + C_RG + 8 * lane), g);
          float s = 0.f;
#pragma unroll
          for (int e = 0; e < 8; ++e) { a[e] += b[e]; s += a[e]; }
          const float mu = sum16lanes(s) * (1.f / 128.f); float q = 0.f;
#pragma unroll
          for (int e = 0; e < 8; ++e) { a[e] -= mu; q += a[e] * a[e]; }
          const float rstd = 1.0f / sqrtf(sum16lanes(q) * (1.f / 128.f) + EPS);
#pragma unroll
          for (int e = 0; e < 8; ++e) a[e] = a[e] * rstd * (g[e] * sigmoidf_fast(g[e]));
          *(v4u*)(obuf + 2 * OB1 + o) = pack8(a); }
    }
}

constexpr int SC_LD = 72;
constexpr int SC_QIN = 0, SC_KIN = 9216, SC_QB = 18432, SC_KDT = 27648, SC_SM = 36864, SC_VT = 46080, SC_TOT = 64512, SC_DEC = 66560, SC_ZS = 66816, SC_END = 70912;
template <bool GLA> __device__ __forceinline__ void scan_unit(LAS unsigned char* shm, const bf16* proj, bf16* outb, int row0, int len, int h, int dir,
                                                              const float* wg, const float* bg, float lgam) {
    int tid_ = threadIdx.x; asm volatile("" : "+v"(tid_)); const int tid = tid_, lane = tid & 63, wid = __builtin_amdgcn_readfirstlane(tid >> 6), fr = lane & 15, fq = lane >> 4;
    const int cq = (GLA ? C_GQ : C_RQ) + h * 64, ck = (GLA ? C_GK : C_RK) + h * 64, cv = (GLA ? C_GV : C_RV) + h * 128, cz = C_GA + dir * 16;
    LAS bf16* qin = (LAS bf16*)(shm + SC_QIN); LAS bf16* kin = (LAS bf16*)(shm + SC_KIN); LAS bf16* qb = (LAS bf16*)(shm + SC_QB);
    LAS bf16* kdT = (LAS bf16*)(shm + SC_KDT); LAS bf16* sm = (LAS bf16*)(shm + SC_SM); LAS bf16* vT = (LAS bf16*)(shm + SC_VT);
    LAS float* tot = (LAS float*)(shm + SC_TOT); LAS float* dec = (LAS float*)(shm + SC_DEC); LAS float* zs = (LAS float*)(shm + SC_ZS);
    const int nch = len >> 6;
    float w[16]; float bias = 0.f;
    if (GLA) {
#pragma unroll
        for (int r = 0; r < 16; ++r) w[r] = wg[r * 256 + h * 64 + lane];
        bias = bg[h * 64 + lane];
    }
    f32x4 S[4];
#pragma unroll
    for (int i = 0; i < 4; ++i) S[i] = (f32x4){0.f, 0.f, 0.f, 0.f};
    unsigned short qr[8], kr[8]; v4u vr0, vr1, zr;
    unsigned short qn[8], kn[8]; v4u vn0, vn1, zn;
#define SC_ROW(c, i) (dir == 0 ? row0 + (c) * 64 + (i) : row0 + len - 1 - ((c) * 64 + (i)))
#define SC_LOAD(c, Q, K, V0, V1, Z) do { \
        _Pragma("unroll") for (int e = 0; e < 8; ++e) { const bf16* rp = proj + (size_t)SC_ROW(c, 8 * wid + e) * PW; Q[e] = rp[cq + lane]; K[e] = rp[ck + lane]; } \
        { const bf16* rp = proj + (size_t)SC_ROW(c, lane) * PW + cv + 16 * wid; V0 = *(const v4u*)rp; V1 = *(const v4u*)(rp + 8); } \
        if (GLA) { if (tid < 128) Z = *(const v4u*)(proj + (size_t)SC_ROW(c, tid >> 1) * PW + cz + 8 * (tid & 1)); } } while (0)
    zr = (v4u){0u, 0u, 0u, 0u}; zn = zr;
    SC_LOAD(0, qr, kr, vr0, vr1, zr);
    for (int c = 0; c < nch; ++c) {
        float la[8];
        if (GLA) {
            if (tid < 128) { float z[8]; unpack8(zr, z); LAS float* zp = zs + (tid >> 1) * 16 + 8 * (tid & 1);
                *(LAS f32x4*)zp = (f32x4){z[0], z[1], z[2], z[3]}; *(LAS f32x4*)(zp + 4) = (f32x4){z[4], z[5], z[6], z[7]}; }
            __syncthreads();
#pragma unroll
            for (int e = 0; e < 8; ++e) { const LAS f32x4* zp = (const LAS f32x4*)(zs + (8 * wid + e) * 16); float a = bias;
#pragma unroll
                for (int r4 = 0; r4 < 4; ++r4) { const f32x4 zz = zp[r4]; a += zz.x * w[4 * r4] + zz.y * w[4 * r4 + 1] + zz.z * w[4 * r4 + 2] + zz.w * w[4 * r4 + 3]; }
                la[e] = (fminf(a, 0.f) - __logf(1.0f + __expf(-fabsf(a)))) * 0.0625f; }
        } else {
#pragma unroll
            for (int e = 0; e < 8; ++e) la[e] = lgam;
        }
        float p[8]; p[0] = la[0];
#pragma unroll
        for (int e = 1; e < 8; ++e) p[e] = p[e - 1] + la[e];
        tot[wid * 64 + lane] = p[7];
        __syncthreads();
        float off = 0.f, bref = 0.f, blast = 0.f;
#pragma unroll
        for (int g = 0; g < 8; ++g) { const float tg = tot[g * 64 + lane]; if (g < wid) off += tg; if (g < 4) bref += tg; blast += tg; }
        {
            unsigned kdp[4];
            float kdv[8];
#pragma unroll
            for (int e = 0; e < 8; ++e) { const float b = off + p[e], q = bf1(qr[e]), k = bf1(kr[e]); const int i = 8 * wid + e;
                qin[i * SC_LD + lane] = (bf16)f2bf(q * __expf(b - bref));
                kin[i * SC_LD + lane] = (bf16)f2bf(k * __expf(bref - b));
                qb[i * SC_LD + lane] = (bf16)f2bf(q * __expf(b));
                kdv[e] = k * __expf(blast - b); }
#pragma unroll
            for (int e = 0; e < 4; ++e) kdp[e] = pk2(kdv[2 * e], kdv[2 * e + 1]);
            *(LAS v4u*)(kdT + lane * SC_LD + 8 * wid) = (v4u){kdp[0], kdp[1], kdp[2], kdp[3]};
            if (wid == 0) dec[lane] = __expf(blast);
            const unsigned vw[8] = {vr0.x, vr0.y, vr0.z, vr0.w, vr1.x, vr1.y, vr1.z, vr1.w};
#pragma unroll
            for (int e = 0; e < 8; ++e) { vT[(16 * wid + 2 * e) * SC_LD + lane] = (bf16)(vw[e] & 0xffffu); vT[(16 * wid + 2 * e + 1) * SC_LD + lane] = (bf16)(vw[e] >> 16); }
        }
        __syncthreads();
        if (c + 1 < nch) SC_LOAD(c + 1, qn, kn, vn0, vn1, zn);
#pragma unroll
        for (int tt = 0; tt < 2; ++tt) { const int idx = 2 * wid + tt, ti = idx >> 2, tj = idx & 3;
            f32x4 a = (f32x4){0.f, 0.f, 0.f, 0.f};
            if (tj <= ti) {
#pragma unroll
                for (int ks = 0; ks < 2; ++ks) { const bf16x8 A = *(const LAS bf16x8*)(qin + (ti * 16 + fr) * SC_LD + 32 * ks + 8 * fq), B = *(const LAS bf16x8*)(kin + (tj * 16 + fr) * SC_LD + 32 * ks + 8 * fq);
                    a = __builtin_amdgcn_mfma_f32_16x16x32_bf16(A, B, a, 0, 0, 0); } }
            const int j = tj * 16 + fr;
#pragma unroll
            for (int r = 0; r < 4; ++r) { const int i = ti * 16 + 4 * fq + r; sm[i * SC_LD + j] = (bf16)f2bf(j <= i ? a[r] : 0.f); } }
        __syncthreads();
        {
            bf16x8 bv[2];
#pragma unroll
            for (int ks = 0; ks < 2; ++ks) bv[ks] = *(const LAS bf16x8*)(vT + (16 * wid + fr) * SC_LD + 32 * ks + 8 * fq);
            f32x4 o[4];
#pragma unroll
            for (int ib = 0; ib < 4; ++ib) { o[ib] = (f32x4){0.f, 0.f, 0.f, 0.f};
#pragma unroll
                for (int ks = 0; ks < 2; ++ks) { const bf16x8 A = *(const LAS bf16x8*)(sm + (ib * 16 + fr) * SC_LD + 32 * ks + 8 * fq); o[ib] = __builtin_amdgcn_mfma_f32_16x16x32_bf16(A, bv[ks], o[ib], 0, 0, 0); } }
#pragma unroll
            for (int ks = 0; ks < 2; ++ks) {
                v4u sw; sw.x = pk2(S[2 * ks][0], S[2 * ks][1]); sw.y = pk2(S[2 * ks][2], S[2 * ks][3]); sw.z = pk2(S[2 * ks + 1][0], S[2 * ks + 1][1]); sw.w = pk2(S[2 * ks + 1][2], S[2 * ks + 1][3]);
                const bf16x8 Bs = __builtin_bit_cast(bf16x8, sw);
#pragma unroll
                for (int ib = 0; ib < 4; ++ib) { const v2u lo = *(const LAS v2u*)(qb + (ib * 16 + fr) * SC_LD + 32 * ks + 4 * fq), hi = *(const LAS v2u*)(qb + (ib * 16 + fr) * SC_LD + 32 * ks + 16 + 4 * fq);
                    const bf16x8 A = __builtin_bit_cast(bf16x8, ((v4u){lo.x, lo.y, hi.x, hi.y})); o[ib] = __builtin_amdgcn_mfma_f32_16x16x32_bf16(A, Bs, o[ib], 0, 0, 0); } }
#pragma unroll
            for (int ib = 0; ib < 4; ++ib)
#pragma unroll
                for (int r = 0; r < 4; ++r) { const int i = ib * 16 + 4 * fq + r; outb[(size_t)SC_ROW(c, i) * 512 + h * 128 + 16 * wid + fr] = (bf16)f2bf(o[ib][r]); }
#pragma unroll
            for (int db = 0; db < 4; ++db) {
#pragma unroll
                for (int r = 0; r < 4; ++r) S[db][r] *= dec[db * 16 + 4 * fq + r];
#pragma unroll
                for (int ks = 0; ks < 2; ++ks) { const bf16x8 A = *(const LAS bf16x8*)(kdT + (db * 16 + fr) * SC_LD + 32 * ks + 8 * fq); S[db] = __builtin_amdgcn_mfma_f32_16x16x32_bf16(A, bv[ks], S[db], 0, 0, 0); } }
        }
#pragma unroll
        for (int e = 0; e < 8; ++e) { qr[e] = qn[e]; kr[e] = kn[e]; }
        vr0 = vn0; vr1 = vn1; zr = zn;
    }
    __syncthreads();
#undef SC_ROW
#undef SC_LOAD
}

struct Args { const float* in[16]; float* out; unsigned char* ws; };
__global__ void __launch_bounds__(NWAVES * 64, 2) hybrid_fwd(Args args) {
    extern __shared__ __attribute__((aligned(16))) unsigned char lds[];
    cg::grid_group grid = cg::this_grid();
    LAS unsigned char* L = (LAS unsigned char*)lds;
    volatile LAS unsigned* MISC = (volatile LAS unsigned*)(L + MISC_OFF);
    const int tid = threadIdx.x, lane = tid & 63, wave = __builtin_amdgcn_readfirstlane(tid >> 6);
    const int G = gridDim.x, bx = blockIdx.x;
    const int vcu = (G % 8 == 0) ? (bx % 8) * (G / 8) + bx / 8 : bx;
    const int gw = vcu * NWAVES + wave, NGW = G * NWAVES;
    unsigned char* ws = args.ws;
    unsigned* ctl = (unsigned*)(ws + WS_CTL);
    bf16* XN = (bf16*)(ws + WS_XN); bf16* PROJ = (bf16*)(ws + WS_PROJ); bf16* MERGED = (bf16*)(ws + WS_MERGED); bf16* OBUF = (bf16*)(ws + WS_OBUF);
    float* ACCF = (float*)(ws + WS_OBUF);
    float* out = args.out;

    {
        LAS float* scr = (LAS float*)(L + wave * 16384);
        for (int l = 0; l < DEPTH; ++l) {
            unsigned char* wl = ws + WS_W + (size_t)l * LW;
            const float* src[8] = {args.in[4] + (size_t)l * DM * INW, args.in[11] + (size_t)l * DM * 3 * DM, args.in[10] + (size_t)(l * 3 + 0) * 512 * DM, args.in[10] + (size_t)(l * 3 + 1) * 512 * DM,
                                   args.in[10] + (size_t)(l * 3 + 2) * 512 * DM, args.in[12] + (size_t)l * DM * DM, args.in[13] + (size_t)l * DM * FF, args.in[14] + (size_t)l * FF * DM};
            const int Ks[8] = {DM, DM, 512, 512, 512, DM, DM, FF}, Ns[8] = {INW, 3 * DM, DM, DM, DM, DM, FF, DM}, roff[8] = {0, 0, 0, DM, 2 * DM, 0, 0, 0};
            const size_t doff[8] = {OW_IN, OW_MERGE, OW_BR, OW_BR, OW_BR, OW_OUT, OW_UP, OW_DOWN};
#pragma unroll
            for (int mi = 0; mi < 8; ++mi) {
                const int nit = (Ks[mi] / 64) * (Ns[mi] / 32);
                for (int it = gw; it < nit; it += NGW) p0_transpose_item(src[mi], Ks[mi], Ns[mi], (bf16*)(wl + doff[mi]), roff[mi], scr, it, lane);
            }
            v4u* z = (v4u*)(wl + OW_IN + (size_t)INW * DM * 2);
            for (int i = gw * 64 + lane; i < (PW - INW) * DM * 2 / 16; i += NGW * 64) z[i] = (v4u){0u, 0u, 0u, 0u};
        }
    }
    grid.sync();

    for (int l = 0; l < DEPTH; ++l) {
        unsigned char* wl = ws + WS_W + (size_t)l * LW;
        const bf16* Win_t = (const bf16*)(wl + OW_IN); const bf16* Wmerge_t = (const bf16*)(wl + OW_MERGE); const bf16* Wbr_t = (const bf16*)(wl + OW_BR);
        const bf16* Wout_t = (const bf16*)(wl + OW_OUT); const bf16* Wup_t = (const bf16*)(wl + OW_UP); const bf16* Wdown_t = (const bf16*)(wl + OW_DOWN);
        for (int hf = 0; hf < 2; ++hf) {
            float* op = out + (size_t)hf * MP * DM; float* os = out + (size_t)(2 * MP + hf * SS) * DM;
            const float* xp = l == 0 ? args.in[0] + (size_t)hf * MP * DM : op; const float* xs = l == 0 ? args.in[1] + (size_t)hf * SS * DM : os;
            norm_rows(xp, xs, args.in[2] + l * DM, XN, gw, NGW, lane);
            grid.sync();
            { pg8::Gemm g{XN, Win_t, MH, PW, DM, 1 << 30, 0}; pg8::StaticOrder S; S.init(MH, PW, G, bx);
              pg8::EpiBf16<0> E{PROJ, PW, 0, 0};
              pg8::gemm_phase<pg8::EpiBf16<0>, pg8::StaticOrder, true, true>(L, g, S, E); }
            grid.sync();
            e1_rows(PROJ, args.in[5] + l * 64, args.in[6] + l * 64, gw, NGW, lane);
            grid.sync();
            {
                unsigned* qctr = ctl + 64 * (1 + l * 2 + hf);
                for (;;) {
                    if (tid == 0) MISC[0] = atomicAdd(qctr, 1u);
                    __syncthreads();
                    const int u = (int)MISC[0];
                    __syncthreads();
                    if (u >= 912) break;
                    if (u < 144) {
                        int row0, len, r;
                        if (u < 16) { row0 = MP; len = SS; r = u; } else { const int s2 = u - 16; row0 = (s2 >> 4) * SP; len = SP; r = s2 & 15; }
                        const int mixer = r >> 3, h = (r >> 1) & 3, dir = r & 1;
                        if (mixer == 0) scan_unit<true>(L, PROJ, OBUF + (size_t)(1 + 2 * dir) * OB1, row0, len, h, dir, args.in[7] + (size_t)(l * 2 + dir) * 16 * 256, args.in[8] + (size_t)(l * 2 + dir) * 256, 0.f);
                        else { const int hh = dir == 0 ? h : 3 - h; const float lg = __logf(1.0f - __builtin_amdgcn_exp2f(-5.0f - (float)hh));
                               scan_unit<false>(L, PROJ, OBUF + (size_t)(2 + 2 * dir) * OB1, row0, len, h, dir, nullptr, nullptr, lg); }
                    } else {
                        const int au = u - 144; int row0, nt, hk, qb, hq;
                        if (au < 256) { row0 = MP; nt = SS / 64; hk = au >> 7; qb = (au >> 2) & 31; hq = au & 3; }
                        else { const int a2 = au - 256, r = a2 & 63; row0 = (a2 >> 6) * SP; nt = SP / 64; hk = r >> 5; qb = (r >> 2) & 7; hq = r & 3; }
                        const int h = hk * 4 + hq;
                        const attn_body::bf16* P = (const attn_body::bf16*)PROJ;
                        attn_body::attn_unit<8>(P + (size_t)(row0 + qb * 256) * PW + C_AQ + h * 64, P + (size_t)row0 * PW + C_AK + hk * 64, P + (size_t)row0 * PW + C_AV + hk * 64,
                                                (attn_body::bf16*)OBUF + (size_t)(row0 + qb * 256) * 512 + h * 64, nt, (char*)lds);
                    }
                }
            }
            grid.sync();
            e2_rows(PROJ, OBUF, args.in[9] + l * 128, gw, NGW, lane);
            grid.sync();
            { pg8::Gemm g{OBUF, Wbr_t, MH, 3 * DM, 512, 4, OB1 * 2}; pg8::StaticOrder S; S.init(MH, 3 * DM, G, bx);
              pg8::EpiBf16<0> E{PROJ, DM, DM, (size_t)MH * DM};
              pg8::gemm_phase<pg8::EpiBf16<0>, pg8::StaticOrder, true, true>(L, g, S, E); }
            grid.sync();
            { pg8::Gemm g{XN, Wmerge_t, MH, 3 * DM, DM, 1 << 30, 0}; pg8::MergeOrder S; S.init(MH, G, bx);
              pg8::EpiMerge E{PROJ, (size_t)MH * DM, ACCF, MERGED};
              pg8::gemm_phase<pg8::EpiMerge, pg8::MergeOrder, true, true>(L, g, S, E); }
            grid.sync();
            { pg8::Gemm g{MERGED, Wout_t, MH, DM, DM, 1 << 30, 0}; pg8::StaticOrder S; S.init(MH, DM, G, bx);
              pg8::EpiRes E{xp, xs, op, os};
              pg8::gemm_phase<pg8::EpiRes, pg8::StaticOrder, true, true>(L, g, S, E); }
            grid.sync();
            norm_rows(op, os, args.in[3] + l * DM, XN, gw, NGW, lane);
            grid.sync();
            { pg8::Gemm g{XN, Wup_t, MH, FF, DM, 1 << 30, 0}; pg8::StaticOrder S; S.init(MH, FF, G, bx);
              pg8::EpiBf16<2> E{PROJ, FF, 0, 0};
              pg8::gemm_phase<pg8::EpiBf16<2>, pg8::StaticOrder, true, true>(L, g, S, E); }
            grid.sync();
            { pg8::Gemm g{PROJ, Wdown_t, MH, DM, FF, 1 << 30, 0}; pg8::StaticOrder S; S.init(MH, DM, G, bx);
              pg8::EpiRes E{op, os, op, os};
              pg8::gemm_phase<pg8::EpiRes, pg8::StaticOrder, true, true>(L, g, S, E); }
            grid.sync();
        }
    }
    final_norm(out, args.in[15], gw, NGW, lane);
}

extern "C" void kernel_launch(void* const* d_in, const int* in_sizes, int n_in, void* d_out, int out_size, void* d_ws, size_t ws_size, hipStream_t stream) {
    static int grid = 0;
    if (grid == 0) {
        if (n_in != 16 || out_size != 2 * MH * DM || ws_size < WS_END) { fprintf(stderr, "kernel_launch: unexpected shapes (n_in %d, out %d, ws %zu)\n", n_in, out_size, ws_size); grid = -1; return; }
        int dev = 0, cus = 0, per_cu = 0;
        if (hipGetDevice(&dev) != hipSuccess || hipDeviceGetAttribute(&cus, hipDeviceAttributeMultiprocessorCount, dev) != hipSuccess) { grid = -1; return; }
        if (hipFuncSetAttribute((const void*)hybrid_fwd, hipFuncAttributeMaxDynamicSharedMemorySize, LDS_BYTES) != hipSuccess) { fprintf(stderr, "kernel_launch: hipFuncSetAttribute failed\n"); grid = -1; return; }
        if (hipOccupancyMaxActiveBlocksPerMultiprocessor(&per_cu, (const void*)hybrid_fwd, NWAVES * 64, LDS_BYTES) != hipSuccess || per_cu < 1) { fprintf(stderr, "kernel_launch: occupancy query says %d\n", per_cu); per_cu = 1; }
        (void)hipGetLastError();
        grid = cus;
    }
    if (grid < 0) return;
    if (hipMemsetAsync((char*)d_ws + WS_CTL, 0, CTL_ZERO_BYTES, stream) != hipSuccess) { fprintf(stderr, "kernel_launch: memset failed\n"); return; }
    Args a{};
    for (int i = 0; i < 16; ++i) a.in[i] = (const float*)d_in[i];
    a.out = (float*)d_out; a.ws = (unsigned char*)d_ws;
    void* kargs[] = {&a};
    const hipError_t le = hipLaunchCooperativeKernel((const void*)hybrid_fwd, dim3(grid), dim3(NWAVES * 64), kargs, LDS_BYTES, stream);
    if (le != hipSuccess) fprintf(stderr, "kernel_launch: cooperative launch failed: %s (grid %d)\n", hipGetErrorName(le), grid);
}
```

```cpp
#include <hip/hip_runtime.h>
#include <hip/hip_cooperative_groups.h>
#include <cstdio>
#include <cstdint>
namespace cg = cooperative_groups;
namespace pg8 {
#define PG8_LAS __attribute__((address_space(3)))
typedef unsigned short bf16_t;
typedef short bf16x8 __attribute__((ext_vector_type(8)));
typedef float f32x4 __attribute__((ext_vector_type(4)));
typedef unsigned u32x4 __attribute__((ext_vector_type(4)));
constexpr int BM = 256, BK = 64, HALF = 128, HTB = HALF * BK * 2  , STAGE_BYTES = 8 * HTB, NXCD = 8, WGM = 8;

__host__ __device__ __forceinline__ int lds_byte(int r, int c) { const int st = (r >> 4) * 2 + (c >> 5), rr = r & 15, cc = c & 31, ob = rr * 64 + cc * 2; return st * 1024 + (ob ^ (((ob >> 9) & 1) << 5)); }
__host__ __device__ __forceinline__ void stage_rc(int b, int& R, int& C) { const int st = b / 1024, sb = b % 1024, swz = sb ^ (((sb >> 9) & 1) << 5); R = (st >> 1) * 16 + swz / 64; C = (st & 1) * 32 + (swz % 64) / 2; }
__host__ __device__ __forceinline__ int perm32(int rho) { const int n = rho >> 4, i = rho & 15; return 8 * (i >> 2) + 4 * n + (i & 3); }

struct Unit { int pm, pn; };
struct Gemm { const bf16_t* A; const bf16_t* Bt; int M, N, K; int a_grp; size_t a_grp_bytes; };

struct StaticOrder {
    int nM, nN, nwg, G, c;
    __host__ __device__ void init(int M, int N, int G_, int c_) { nM = M / BM; nN = N / BM; nwg = nM * nN; G = G_; c = c_; }
    __host__ __device__ bool next(int i, Unit& u) const {
        const long L = (long)i * G + c; if (L >= nwg) return false;
        int wgid = (int)L; { const int q = nwg / NXCD, r = nwg % NXCD, xcd = wgid % NXCD, off = wgid / NXCD; wgid = (xcd < r ? xcd * (q + 1) : r * (q + 1) + (xcd - r) * q) + off; }
        const int nig = WGM * nN, gid = wgid / nig, fm = gid * WGM, gsz = (nM - fm) < WGM ? (nM - fm) : WGM;
        u.pm = fm + ((wgid % nig) % gsz); u.pn = (wgid % nig) / gsz; return true;
    }
    __device__ __forceinline__ void a_ready(const Unit&) const {}
    __device__ __forceinline__ void done(const Unit&) const {}
};

__device__ __forceinline__ unsigned cvt_pk_bf16(float lo, float hi) { unsigned r; asm volatile("v_cvt_pk_bf16_f32 %0, %1, %2" : "=v"(r) : "v"(lo), "v"(hi)); return r; }
typedef float f32x2 __attribute__((ext_vector_type(2)));
__device__ __forceinline__ float bflo(unsigned w) { return __builtin_bit_cast(float, w << 16); }
__device__ __forceinline__ float bfhi(unsigned w) { return __builtin_bit_cast(float, w & 0xffff0000u); }
template <int ACT> struct EpiBf16 {
    static constexpr bool PERM = true, AFTER_DRAIN = false;
    bf16_t* O; int ldc; int split_cols; size_t split_stride;
    __device__ __forceinline__ void operator()(const f32x4 (&acc)[2][2][4][2], const Unit& u, int wr, int wc, int fr, int fq) const {
        const int row0 = u.pm * BM + wr * 64 + fr; int colt = u.pn * BM; bf16_t* base = O;
        if (split_cols) { const int t = colt / split_cols; base += (size_t)t * split_stride; colt -= t * split_cols; }
        const int col0 = colt + wc * 32 + 8 * fq;
#pragma unroll
        for (int ai = 0; ai < 2; ++ai)
#pragma unroll
            for (int m = 0; m < 4; ++m) { bf16_t* rowp = base + (size_t)(row0 + ai * HALF + m * 16) * ldc + col0;
#pragma unroll
                for (int bj = 0; bj < 2; ++bj) { f32x4 v0 = acc[ai][bj][m][0], v1 = acc[ai][bj][m][1];
                    if (ACT == 2) {
#pragma unroll
                        for (int j = 0; j < 4; ++j) { const float a = fmaxf(v0[j], 0.f), b = fmaxf(v1[j], 0.f); v0[j] = a * a; v1[j] = b * b; } }
                    u32x4 w; w.x = cvt_pk_bf16(v0[0], v0[1]); w.y = cvt_pk_bf16(v0[2], v0[3]); w.z = cvt_pk_bf16(v1[0], v1[1]); w.w = cvt_pk_bf16(v1[2], v1[3]);
                    *(u32x4*)(rowp + bj * HALF) = w; } }
    }
};
struct EpiMerge {
    static constexpr bool PERM = true, AFTER_DRAIN = false;
    const bf16_t* Y; size_t ystride; float* accf; bf16_t* merged;
    __device__ __forceinline__ void operator()(const f32x4 (&acc)[2][2][4][2], const Unit& u, int wr, int wc, int fr, int fq) const {
        const int b = u.pn >> 2, ct = u.pn & 3;
        const int row0 = u.pm * BM + wr * 64 + fr, col0 = ct * BM + wc * 32 + 8 * fq;
        const bf16_t* Yb = Y + (size_t)b * ystride;
#pragma unroll
        for (int ai = 0; ai < 2; ++ai)
#pragma unroll
            for (int m = 0; m < 4; ++m) {
#pragma unroll
                for (int bj = 0; bj < 2; ++bj) { const size_t o = (size_t)(row0 + ai * HALF + m * 16) * 1024 + col0 + bj * HALF;
                    const u32x4 yv = *(const u32x4*)(Yb + o);
                    float y[8] = {bflo(yv.x), bfhi(yv.x), bflo(yv.y), bfhi(yv.y), bflo(yv.z), bfhi(yv.z), bflo(yv.w), bfhi(yv.w)};
                    float p[8];
#pragma unroll
                    for (int j = 0; j < 8; ++j) { const float a = j < 4 ? acc[ai][bj][m][0][j & 3] : acc[ai][bj][m][1][j & 3];
                        const float g = __builtin_amdgcn_rcpf(1.0f + __builtin_amdgcn_exp2f(-1.4426950408889634f * a)); p[j] = g * y[j]; }
                    if (b > 0) { const f32x4 c0 = *(const f32x4*)(accf + o), c1 = *(const f32x4*)(accf + o + 4);
#pragma unroll
                        for (int j = 0; j < 4; ++j) { p[j] += c0[j]; p[4 + j] += c1[j]; } }
                    if (b < 2) { *(f32x4*)(accf + o) = (f32x4){p[0], p[1], p[2], p[3]}; *(f32x4*)(accf + o + 4) = (f32x4){p[4], p[5], p[6], p[7]}; }
                    else { u32x4 w; w.x = cvt_pk_bf16(p[0], p[1]); w.y = cvt_pk_bf16(p[2], p[3]); w.z = cvt_pk_bf16(p[4], p[5]); w.w = cvt_pk_bf16(p[6], p[7]); *(u32x4*)(merged + o) = w; } } }
    }
};
struct EpiRes {
    static constexpr bool PERM = false, AFTER_DRAIN = false;
    const float* base_p; const float* base_s; float* out_p; float* out_s;
    __device__ __forceinline__ void operator()(const f32x4 (&acc)[2][2][4][2], const Unit& u, int wr, int wc, int fr, int fq) const {
        const bool smp = u.pm >= 64; const float* bs = smp ? base_s : base_p; float* ot = smp ? out_s : out_p;
        const int r0 = (smp ? u.pm - 64 : u.pm) * BM + wr * 64 + fr, col0 = u.pn * BM + wc * 32 + 4 * fq;
#pragma unroll
        for (int ai = 0; ai < 2; ++ai)
#pragma unroll
            for (int m = 0; m < 4; ++m) { const size_t off = (size_t)(r0 + ai * HALF + m * 16) * 1024 + col0;
#pragma unroll
                for (int bj = 0; bj < 2; ++bj)
#pragma unroll
                    for (int n = 0; n < 2; ++n) { const size_t o = off + bj * HALF + n * 16; const f32x4 v = *(const f32x4*)(bs + o) + acc[ai][bj][m][n]; *(f32x4*)(ot + o) = v; } }
    }
};
struct MergeOrder {
    int nM, nwg, G, c;
    __host__ __device__ void init(int M, int G_, int c_) { nM = M / BM; nwg = nM * 4; G = G_; c = c_; }
    __host__ __device__ bool next(int i, Unit& u) const {
        const int j = i / 3, b = i - 3 * j; const long L = (long)j * G + c; if (L >= nwg) return false;
        int wgid = (int)L; { const int q = nwg / NXCD, r = nwg % NXCD, xcd = wgid % NXCD, off = wgid / NXCD; wgid = (xcd < r ? xcd * (q + 1) : r * (q + 1) + (xcd - r) * q) + off; }
        const int nN = 4, nig = WGM * nN, gid = wgid / nig, fm = gid * WGM, gsz = (nM - fm) < WGM ? (nM - fm) : WGM;
        u.pm = fm + ((wgid % nig) % gsz); u.pn = b * 4 + (wgid % nig) / gsz; return true;
    }
    __device__ __forceinline__ void a_ready(const Unit&) const {}
    __device__ __forceinline__ void done(const Unit&) const {}
};
template <class Epi, class Sched, bool ALIGN_EPI = false, bool SP2 = false>
__device__ __forceinline__ void gemm_phase(PG8_LAS unsigned char* lds, const Gemm g, const Sched& S, const Epi& E) {
    int tid_ = threadIdx.x; asm volatile("" : "+v"(tid_)); const int tid = tid_, wid = __builtin_amdgcn_readfirstlane(tid >> 6), lane = tid & 63, wr = wid >> 2, wc = wid & 3, fr = lane & 15, fq = lane >> 4;
    const int K = g.K, nt = K / BK;
    unsigned voffA[2], voffB[2];
#pragma unroll
    for (int i = 0; i < 2; ++i) { int R, C; stage_rc(tid * 16 + i * 8192, R, C); const int Rb = Epi::PERM ? ((R & ~31) + perm32(R & 31)) : R;
        voffA[i] = (unsigned)(R * K + C) * 2u; voffB[i] = (unsigned)(Rb * K + C) * 2u; }
    const size_t kstep = (size_t)(BK * 2);
    const size_t hstep = (size_t)HALF * K * 2;
    const size_t tstep = 2 * hstep;
    const unsigned ldsw = (unsigned)wid * 1024u;
    const int aoff = lds_byte(wr * 64 + fr, fq * 8), boff = lds_byte(wc * 32 + fr, fq * 8);
#define PG8_SA(b, h) (((b) * 2 + (h)) * HTB)
#define PG8_SB(b, h) ((4 + (b) * 2 + (h)) * HTB)
#define PG8_STAGE(bufoff, gbase, voff) do { _Pragma("unroll") for (int _i = 0; _i < 2; ++_i) \
        __builtin_amdgcn_global_load_lds((const unsigned*)((const char*)(gbase) + (voff)[_i]), (PG8_LAS unsigned*)(lds + (bufoff) + ldsw + _i * 8192), 16, 0, 0); } while (0)
#define PG8_LDA(dst, b, h) do { _Pragma("unroll") for (int m = 0; m < 4; ++m) _Pragma("unroll") for (int k = 0; k < 2; ++k) dst[m][k] = *(const PG8_LAS bf16x8*)(lds + PG8_SA(b, h) + aoff + m * 2048 + k * 1024); } while (0)
#define PG8_LDB(dst, b, h) do { _Pragma("unroll") for (int n = 0; n < 2; ++n) _Pragma("unroll") for (int k = 0; k < 2; ++k) dst[n][k] = *(const PG8_LAS bf16x8*)(lds + PG8_SB(b, h) + boff + n * 2048 + k * 1024); } while (0)
#define PG8_MMA(ai, bj, At, Bt) do { __builtin_amdgcn_s_setprio(1); _Pragma("unroll") for (int m = 0; m < 4; ++m) _Pragma("unroll") for (int n = 0; n < 2; ++n) _Pragma("unroll") for (int k = 0; k < 2; ++k) \
        acc[ai][bj][m][n] = __builtin_amdgcn_mfma_f32_16x16x32_bf16(Bt[n][k], At[m][k], acc[ai][bj][m][n], 0, 0, 0); __builtin_amdgcn_s_setprio(0); } while (0)
#define PG8_WAIT_V(n) asm volatile("s_waitcnt vmcnt(" #n ")" ::: "memory")
#define PG8_WAIT_L(n) asm volatile("s_waitcnt lgkmcnt(" #n ")" ::: "memory")
#define PG8_BAR __builtin_amdgcn_s_barrier()
#define PG8_SCHED __builtin_amdgcn_sched_barrier(0)
    Unit cur, nxt; int ui = 0;
    if (!S.next(0, cur)) return;
    f32x4 acc[2][2][4][2];
#pragma unroll
    for (int a = 0; a < 2; ++a)
#pragma unroll
        for (int b = 0; b < 2; ++b)
#pragma unroll
            for (int m = 0; m < 4; ++m)
#pragma unroll
                for (int n = 0; n < 2; ++n) acc[a][b][m][n] = (f32x4){0.f, 0.f, 0.f, 0.f};
    bf16x8 At[4][2], B0[2][2], B1[2][2];
    const char* cA = (const char*)g.A + (size_t)(cur.pn / g.a_grp) * g.a_grp_bytes + (size_t)cur.pm * tstep; const char* cB = (const char*)g.Bt + (size_t)cur.pn * tstep;
    S.a_ready(cur);
    if constexpr (SP2) {
        PG8_STAGE(PG8_SB(0, 0), cB, voffB); PG8_STAGE(PG8_SB(0, 1), cB + hstep, voffB); PG8_STAGE(PG8_SA(0, 0), cA, voffA); PG8_STAGE(PG8_SA(0, 1), cA + hstep, voffA);
        if (wr == 1) PG8_BAR;
        PG8_WAIT_V(2); PG8_BAR;
        PG8_STAGE(PG8_SB(1, 0), cB + kstep, voffB); PG8_STAGE(PG8_SA(1, 0), cA + kstep, voffA); PG8_STAGE(PG8_SB(1, 1), cB + hstep + kstep, voffB);
        PG8_WAIT_V(6); PG8_BAR;
    } else {
        PG8_STAGE(PG8_SB(0, 0), cB, voffB); PG8_STAGE(PG8_SA(0, 0), cA, voffA); PG8_STAGE(PG8_SB(0, 1), cB + hstep, voffB); PG8_STAGE(PG8_SA(0, 1), cA + hstep, voffA);
        if (wr == 1) PG8_BAR;
        PG8_WAIT_V(4); PG8_BAR;
        PG8_STAGE(PG8_SB(1, 0), cB + kstep, voffB); PG8_STAGE(PG8_SA(1, 0), cA + kstep, voffA); PG8_STAGE(PG8_SB(1, 1), cB + hstep + kstep, voffB);
        PG8_WAIT_V(6); PG8_BAR;
    }
    for (;;) {
        const bool has_next = S.next(ui + 1, nxt);
        const char* nA = has_next ? (const char*)g.A + (size_t)(nxt.pn / g.a_grp) * g.a_grp_bytes + (size_t)nxt.pm * tstep : cA; const char* nB = has_next ? (const char*)g.Bt + (size_t)nxt.pn * tstep : cB;
        for (int t = 0; t < nt; t += 2) {
            const bool last = (t == nt - 2);
            const char* a1 = cA + (size_t)(t + 1) * kstep;
            const char* a2 = last ? nA : cA + (size_t)(t + 2) * kstep; const char* b2 = last ? nB : cB + (size_t)(t + 2) * kstep;
            const char* a3 = a2 + kstep; const char* b3 = b2 + kstep;
            if (last && has_next) S.a_ready(nxt);
            if constexpr (SP2) {
            PG8_LDB(B0, 0, 0); PG8_LDB(B1, 0, 1); PG8_SCHED; PG8_LDA(At, 0, 0); PG8_STAGE(PG8_SA(1, 1), a1 + hstep, voffA);
            PG8_WAIT_V(8); PG8_WAIT_L(0); PG8_BAR; PG8_MMA(0, 0, At, B0); PG8_MMA(0, 1, At, B1); PG8_BAR; PG8_SCHED;
            PG8_LDA(At, 0, 1); PG8_STAGE(PG8_SB(0, 0), b2, voffB); PG8_STAGE(PG8_SB(0, 1), b2 + hstep, voffB); PG8_STAGE(PG8_SA(0, 0), a2, voffA);
            PG8_WAIT_V(8); PG8_WAIT_L(0); PG8_BAR; PG8_MMA(1, 0, At, B0); PG8_MMA(1, 1, At, B1); PG8_BAR; PG8_SCHED;
            PG8_LDB(B0, 1, 0); PG8_LDB(B1, 1, 1); PG8_SCHED; PG8_LDA(At, 1, 0); PG8_STAGE(PG8_SA(0, 1), a2 + hstep, voffA);
            PG8_WAIT_V(8); PG8_WAIT_L(0); PG8_BAR; PG8_MMA(0, 0, At, B0); PG8_MMA(0, 1, At, B1); PG8_BAR; PG8_SCHED;
            PG8_LDA(At, 1, 1); PG8_STAGE(PG8_SB(1, 0), b3, voffB); PG8_STAGE(PG8_SB(1, 1), b3 + hstep, voffB); PG8_STAGE(PG8_SA(1, 0), a3, voffA);
            PG8_WAIT_V(8); PG8_WAIT_L(0); PG8_BAR; PG8_MMA(1, 0, At, B0); PG8_MMA(1, 1, At, B1); PG8_BAR; PG8_SCHED;
            } else {
            PG8_LDB(B0, 0, 0); PG8_SCHED; PG8_LDA(At, 0, 0); PG8_STAGE(PG8_SA(1, 1), a1 + hstep, voffA);
            PG8_WAIT_L(8); PG8_BAR; PG8_WAIT_L(0); PG8_MMA(0, 0, At, B0); PG8_BAR; PG8_SCHED;
            PG8_LDB(B1, 0, 1); PG8_STAGE(PG8_SB(0, 0), b2, voffB);
            PG8_BAR; PG8_WAIT_L(0); PG8_MMA(0, 1, At, B1); PG8_BAR;
            PG8_LDA(At, 0, 1); PG8_STAGE(PG8_SA(0, 0), a2, voffA);
            PG8_BAR; PG8_WAIT_L(0); PG8_MMA(1, 0, At, B0); PG8_BAR; PG8_SCHED;
            PG8_STAGE(PG8_SB(0, 1), b2 + hstep, voffB);
            PG8_WAIT_V(6); PG8_BAR; PG8_MMA(1, 1, At, B1); PG8_BAR;
            PG8_LDB(B0, 1, 0); PG8_SCHED; PG8_LDA(At, 1, 0); PG8_STAGE(PG8_SA(0, 1), a2 + hstep, voffA);
            PG8_WAIT_L(8); PG8_BAR; PG8_WAIT_L(0); PG8_MMA(0, 0, At, B0); PG8_BAR; PG8_SCHED;
            PG8_LDB(B1, 1, 1); PG8_STAGE(PG8_SB(1, 0), b3, voffB);
            PG8_BAR; PG8_WAIT_L(0); PG8_MMA(0, 1, At, B1); PG8_BAR;
            PG8_LDA(At, 1, 1); PG8_STAGE(PG8_SA(1, 0), a3, voffA);
            PG8_BAR; PG8_WAIT_L(0); PG8_MMA(1, 0, At, B0); PG8_BAR; PG8_SCHED;
            PG8_STAGE(PG8_SB(1, 1), b3 + hstep, voffB);
            PG8_WAIT_V(6); PG8_BAR; PG8_MMA(1, 1, At, B1); PG8_BAR;
            }
        }
        if constexpr (ALIGN_EPI) { if (wr == 0) PG8_BAR; }
        if constexpr (!Epi::AFTER_DRAIN) { E(acc, cur, wr, wc, fr, fq); S.done(cur); }
        if (!has_next) break;
#pragma unroll
        for (int a = 0; a < 2; ++a)
#pragma unroll
            for (int b = 0; b < 2; ++b)
#pragma unroll
                for (int m = 0; m < 4; ++m)
#pragma unroll
                    for (int n = 0; n < 2; ++n) acc[a][b][m][n] = (f32x4){0.f, 0.f, 0.f, 0.f};
        cur = nxt; cA = nA; cB = nB; ++ui;
        if constexpr (ALIGN_EPI) { if (wr == 1) PG8_BAR; }
    }
    PG8_WAIT_V(0);
    if constexpr (!ALIGN_EPI) { if (wr == 0) PG8_BAR; }
    PG8_BAR;
    if constexpr (Epi::AFTER_DRAIN) { E.fused(acc, cur, wr, wc, fr, fq, lds, wid, lane); S.done(cur); }
#undef PG8_SA
#undef PG8_SB
#undef PG8_STAGE
#undef PG8_LDA
#undef PG8_LDB
#undef PG8_MMA
#undef PG8_WAIT_V
#undef PG8_WAIT_L
#undef PG8_BAR
#undef PG8_SCHED
}
}
#include <hip/hip_bf16.h>
#include <cmath>
namespace attn_body {
using bf16=__hip_bfloat16;
using bf16x8=__attribute__((ext_vector_type(8)))short;
using s16x4=__attribute__((ext_vector_type(4)))short;
using f32x16=__attribute__((ext_vector_type(16)))float;
using u32x4=__attribute__((ext_vector_type(4)))unsigned;
constexpr int D=64,PQ=4096,PO=512;
constexpr int NW=8,QBLK=32,QB=QBLK*NW,KVBLK=64;
__device__ __forceinline__ int crow(int r,int hi){return (r&3)+8*(r>>2)+4*hi;}
#define SBAR() __builtin_amdgcn_sched_barrier(0)
constexpr int NSLOT=3, SLOTB=8192;
constexpr int LDS_K=0, LDS_V=NSLOT*SLOTB, LDS_WS=2*NSLOT*SLOTB, LDS_OST=LDS_WS+NW*64*4, LDS_BYTES=LDS_OST+NW*4096;
constexpr float C2=0.125f*1.4426950408889634f;
__device__ __forceinline__ void glds16(const void*gsrc,unsigned lds_dst){unsigned keep;
  asm volatile("s_mov_b32 %0, m0\n\ts_mov_b32 m0, %2\n\ts_nop 0\n\tglobal_load_lds_dwordx4 %1, off\n\ts_mov_b32 m0, %0":"=&s"(keep):"v"(gsrc),"s"(lds_dst):"memory");}
__device__ __forceinline__ float max3f(float a,float b,float c){float r;asm("v_max3_f32 %0, %1, %2, %3":"=v"(r):"v"(a),"v"(b),"v"(c));return r;}
__device__ __forceinline__ float max2f(float a,float b){float r;asm("v_max_f32_e32 %0, %1, %2":"=v"(r):"v"(a),"v"(b));return r;}
__device__ __forceinline__ float fadd_s(float a,float b){float r;asm("v_add_f32_e32 %0, %1, %2":"=v"(r):"v"(a),"v"(b));return r;}
__device__ __forceinline__ float fsub_s(float a,float b){float r;asm("v_sub_f32_e32 %0, %1, %2":"=v"(r):"v"(a),"v"(b));return r;}
typedef float f32x2_t __attribute__((ext_vector_type(2))); typedef __bf16 bf16x2_t __attribute__((ext_vector_type(2)));
__device__ __forceinline__ unsigned cvtpk_s(float lo,float hi){f32x2_t v={lo,hi};bf16x2_t b=__builtin_convertvector(v,bf16x2_t);return __builtin_bit_cast(unsigned,b);}
#define WAIT_BAR(N) asm volatile("s_waitcnt vmcnt(" #N ") lgkmcnt(0)\n\ts_barrier":::"memory")

__device__ __forceinline__ void qkt(f32x16&p0,f32x16&p1,const char*Kslot,const bf16x8*qr,const f32x16&negm,int r32,int hi){
  const char*kb=Kslot+hi*1024+r32*16;
  #pragma unroll
  for(int d0=0;d0<4;++d0){
    const bf16x8 b0=*reinterpret_cast<const bf16x8*>(kb+d0*2048);
    const bf16x8 b1=*reinterpret_cast<const bf16x8*>(kb+d0*2048+512);
    if(d0==0){p0=__builtin_amdgcn_mfma_f32_32x32x16_bf16(b0,qr[0],negm,0,0,0);p1=__builtin_amdgcn_mfma_f32_32x32x16_bf16(b1,qr[0],negm,0,0,0);}
    else{p0=__builtin_amdgcn_mfma_f32_32x32x16_bf16(b0,qr[d0],p0,0,0,0);p1=__builtin_amdgcn_mfma_f32_32x32x16_bf16(b1,qr[d0],p1,0,0,0);}}
}
typedef __attribute__((address_space(3))) const char* lds_cptr;
typedef short v4i16_t __attribute__((ext_vector_type(4)));
__device__ __forceinline__ void kload8(bf16x8*kf,lds_cptr kp){
  kf[0]=*(const __attribute__((address_space(3))) bf16x8*)(kp);      kf[1]=*(const __attribute__((address_space(3))) bf16x8*)(kp+512);
  kf[2]=*(const __attribute__((address_space(3))) bf16x8*)(kp+2048); kf[3]=*(const __attribute__((address_space(3))) bf16x8*)(kp+2560);
  kf[4]=*(const __attribute__((address_space(3))) bf16x8*)(kp+4096); kf[5]=*(const __attribute__((address_space(3))) bf16x8*)(kp+4608);
  kf[6]=*(const __attribute__((address_space(3))) bf16x8*)(kp+6144); kf[7]=*(const __attribute__((address_space(3))) bf16x8*)(kp+6656);
}
__device__ __forceinline__ void kload2(bf16x8*kf,lds_cptr kp,int j){ kf[2*j]=*(const __attribute__((address_space(3))) bf16x8*)(kp+j*2048); kf[2*j+1]=*(const __attribute__((address_space(3))) bf16x8*)(kp+j*2048+512); }
__device__ __forceinline__ s16x4 vtr(lds_cptr p){ return __builtin_bit_cast(s16x4,__builtin_amdgcn_ds_read_tr16_b64_v4i16((__attribute__((address_space(3))) v4i16_t*)p)); }
__device__ __forceinline__ float rowmax(const f32x16&p0,const f32x16&p1){
  float a=max3f(p0[0],p0[1],p1[0]),b=max3f(p0[2],p0[3],p1[1]);a=max3f(a,p1[2],p1[3]);
  #pragma unroll
  for(int r=4;r<16;r+=4){a=max3f(a,p0[r],p0[r+1]);b=max3f(b,p0[r+2],p0[r+3]);a=max3f(a,p1[r],p1[r+1]);b=max3f(b,p1[r+2],p1[r+3]);}
  const float m=max2f(a,b);
  auto rr=__builtin_amdgcn_permlane32_swap(__float_as_uint(m),__float_as_uint(m),false,false);
  return max2f(__uint_as_float(rr[0]),__uint_as_float(rr[1]));
}
__device__ __forceinline__ void pv(f32x16*o,int vb,bf16x8 pa0,bf16x8 pa1,bf16x8 pa2,bf16x8 pa3){
  #pragma unroll
  for(int d0=0;d0<2;++d0){s16x4 lo[4],hi[4];
    #pragma unroll
    for(int ks=0;ks<4;++ks){
      asm volatile("ds_read_b64_tr_b16 %0,%1 offset:%c2":"=&v"(lo[ks]):"v"(vb),"i"(d0*4096+ks*1024):"memory");
      asm volatile("ds_read_b64_tr_b16 %0,%1 offset:%c2":"=&v"(hi[ks]):"v"(vb),"i"(d0*4096+ks*1024+512):"memory");}
    asm volatile("s_waitcnt lgkmcnt(0)":::"memory");SBAR();
    #define PK(k) (bf16x8){lo[k][0],lo[k][1],lo[k][2],lo[k][3],hi[k][0],hi[k][1],hi[k][2],hi[k][3]}
    o[d0]=__builtin_amdgcn_mfma_f32_32x32x16_bf16(pa0,PK(0),o[d0],0,0,0);
    o[d0]=__builtin_amdgcn_mfma_f32_32x32x16_bf16(pa1,PK(1),o[d0],0,0,0);
    o[d0]=__builtin_amdgcn_mfma_f32_32x32x16_bf16(pa2,PK(2),o[d0],0,0,0);
    o[d0]=__builtin_amdgcn_mfma_f32_32x32x16_bf16(pa3,PK(3),o[d0],0,0,0);
    #undef PK
  }
}

#ifndef ATTN_STORE16
#define ATTN_STORE16(p,v) (*(u32x4*)(p)=(v))
#endif
template<int THRL> __device__ __forceinline__ void attn_unit(const bf16*Qu,const bf16*__restrict__ Kh,const bf16*__restrict__ Vh,bf16*Ou,const int NT,char*shm){
  int tid_=threadIdx.x; asm volatile("":"+v"(tid_)); const int tid=tid_,lane=tid&63,r32=lane&31,hi=lane>>5; const int wid=__builtin_amdgcn_readfirstlane(tid>>6);
  const bf16*Qw=Qu+(long)(wid*QBLK)*PQ;
  const unsigned lds0=(unsigned)(uintptr_t)shm;
  float*wsf=(float*)(shm+LDS_WS)+wid*64;
  const bf16*ksrc=Kh+(long)lane*PQ+wid*8;
  const bf16*vsrc=Vh+(long)(16*(wid&3)+(lane>>2))*PQ+(wid>>2)*32+(lane&3)*8;
  const unsigned kdst=lds0+LDS_K+wid*1024, vdst=lds0+LDS_V+wid*1024;
  #define DMA_K(t,slot) glds16(ksrc+(long)(t)*KVBLK*PQ,(unsigned)__builtin_amdgcn_readfirstlane(kdst+(slot)))
  #define DMA_V(t,slot) glds16(vsrc+(long)(t)*KVBLK*PQ,(unsigned)__builtin_amdgcn_readfirstlane(vdst+(slot)))
  const int vb0=(int)(lds0+LDS_V)+((lane>>4)&1)*32+(lane&3)*8+(4*hi+((lane&15)>>2))*64;
  const char*Kbase=shm+LDS_K; bf16x8 kf[8];
  const lds_cptr shm3=(lds_cptr)shm; const lds_cptr kp0=shm3+LDS_K+hi*1024+r32*16; const lds_cptr vp0=shm3+LDS_V+((lane>>4)&1)*32+(lane&3)*8+(4*hi+((lane&15)>>2))*64;
  DMA_K(0,0);DMA_V(0,0);DMA_K(1,SLOTB);
  bf16x8 qr[4];
  #pragma unroll
  for(int d0=0;d0<4;++d0)qr[d0]=*reinterpret_cast<const bf16x8*>(&Qw[(long)r32*PQ+d0*16+hi*8]);
  float mhat=0.f,l_reg=0.f;f32x16 o[2];o[0]=f32x16{};o[1]=f32x16{};f32x16 negm=f32x16{};asm volatile("":"+v"(negm));
  #define CMASK(P0,P1,t) do{}while(0)
  bool resc=false;
  #define START(P0,P1) do{ const float rm=rowmax(P0,P1); resc=false; \
    { const float dl=rm; mhat=fadd_s(mhat,dl); \
      _Pragma("unroll") for(int r=0;r<16;++r){P0[r]=fsub_s(P0[r],dl);P1[r]=fsub_s(P1[r],dl);} \
      _Pragma("unroll") for(int r=0;r<16;++r)negm[r]=-mhat; asm volatile("":"+v"(negm)); } \
    _Pragma("unroll") for(int r=0;r<16;++r)P0[r]=__builtin_amdgcn_exp2f(P0[r]); }while(0)
  #define RESC() do{ if(resc){ asm volatile("s_waitcnt lgkmcnt(0)":::"memory"); \
      _Pragma("unroll") for(int d_=0;d_<2;++d_) _Pragma("unroll") for(int r=0;r<16;++r)o[d_][r]*=wsf[crow(r,hi)]; } }while(0)
  f32x16 pA0,pA1,pB0,pB1;
  int sl_prev=0,sl_cur=0,sl_next=SLOTB;
  #define ROT() do{sl_prev=sl_cur;sl_cur=sl_next;sl_next=(sl_next==(NSLOT-1)*SLOTB)?0:sl_next+SLOTB;}while(0)
  DMA_K(2,2*SLOTB);
  WAIT_BAR(3);
  qkt(pA0,pA1,Kbase,qr,negm,r32,hi);asm volatile("s_nop 15\n\ts_nop 7":"+v"(pA0),"+v"(pA1));CMASK(pA0,pA1,0);
  START(pA0,pA1);
  _Pragma("unroll") for(int r=0;r<16;++r)pA1[r]=__builtin_amdgcn_exp2f(pA1[r]);
  WAIT_BAR(0);
  DMA_K(3,0);DMA_V(1,SLOTB);
  ROT();
  kload8(kf,kp0+sl_cur);
  WAIT_BAR(2);
  s16x4 vlo[8],vhi[8]; u32x4 pw0,pw1,pw2,pw3;
  #define PKW(P,B) cvtpk_s(P[B],P[B+1])
  #define PAF(k) __builtin_bit_cast(bf16x8,pw##k)
  #define VFR(i) (bf16x8){vlo[i][0],vlo[i][1],vlo[i][2],vlo[i][3],vhi[i][0],vhi[i][1],vhi[i][2],vhi[i][3]}
  #define PIN(x) asm volatile("":"+v"(x))
  #define MX3(a,b,c) __builtin_fmaxf(__builtin_fmaxf((a),(b)),(c))
  #define GAPA(MF,A0,A1,A2,A3,W0,W1,PW) do{ MF; sacc+=A0; sacc+=A1; sacc+=A2; sacc+=A3; PIN(sacc); W0; W1; PIN(PW); SBAR(); }while(0)
  #define EX(v) __builtin_amdgcn_exp2f(v)
  #define GAPB(MF,X,B) do{ MF; X[B]=EX(X[B]); X[B+1]=EX(X[B+1]); X[B+2]=EX(X[B+2]); X[B+3]=EX(X[B+3]); PIN(X); SBAR(); }while(0)
  #define VRD(i) do{ vlo[i]=vtr(vp_+(((i)>>2)*4096+((i)&3)*1024)); vhi[i]=vtr(vp_+(((i)>>2)*4096+((i)&3)*1024+512)); }while(0)
  #define KRD(G,j) do{ if(G){ kload2(kf,kp0+sl_next,j); SBAR(); } }while(0)
  #define STEP(C0,C1,P0,P1,t,GK,GV,GL) do{ SBAR(); \
    const lds_cptr vp_=vp0+sl_prev; \
    VRD(0); SBAR(); float sacc=(P0[0]+P0[1]); \
    GAPA(C0=__builtin_amdgcn_mfma_f32_32x32x16_bf16(kf[0],qr[0],negm,0,0,0), P0[2],P0[3],P0[4],P0[5],     pw0[0]=PKW(P0,0), pw0[1]=PKW(P0,2), pw0); \
    VRD(4); SBAR(); GAPA(C1=__builtin_amdgcn_mfma_f32_32x32x16_bf16(kf[1],qr[0],negm,0,0,0), P0[6],P0[7],P0[8],P0[9],     pw0[2]=PKW(P0,4), pw0[3]=PKW(P0,6), pw0); \
    VRD(1); SBAR(); GAPA(C0=__builtin_amdgcn_mfma_f32_32x32x16_bf16(kf[2],qr[1],C0,0,0,0),   P0[10],P0[11],P0[12],P0[13], pw1[0]=PKW(P0,8), pw1[1]=PKW(P0,10), pw1); \
    VRD(5); SBAR(); GAPA(C1=__builtin_amdgcn_mfma_f32_32x32x16_bf16(kf[3],qr[1],C1,0,0,0),   P0[14],P0[15],P1[0],P1[1],   pw1[2]=PKW(P0,12),pw1[3]=PKW(P0,14), pw1); \
    VRD(2); SBAR(); GAPA(C0=__builtin_amdgcn_mfma_f32_32x32x16_bf16(kf[4],qr[2],C0,0,0,0),   P1[2],P1[3],P1[4],P1[5],     pw2[0]=PKW(P1,0), pw2[1]=PKW(P1,2), pw2); \
    VRD(6); SBAR(); GAPA(C1=__builtin_amdgcn_mfma_f32_32x32x16_bf16(kf[5],qr[2],C1,0,0,0),   P1[6],P1[7],P1[8],P1[9],     pw2[2]=PKW(P1,4), pw2[3]=PKW(P1,6), pw2); \
    VRD(3); SBAR(); GAPA(C0=__builtin_amdgcn_mfma_f32_32x32x16_bf16(kf[6],qr[3],C0,0,0,0),   P1[10],P1[11],P1[12],P1[13], pw3[0]=PKW(P1,8), pw3[1]=PKW(P1,10), pw3); \
    VRD(7); SBAR(); GAPA(C1=__builtin_amdgcn_mfma_f32_32x32x16_bf16(kf[7],qr[3],C1,0,0,0),   P1[14],P1[15],0.f,0.f,       pw3[2]=PKW(P1,12),pw3[3]=PKW(P1,14), pw3); \
    l_reg+=sacc; \
    if(GK){DMA_K((t)+3,sl_cur);} if(GV){DMA_V((t)+1,sl_next);} \
    CMASK(C0,C1,t); \
    { float a=MX3(C0[0],C0[1],C1[0]),b=MX3(C0[2],C0[3],C1[1]); a=MX3(a,C1[2],C1[3]); \
      _Pragma("unroll") for(int r=4;r<16;r+=4){a=MX3(a,C0[r],C0[r+1]);b=MX3(b,C0[r+2],C0[r+3]);a=MX3(a,C1[r],C1[r+1]);b=MX3(b,C1[r+2],C1[r+3]);} \
      float rm=__builtin_fmaxf(a,b); { auto rr=__builtin_amdgcn_permlane32_swap(__float_as_uint(rm),__float_as_uint(rm),false,false); rm=__builtin_fmaxf(__uint_as_float(rr[0]),__uint_as_float(rr[1])); } \
      resc=false; \
      if(__builtin_expect(__any(rm>(float)THRL),0)){ const float dl=__builtin_fmaxf(rm,0.f); mhat+=dl; \
        _Pragma("unroll") for(int r=0;r<16;++r){C0[r]-=dl;C1[r]-=dl;} \
        _Pragma("unroll") for(int r=0;r<16;++r)negm[r]=-mhat; asm volatile("":"+v"(negm)); \
        const float f=__builtin_amdgcn_exp2f(-dl); l_reg*=f; if(hi==0)wsf[r32]=f; resc=true; } } \
    SBAR(); \
    GAPB(o[0]=__builtin_amdgcn_mfma_f32_32x32x16_bf16(PAF(0),VFR(0),o[0],0,0,0), C0,0); \
    GAPB(o[1]=__builtin_amdgcn_mfma_f32_32x32x16_bf16(PAF(0),VFR(4),o[1],0,0,0), C0,4); \
    KRD(GL,0); GAPB(o[0]=__builtin_amdgcn_mfma_f32_32x32x16_bf16(PAF(1),VFR(1),o[0],0,0,0), C0,8); \
    KRD(GL,1); GAPB(o[1]=__builtin_amdgcn_mfma_f32_32x32x16_bf16(PAF(1),VFR(5),o[1],0,0,0), C0,12); \
    KRD(GL,2); GAPB(o[0]=__builtin_amdgcn_mfma_f32_32x32x16_bf16(PAF(2),VFR(2),o[0],0,0,0), C1,0); \
    KRD(GL,3); GAPB(o[1]=__builtin_amdgcn_mfma_f32_32x32x16_bf16(PAF(2),VFR(6),o[1],0,0,0), C1,4); \
    GAPB(o[0]=__builtin_amdgcn_mfma_f32_32x32x16_bf16(PAF(3),VFR(3),o[0],0,0,0), C1,8); \
    GAPB(o[1]=__builtin_amdgcn_mfma_f32_32x32x16_bf16(PAF(3),VFR(7),o[1],0,0,0), C1,12); \
    }while(0)
  int t=1;
  #undef CMASK
  #define CMASK(P0,P1,t) do{}while(0)
  for(;t+5<NT;t+=2){
    STEP(pB0,pB1,pA0,pA1,t,true,true,true);     WAIT_BAR(2); RESC(); ROT();
    STEP(pA0,pA1,pB0,pB1,t+1,true,true,true);   WAIT_BAR(2); RESC(); ROT();
  }
  #undef CMASK
  #define CMASK(P0,P1,t) do{}while(0)
  #define ENDW(tt) do{ if((tt)+3<NT){WAIT_BAR(2);} else if((tt)+2<NT){WAIT_BAR(1);} else {WAIT_BAR(0);} }while(0)
  for(;t+1<NT;t+=2){
    STEP(pB0,pB1,pA0,pA1,t,(t+3<NT),(t+1<NT),(t+1<NT));       ENDW(t);   RESC(); ROT();
    STEP(pA0,pA1,pB0,pB1,t+1,(t+4<NT),(t+2<NT),(t+2<NT));     ENDW(t+1); RESC(); ROT();
  }
  STEP(pB0,pB1,pA0,pA1,NT-1,false,false,false); RESC();
  { float sacc=pB0[0]+pB0[1]; _Pragma("unroll") for(int r=2;r<16;++r)sacc+=pB0[r]; _Pragma("unroll") for(int r=0;r<16;++r)sacc+=pB1[r]; l_reg+=sacc;
    pw0=(u32x4){PKW(pB0,0),PKW(pB0,2),PKW(pB0,4),PKW(pB0,6)};pw1=(u32x4){PKW(pB0,8),PKW(pB0,10),PKW(pB0,12),PKW(pB0,14)};pw2=(u32x4){PKW(pB1,0),PKW(pB1,2),PKW(pB1,4),PKW(pB1,6)};pw3=(u32x4){PKW(pB1,8),PKW(pB1,10),PKW(pB1,12),PKW(pB1,14)};
    SBAR(); pv(o,vb0+sl_cur,PAF(0),PAF(1),PAF(2),PAF(3)); }
  #undef PKW
  #undef PAF
  #undef VFR
  #undef PIN
  #undef MX3
  #undef GAPA
  #undef GAPB
  #undef EX
  #undef VRD
  #undef KRD
  #undef STEP
  #undef ENDW
  {auto rr=__builtin_amdgcn_permlane32_swap(__float_as_uint(l_reg),__float_as_uint(l_reg),false,false);l_reg=__uint_as_float(rr[0])+__uint_as_float(rr[1]);}
  if(hi==0)wsf[32+r32]=l_reg;asm volatile("s_waitcnt lgkmcnt(0)":::"memory");
  float rli[16];
  #pragma unroll
  for(int r=0;r<16;++r)rli[r]=__builtin_amdgcn_rcpf(wsf[32+crow(r,hi)]);
  bf16*Ow=Ou+(long)(wid*QBLK)*PO;
  { bf16*stg=(bf16*)(shm+LDS_OST)+wid*2048;
    #pragma unroll
    for(int r=0;r<16;++r){const int orow=crow(r,hi);
      #pragma unroll
      for(int d0=0;d0<2;++d0)stg[orow*64+d0*32+r32]=__float2bfloat16(o[d0][r]*rli[r]);}
    asm volatile("s_waitcnt lgkmcnt(0)":::"memory");
    #pragma unroll
    for(int i=0;i<4;++i){const int row=i*8+(lane>>3),ch=lane&7; const u32x4 v=*(const u32x4*)(stg+row*64+ch*8); ATTN_STORE16(Ow+(long)row*PO+ch*8,v);} }
  asm volatile("s_waitcnt lgkmcnt(0)\n\ts_barrier":::"memory");
  #undef DMA_K
  #undef DMA_V
  #undef CMASK
  #undef START
  #undef RESC
  #undef ROT
}
constexpr int ATTN_LDS_BYTES=LDS_BYTES;
#undef SBAR
#undef WAIT_BAR
}
#define GAS __attribute__((address_space(1)))
#define LAS __attribute__((address_space(3)))
typedef unsigned short bf16;
typedef unsigned v4u __attribute__((ext_vector_type(4)));
typedef unsigned v2u __attribute__((ext_vector_type(2)));
typedef float f32x4 __attribute__((ext_vector_type(4)));
typedef short bf16x8 __attribute__((ext_vector_type(8)));
#define LDS_WAIT() asm volatile("s_waitcnt lgkmcnt(0)" ::: "memory")

constexpr int NWAVES = 8;
constexpr int DM = 1024, FF = 4096, DEPTH = 2;
constexpr int MH = 24576, MP = 16384;
constexpr int SP = 2048, SS = 8192;
constexpr int PW = 4096, INW = 3872;
constexpr int C_AQ = 0, C_AK = 512, C_AV = 640, C_GQ = 768, C_GK = 1024, C_GV = 1280, C_GA = 1792, C_GG = 1824, C_RQ = 2336, C_RK = 2592, C_RV = 2848, C_RG = 3360;
constexpr float EPS = 1e-6f;
constexpr float ATT_C2 = 0.125f * 1.4426950408889634f;

constexpr size_t MiB = 1u << 20;
constexpr size_t WS_CTL = 0, CTL_ZERO_BYTES = 65536;
constexpr int CW_BAR = 4096;
constexpr size_t WS_W = 1 * MiB, LW = 35 * MiB;
constexpr size_t OW_IN = 0, OW_MERGE = 8 * MiB, OW_BR = 14 * MiB, OW_OUT = 17 * MiB, OW_UP = 19 * MiB, OW_DOWN = 27 * MiB;
constexpr size_t WS_XN = 71 * MiB;
constexpr size_t WS_PROJ = 119 * MiB;
constexpr size_t WS_MERGED = WS_PROJ + 144 * MiB;
constexpr size_t WS_OBUF = 311 * MiB;
constexpr size_t OB1 = (size_t)MH * 512;
constexpr size_t WS_END = 431 * MiB;

constexpr int RING_BYTES = 131072, MISC_OFF = RING_BYTES + 320, LDS_BYTES = 147456;

__device__ __forceinline__ unsigned f2bf(float f) { unsigned u = __builtin_bit_cast(unsigned, f); return (u + 0x7fffu + ((u >> 16) & 1u)) >> 16; }
__device__ __forceinline__ unsigned pk2(float lo, float hi) { return f2bf(lo) | (f2bf(hi) << 16); }
__device__ __forceinline__ float bf_lo(unsigned w) { return __builtin_bit_cast(float, w << 16); }
__device__ __forceinline__ float bf_hi(unsigned w) { return __builtin_bit_cast(float, w & 0xffff0000u); }
__device__ __forceinline__ float bf1(unsigned short h) { return __builtin_bit_cast(float, (unsigned)h << 16); }
__device__ __forceinline__ void unpack8(const v4u w, float (&v)[8]) { v[0] = bf_lo(w.x); v[1] = bf_hi(w.x); v[2] = bf_lo(w.y); v[3] = bf_hi(w.y); v[4] = bf_lo(w.z); v[5] = bf_hi(w.z); v[6] = bf_lo(w.w); v[7] = bf_hi(w.w); }
__device__ __forceinline__ v4u pack8(const float (&v)[8]) { v4u w; w.x = pk2(v[0], v[1]); w.y = pk2(v[2], v[3]); w.z = pk2(v[4], v[5]); w.w = pk2(v[6], v[7]); return w; }
__device__ __forceinline__ float wave_sum(float v) {
#pragma unroll
    for (int o = 1; o < 64; o <<= 1) v += __shfl_xor(v, o);
    return v;
}
__device__ __forceinline__ float sigmoidf_fast(float a) { return __builtin_amdgcn_rcpf(1.0f + __builtin_amdgcn_exp2f(-1.4426950408889634f * a)); }

__device__ __forceinline__ void p0_transpose_item(const float* W, int K, int N, bf16* WT, int row_off, LAS float* scr, int item, int lane) {
    const int nblk = N / 32, kb = item / nblk, nb = item % nblk, k0 = 64 * kb, n0 = 32 * nb;
#pragma unroll 8
    for (int i = 0; i < 32; ++i) { const int kk = 2 * i + (lane >> 5); scr[kk * 33 + (lane & 31)] = W[(size_t)(k0 + kk) * N + n0 + (lane & 31)]; }
    LDS_WAIT(); asm volatile("" ::: "memory");
    const int c = lane & 7;
#pragma unroll
    for (int j = 0; j < 4; ++j) { const int n = (lane >> 3) + 8 * j; const LAS float* s = scr + (8 * c) * 33 + n;
        v4u o; o.x = pk2(s[0 * 33], s[1 * 33]); o.y = pk2(s[2 * 33], s[3 * 33]); o.z = pk2(s[4 * 33], s[5 * 33]); o.w = pk2(s[6 * 33], s[7 * 33]);
        *(v4u*)(WT + (size_t)(row_off + n0 + n) * K + k0 + 8 * c) = o; }
    LDS_WAIT(); asm volatile("" ::: "memory");
}

__device__ __forceinline__ void norm_rows(const float* xp, const float* xs, const float* gain, bf16* XN, int gw, int NGW, int lane_in) {
    int lane = lane_in; asm volatile("" : "+v"(lane)); asm volatile("" : "+s"(gw));
    f32x4 g[4];
#pragma unroll
    for (int j = 0; j < 4; ++j) g[j] = *((const f32x4*)gain + lane + 64 * j);
    for (int m = gw; m < MH; m += NGW) {
        const float* xrow = m < MP ? xp + (size_t)m * DM : xs + (size_t)(m - MP) * DM;
        const f32x4* xr = (const f32x4*)xrow + lane;
        f32x4 v[4]; float s = 0.f;
#pragma unroll
        for (int j = 0; j < 4; ++j) { v[j] = xr[64 * j]; s += (v[j].x * v[j].x + v[j].y * v[j].y) + (v[j].z * v[j].z + v[j].w * v[j].w); }
        const float rstd = 1.0f / sqrtf(wave_sum(s) * (1.f / DM) + EPS);
        unsigned long long* o8 = (unsigned long long*)(XN + (size_t)m * DM) + lane;
#pragma unroll
        for (int j = 0; j < 4; ++j) { const f32x4 y = v[j] * rstd * g[j]; o8[64 * j] = (unsigned long long)pk2(y.x, y.y) | ((unsigned long long)pk2(y.z, y.w) << 32); }
    }
}
__device__ __forceinline__ void final_norm(float* out, const float* gain, int gw, int NGW, int lane_in) {
    int lane = lane_in; asm volatile("" : "+v"(lane)); asm volatile("" : "+s"(gw));
    f32x4 g[4];
#pragma unroll
    for (int j = 0; j < 4; ++j) g[j] = *((const f32x4*)gain + lane + 64 * j);
    for (int m = gw; m < 2 * MH; m += NGW) {
        f32x4* xr = (f32x4*)(out + (size_t)m * DM) + lane;
        f32x4 v[4]; float s = 0.f;
#pragma unroll
        for (int j = 0; j < 4; ++j) { v[j] = xr[64 * j]; s += (v[j].x * v[j].x + v[j].y * v[j].y) + (v[j].z * v[j].z + v[j].w * v[j].w); }
        const float rstd = 1.0f / sqrtf(wave_sum(s) * (1.f / DM) + EPS);
#pragma unroll
        for (int j = 0; j < 4; ++j) xr[64 * j] = v[j] * rstd * g[j];
    }
}

__device__ __forceinline__ void rope8(float (&v)[8], int lane, int t) {
    const int sub = lane & 7;
    const float pos = (float)((sub & 4) ? (t & 63) : (t >> 6));
    const bool upper = (sub & 2) != 0;
    const int i0 = 8 * (sub & 1);
#pragma unroll
    for (int e = 0; e < 8; ++e) {
        const float partner = __shfl_xor(v[e], 2);
        const float inv = __builtin_amdgcn_exp2f(-(float)(i0 + e) * 0.8304820237218406f);
        const float ang = pos * inv, s = __sinf(ang), c = __cosf(ang);
        v[e] = v[e] * c + (upper ? partner : -partner) * s;
    }
}
__device__ __forceinline__ float sum8lanes(float s) { s += __shfl_xor(s, 1); s += __shfl_xor(s, 2); s += __shfl_xor(s, 4); return s; }
__device__ __forceinline__ void e1_rows(bf16* proj, const float* qg, const float* kg, int gw, int NGW, int lane_in) {
    int lane = lane_in; asm volatile("" : "+v"(lane)); asm volatile("" : "+s"(gw));
    float gq[8], gk[8];
#pragma unroll
    for (int e = 0; e < 8; ++e) { gq[e] = qg[8 * (lane & 7) + e]; gk[e] = kg[8 * (lane & 7) + e]; }
    for (int m = gw; m < MH; m += NGW) {
        const int t = m < MP ? (m & (SP - 1)) : (m - MP);
        bf16* row = proj + (size_t)m * PW;
        { v4u w = *(const v4u*)(row + C_AQ + 8 * lane); float v[8]; unpack8(w, v);
          float s = 0.f;
#pragma unroll
          for (int e = 0; e < 8; ++e) s += v[e] * v[e];
          const float rstd = 1.0f / sqrtf(sum8lanes(s) * (1.f / 64.f) + EPS);
#pragma unroll
          for (int e = 0; e < 8; ++e) v[e] = v[e] * rstd * gq[e];
          rope8(v, lane, t);
#pragma unroll
          for (int e = 0; e < 8; ++e) v[e] *= ATT_C2;
          *(v4u*)(row + C_AQ + 8 * lane) = pack8(v); }
        { const int l2 = lane & 15; v4u w = *(const v4u*)(row + C_AK + 8 * l2); float v[8]; unpack8(w, v);
          float s = 0.f;
#pragma unroll
          for (int e = 0; e < 8; ++e) s += v[e] * v[e];
          const float rstd = 1.0f / sqrtf(sum8lanes(s) * (1.f / 64.f) + EPS);
#pragma unroll
          for (int e = 0; e < 8; ++e) v[e] = v[e] * rstd * gk[e];
          rope8(v, lane, t);
          if (lane < 16) *(v4u*)(row + C_AK + 8 * l2) = pack8(v); }
        { const int l2 = lane & 31;
          if (lane < 32) { v4u w = *(const v4u*)(row + C_GQ + 8 * l2); float v[8]; unpack8(w, v);
#pragma unroll
              for (int e = 0; e < 8; ++e) v[e] *= 0.125f;
              *(v4u*)(row + C_GQ + 8 * l2) = pack8(v); }
          bf16* p = row + (lane < 32 ? C_RQ : C_RK) + 8 * l2;
          v4u w = *(const v4u*)p; float v[8]; unpack8(w, v);
          rope8(v, lane, t);
          const float sc = lane < 32 ? 1.0f : 0.125f;
#pragma unroll
          for (int e = 0; e < 8; ++e) v[e] *= sc;
          *(v4u*)p = pack8(v); }
    }
}

__device__ __forceinline__ float sum16lanes(float s) { s += __shfl_xor(s, 1); s += __shfl_xor(s, 2); s += __shfl_xor(s, 4); s += __shfl_xor(s, 8); return s; }
__device__ __forceinline__ void e2_rows(const bf16* proj, bf16* obuf, const float* ggain, int gw, int NGW, int lane_in) {
    int lane = lane_in; asm volatile("" : "+v"(lane)); asm volatile("" : "+s"(gw));
    float gn[8];
#pragma unroll
    for (int e = 0; e < 8; ++e) gn[e] = ggain[8 * (lane & 15) + e];
    for (int m = gw; m < MH; m += NGW) {
        const bf16* prow = proj + (size_t)m * PW; const size_t o = (size_t)m * 512 + 8 * lane;
        { float a[8], b[8], g[8]; unpack8(*(const v4u*)(obuf + 1 * OB1 + o), a); unpack8(*(const v4u*)(obuf + 3 * OB1 + o), b); unpack8(*(const v4u*)(prow + C_GG + 8 * lane), g);
          float s = 0.f;
#pragma unroll
          for (int e = 0; e < 8; ++e) { a[e] += b[e]; s += a[e] * a[e]; }
          const float rstd = 1.0f / sqrtf(sum16lanes(s) * (1.f / 128.f) + EPS);
#pragma unroll
          for (int e = 0; e < 8; ++e) a[e] = a[e] * rstd * gn[e] * (g[e] * sigmoidf_fast(g[e]));
          *(v4u*)(obuf + 1 * OB1 + o) = pack8(a); }
        { float a[8], b[8], g[8]; unpack8(*(const v4u*)(obuf + 2 * OB1 + o), a); unpack8(*(const v4u*)(obuf + 4 * OB1 + o), b); unpack8(*(const v4u*)(prow + C_RG + 8 * lane), g);
          float s = 0.f;
#pragma unroll
          for (int e = 0; e < 8; ++e) { a[e] += b[e]; s += a[e]; }
          const float mu = sum16lanes(s) * (1.f / 128.f); float q = 0.f;
#pragma unroll
          for (int e = 0; e < 8; ++e) { a[e] -= mu; q += a[e] * a[e]; }
          const float rstd = 1.0f / sqrtf(sum16lanes(q) * (1.f / 128.f) + EPS);
#pragma unroll
          for (int e = 0; e < 8; ++e) a[e] = a[e] * rstd * (g[e] * sigmoidf_fast(g[e]));
          *(v4u*)(obuf + 2 * OB1 + o) = pack8(a); }
    }
}

constexpr int SC_LD = 72;
constexpr int SC_QIN = 0, SC_KIN = 9216, SC_QB = 18432, SC_KDT = 27648, SC_SM = 36864, SC_VT = 46080, SC_TOT = 64512, SC_DEC = 66560, SC_ZS = 66816, SC_END = 70912;
template <bool GLA> __device__ __forceinline__ void scan_unit(LAS unsigned char* shm, const bf16* proj, bf16* outb, int row0, int len, int h, int dir,
                                                              const float* wg, const float* bg, float lgam) {
    int tid_ = threadIdx.x; asm volatile("" : "+v"(tid_)); const int tid = tid_, lane = tid & 63, wid = __builtin_amdgcn_readfirstlane(tid >> 6), fr = lane & 15, fq = lane >> 4;
    const int cq = (GLA ? C_GQ : C_RQ) + h * 64, ck = (GLA ? C_GK : C_RK) + h * 64, cv = (GLA ? C_GV : C_RV) + h * 128, cz = C_GA + dir * 16;
    LAS bf16* qin = (LAS bf16*)(shm + SC_QIN); LAS bf16* kin = (LAS bf16*)(shm + SC_KIN); LAS bf16* qb = (LAS bf16*)(shm + SC_QB);
    LAS bf16* kdT = (LAS bf16*)(shm + SC_KDT); LAS bf16* sm = (LAS bf16*)(shm + SC_SM); LAS bf16* vT = (LAS bf16*)(shm + SC_VT);
    LAS float* tot = (LAS float*)(shm + SC_TOT); LAS float* dec = (LAS float*)(shm + SC_DEC); LAS float* zs = (LAS float*)(shm + SC_ZS);
    const int nch = len >> 6;
    float w[16]; float bias = 0.f;
    if (GLA) {
#pragma unroll
        for (int r = 0; r < 16; ++r) w[r] = wg[r * 256 + h * 64 + lane];
        bias = bg[h * 64 + lane];
    }
    f32x4 S[4];
#pragma unroll
    for (int i = 0; i < 4; ++i) S[i] = (f32x4){0.f, 0.f, 0.f, 0.f};
    unsigned short qr[8], kr[8]; v4u vr0, vr1, zr;
    unsigned short qn[8], kn[8]; v4u vn0, vn1, zn;
#define SC_ROW(c, i) (dir == 0 ? row0 + (c) * 64 + (i) : row0 + len - 1 - ((c) * 64 + (i)))
#define SC_LOAD(c, Q, K, V0, V1, Z) do { \
        _Pragma("unroll") for (int e = 0; e < 8; ++e) { const bf16* rp = proj + (size_t)SC_ROW(c, 8 * wid + e) * PW; Q[e] = rp[cq + lane]; K[e] = rp[ck + lane]; } \
        { const bf16* rp = proj + (size_t)SC_ROW(c, lane) * PW + cv + 16 * wid; V0 = *(const v4u*)rp; V1 = *(const v4u*)(rp + 8); } \
        if (GLA) { if (tid < 128) Z = *(const v4u*)(proj + (size_t)SC_ROW(c, tid >> 1) * PW + cz + 8 * (tid & 1)); } } while (0)
    zr = (v4u){0u, 0u, 0u, 0u}; zn = zr;
    SC_LOAD(0, qr, kr, vr0, vr1, zr);
    for (int c = 0; c < nch; ++c) {
        float la[8];
        if (GLA) {
            if (tid < 128) { float z[8]; unpack8(zr, z); LAS float* zp = zs + (tid >> 1) * 16 + 8 * (tid & 1);
                *(LAS f32x4*)zp = (f32x4){z[0], z[1], z[2], z[3]}; *(LAS f32x4*)(zp + 4) = (f32x4){z[4], z[5], z[6], z[7]}; }
            __syncthreads();
#pragma unroll
            for (int e = 0; e < 8; ++e) { const LAS f32x4* zp = (const LAS f32x4*)(zs + (8 * wid + e) * 16); float a = bias;
#pragma unroll
                for (int r4 = 0; r4 < 4; ++r4) { const f32x4 zz = zp[r4]; a += zz.x * w[4 * r4] + zz.y * w[4 * r4 + 1] + zz.z * w[4 * r4 + 2] + zz.w * w[4 * r4 + 3]; }
                la[e] = (fminf(a, 0.f) - __logf(1.0f + __expf(-fabsf(a)))) * 0.0625f; }
        } else {
#pragma unroll
            for (int e = 0; e < 8; ++e) la[e] = lgam;
        }
        float p[8]; p[0] = la[0];
#pragma unroll
        for (int e = 1; e < 8; ++e) p[e] = p[e - 1] + la[e];
        tot[wid * 64 + lane] = p[7];
        __syncthreads();
        float off = 0.f, bref = 0.f, blast = 0.f;
#pragma unroll
        for (int g = 0; g < 8; ++g) { const float tg = tot[g * 64 + lane]; if (g < wid) off += tg; if (g < 4) bref += tg; blast += tg; }
        {
            unsigned kdp[4];
            float kdv[8];
#pragma unroll
            for (int e = 0; e < 8; ++e) { const float b = off + p[e], q = bf1(qr[e]), k = bf1(kr[e]); const int i = 8 * wid + e;
                qin[i * SC_LD + lane] = (bf16)f2bf(q * __expf(b - bref));
                kin[i * SC_LD + lane] = (bf16)f2bf(k * __expf(bref - b));
                qb[i * SC_LD + lane] = (bf16)f2bf(q * __expf(b));
                kdv[e] = k * __expf(blast - b); }
#pragma unroll
            for (int e = 0; e < 4; ++e) kdp[e] = pk2(kdv[2 * e], kdv[2 * e + 1]);
            *(LAS v4u*)(kdT + lane * SC_LD + 8 * wid) = (v4u){kdp[0], kdp[1], kdp[2], kdp[3]};
            if (wid == 0) dec[lane] = __expf(blast);
            const unsigned vw[8] = {vr0.x, vr0.y, vr0.z, vr0.w, vr1.x, vr1.y, vr1.z, vr1.w};
#pragma unroll
            for (int e = 0; e < 8; ++e) { vT[(16 * wid + 2 * e) * SC_LD + lane] = (bf16)(vw[e] & 0xffffu); vT[(16 * wid + 2 * e + 1) * SC_LD + lane] = (bf16)(vw[e] >> 16); }
        }
        __syncthreads();
        if (c + 1 < nch) SC_LOAD(c + 1, qn, kn, vn0, vn1, zn);
#pragma unroll
        for (int tt = 0; tt < 2; ++tt) { const int idx = 2 * wid + tt, ti = idx >> 2, tj = idx & 3;
            f32x4 a = (f32x4){0.f, 0.f, 0.f, 0.f};
            if (tj <= ti) {
#pragma unroll
                for (int ks = 0; ks < 2; ++ks) { const bf16x8 A = *(const LAS bf16x8*)(qin + (ti * 16 + fr) * SC_LD + 32 * ks + 8 * fq), B = *(const LAS bf16x8*)(kin + (tj * 16 + fr) * SC_LD + 32 * ks + 8 * fq);
                    a = __builtin_amdgcn_mfma_f32_16x16x32_bf16(A, B, a, 0, 0, 0); } }
            const int j = tj * 16 + fr;
#pragma unroll
            for (int r = 0; r < 4; ++r) { const int i = ti * 16 + 4 * fq + r; sm[i * SC_LD + j] = (bf16)f2bf(j <= i ? a[r] : 0.f); } }
        __syncthreads();
        {
            bf16x8 bv[2];
#pragma unroll
            for (int ks = 0; ks < 2; ++ks) bv[ks] = *(const LAS bf16x8*)(vT + (16 * wid + fr) * SC_LD + 32 * ks + 8 * fq);
            f32x4 o[4];
#pragma unroll
            for (int ib = 0; ib < 4; ++ib) { o[ib] = (f32x4){0.f, 0.f, 0.f, 0.f};
#pragma unroll
                for (int ks = 0; ks < 2; ++ks) { const bf16x8 A = *(const LAS bf16x8*)(sm + (ib * 16 + fr) * SC_LD + 32 * ks + 8 * fq); o[ib] = __builtin_amdgcn_mfma_f32_16x16x32_bf16(A, bv[ks], o[ib], 0, 0, 0); } }
#pragma unroll
            for (int ks = 0; ks < 2; ++ks) {
                v4u sw; sw.x = pk2(S[2 * ks][0], S[2 * ks][1]); sw.y = pk2(S[2 * ks][2], S[2 * ks][3]); sw.z = pk2(S[2 * ks + 1][0], S[2 * ks + 1][1]); sw.w = pk2(S[2 * ks + 1][2], S[2 * ks + 1][3]);
                const bf16x8 Bs = __builtin_bit_cast(bf16x8, sw);
#pragma unroll
                for (int ib = 0; ib < 4; ++ib) { const v2u lo = *(const LAS v2u*)(qb + (ib * 16 + fr) * SC_LD + 32 * ks + 4 * fq), hi = *(const LAS v2u*)(qb + (ib * 16 + fr) * SC_LD + 32 * ks + 16 + 4 * fq);
                    const bf16x8 A = __builtin_bit_cast(bf16x8, ((v4u){lo.x, lo.y, hi.x, hi.y})); o[ib] = __builtin_amdgcn_mfma_f32_16x16x32_bf16(A, Bs, o[ib], 0, 0, 0); } }
#pragma unroll
            for (int ib = 0; ib < 4; ++ib)
#pragma unroll
                for (int r = 0; r < 4; ++r) { const int i = ib * 16 + 4 * fq + r; outb[(size_t)SC_ROW(c, i) * 512 + h * 128 + 16 * wid + fr] = (bf16)f2bf(o[ib][r]); }
#pragma unroll
            for (int db = 0; db < 4; ++db) {
#pragma unroll
                for (int r = 0; r < 4; ++r) S[db][r] *= dec[db * 16 + 4 * fq + r];
#pragma unroll
                for (int ks = 0; ks < 2; ++ks) { const bf16x8 A = *(const LAS bf16x8*)(kdT + (db * 16 + fr) * SC_LD + 32 * ks + 8 * fq); S[db] = __builtin_amdgcn_mfma_f32_16x16x32_bf16(A, bv[ks], S[db], 0, 0, 0); } }
        }
#pragma unroll
        for (int e = 0; e < 8; ++e) { qr[e] = qn[e]; kr[e] = kn[e]; }
        vr0 = vn0; vr1 = vn1; zr = zn;
    }
    __syncthreads();
#undef SC_ROW
#undef SC_LOAD
}

#define XB_TMO      128
#define XB_XCNT(j)  (256  + 64 * (j))
#define XB_XSUB(j)  (1280 + 64 * (j))
#define XB_XGEN(j)  (2304 + 64 * (j))
#define XB_TOP      3328
#define XB_TOPGEN   3392
#define XCD_BAR_WORDS 3456
#define XB_SPIN_CAP (1u << 18)

__device__ __forceinline__ unsigned xb_ld(unsigned* p)              { return __hip_atomic_load(p, __ATOMIC_RELAXED, __HIP_MEMORY_SCOPE_AGENT); }
__device__ __forceinline__ unsigned xb_add(unsigned* p, unsigned v) { return __hip_atomic_fetch_add(p, v, __ATOMIC_RELAXED, __HIP_MEMORY_SCOPE_AGENT); }
__device__ __forceinline__ unsigned xb_xcc_id() { return (unsigned)__builtin_amdgcn_s_getreg((3 << 11) | 20) & 0xFu; }
#define XB_SPIN(cond, bar) do { unsigned _sp = 0; while (cond) { __builtin_amdgcn_s_sleep(1); \
    if ((++_sp & 255u) == 0u) { if (xb_ld(&(bar)[XB_TMO])) break; if (_sp > XB_SPIN_CAP) { atomicAdd(&(bar)[XB_TMO], 1u); break; } } } } while (0)

struct XcdBarrier {
    unsigned* bar; unsigned x;
    volatile LAS unsigned* st;
};

__device__ __forceinline__ XcdBarrier xcd_barrier_post(unsigned* bar, volatile LAS unsigned* st) {
    XcdBarrier b; b.bar = bar; b.x = xb_xcc_id(); b.st = st;
    if (threadIdx.x == 0) (void)xb_add(&bar[XB_XCNT(b.x)], 1u);
    return b;
}
__device__ __forceinline__ void xcd_barrier_complete(unsigned* bar, unsigned x, unsigned& nloc, unsigned& nx) {
    const unsigned G = gridDim.x * gridDim.y * gridDim.z;
    unsigned sum, cnt, mine, sp = 0u;
    for (;;) {
        sum = 0u; cnt = 0u; mine = 0u;
#pragma unroll
        for (unsigned j = 0; j < 16; ++j) { const unsigned c = xb_ld(&bar[XB_XCNT(j)]); sum += c; cnt += (c > 0u) ? 1u : 0u; mine = (j == x) ? c : mine; }
        if (sum == G) break;
        __builtin_amdgcn_s_sleep(1);
        if ((++sp & 255u) == 0u) { if (xb_ld(&bar[XB_TMO])) break; if (sp > XB_SPIN_CAP) { atomicAdd(&bar[XB_TMO], 1u); break; } }
    }
    nloc = mine > 0u ? mine : 1u; nx = cnt > 0u ? cnt : 1u;
}

__device__ __forceinline__ void xcd_barrier(const XcdBarrier& b) {
    asm volatile("s_waitcnt vmcnt(0)" ::: "memory");
    __syncthreads();
    if (threadIdx.x == 0) {
        unsigned* bar = b.bar;
        __builtin_amdgcn_s_waitcnt(0);
        unsigned nloc = b.st[0], nx = b.st[1];
        if (nloc == 0u) { xcd_barrier_complete(bar, b.x, nloc, nx); b.st[0] = nloc; b.st[1] = nx; }
        const unsigned old = xb_add(&bar[XB_XSUB(b.x)], 1u);
        const unsigned gen = old / nloc;
        if (old + 1u == (gen + 1u) * nloc) {
            __builtin_amdgcn_fence(__ATOMIC_RELEASE, "agent");
            asm volatile("s_waitcnt vmcnt(0)" ::: "memory");
            const unsigned og = xb_add(&bar[XB_TOP], 1u);
            const unsigned tg = og / nx;
            if (og + 1u == (tg + 1u) * nx) xb_add(&bar[XB_TOPGEN], 1u);
            else XB_SPIN(xb_ld(&bar[XB_TOPGEN]) == tg, bar);
            __builtin_amdgcn_fence(__ATOMIC_ACQUIRE, "agent");
            xb_add(&bar[XB_XGEN(b.x)], 1u);
            asm volatile("s_waitcnt vmcnt(0)" ::: "memory");
        } else {
            XB_SPIN(xb_ld(&bar[XB_XGEN(b.x)]) == gen, bar);
            __builtin_amdgcn_fence(__ATOMIC_ACQUIRE, "agent");
            asm volatile("s_waitcnt vmcnt(0)" ::: "memory");
        }
    }
    __syncthreads();
}

struct Args { const float* in[16]; float* out; unsigned char* ws; };
__global__ void __launch_bounds__(NWAVES * 64, 2) hybrid_fwd(Args args) {
    extern __shared__ __attribute__((aligned(16))) unsigned char lds[];
    cg::grid_group grid = cg::this_grid();
    LAS unsigned char* L = (LAS unsigned char*)lds;
    volatile LAS unsigned* MISC = (volatile LAS unsigned*)(L + MISC_OFF);
    const int tid = threadIdx.x, lane = tid & 63, wave = __builtin_amdgcn_readfirstlane(tid >> 6);
    const int G = gridDim.x, bx = blockIdx.x;
    const int vcu = (G % 8 == 0) ? (bx % 8) * (G / 8) + bx / 8 : bx;
    const int gw = vcu * NWAVES + wave, NGW = G * NWAVES;
    unsigned char* ws = args.ws;
    unsigned* ctl = (unsigned*)(ws + WS_CTL);
    bf16* XN = (bf16*)(ws + WS_XN); bf16* PROJ = (bf16*)(ws + WS_PROJ); bf16* MERGED = (bf16*)(ws + WS_MERGED); bf16* OBUF = (bf16*)(ws + WS_OBUF);
    float* ACCF = (float*)(ws + WS_OBUF);
    float* out = args.out;
    for (int u = tid; u < (LDS_BYTES - RING_BYTES) / 4; u += NWAVES * 64) ((LAS unsigned*)(L + RING_BYTES))[u] = 0u;
    __syncthreads();
    XcdBarrier bar = xcd_barrier_post(ctl + CW_BAR, MISC + 8);

    {
        LAS float* scr = (LAS float*)(L + wave * 16384);
        for (int l = 0; l < DEPTH; ++l) {
            unsigned char* wl = ws + WS_W + (size_t)l * LW;
            const float* src[8] = {args.in[4] + (size_t)l * DM * INW, args.in[11] + (size_t)l * DM * 3 * DM, args.in[10] + (size_t)(l * 3 + 0) * 512 * DM, args.in[10] + (size_t)(l * 3 + 1) * 512 * DM,
                                   args.in[10] + (size_t)(l * 3 + 2) * 512 * DM, args.in[12] + (size_t)l * DM * DM, args.in[13] + (size_t)l * DM * FF, args.in[14] + (size_t)l * FF * DM};
            const int Ks[8] = {DM, DM, 512, 512, 512, DM, DM, FF}, Ns[8] = {INW, 3 * DM, DM, DM, DM, DM, FF, DM}, roff[8] = {0, 0, 0, DM, 2 * DM, 0, 0, 0};
            const size_t doff[8] = {OW_IN, OW_MERGE, OW_BR, OW_BR, OW_BR, OW_OUT, OW_UP, OW_DOWN};
#pragma unroll
            for (int mi = 0; mi < 8; ++mi) {
                const int nit = (Ks[mi] / 64) * (Ns[mi] / 32);
                for (int it = gw; it < nit; it += NGW) p0_transpose_item(src[mi], Ks[mi], Ns[mi], (bf16*)(wl + doff[mi]), roff[mi], scr, it, lane);
            }
            v4u* z = (v4u*)(wl + OW_IN + (size_t)INW * DM * 2);
            for (int i = gw * 64 + lane; i < (PW - INW) * DM * 2 / 16; i += NGW * 64) z[i] = (v4u){0u, 0u, 0u, 0u};
        }
    }
    grid.sync();

    for (int l = 0; l < DEPTH; ++l) {
        unsigned char* wl = ws + WS_W + (size_t)l * LW;
        const bf16* Win_t = (const bf16*)(wl + OW_IN); const bf16* Wmerge_t = (const bf16*)(wl + OW_MERGE); const bf16* Wbr_t = (const bf16*)(wl + OW_BR);
        const bf16* Wout_t = (const bf16*)(wl + OW_OUT); const bf16* Wup_t = (const bf16*)(wl + OW_UP); const bf16* Wdown_t = (const bf16*)(wl + OW_DOWN);
        for (int hf = 0; hf < 2; ++hf) {
            float* op = out + (size_t)hf * MP * DM; float* os = out + (size_t)(2 * MP + hf * SS) * DM;
            const float* xp = l == 0 ? args.in[0] + (size_t)hf * MP * DM : op; const float* xs = l == 0 ? args.in[1] + (size_t)hf * SS * DM : os;
            norm_rows(xp, xs, args.in[2] + l * DM, XN, gw, NGW, lane);
            xcd_barrier(bar);
            { pg8::Gemm g{XN, Win_t, MH, PW, DM, 1 << 30, 0}; pg8::StaticOrder S; S.init(MH, PW, G, bx);
              pg8::EpiBf16<0> E{PROJ, PW, 0, 0};
              pg8::gemm_phase<pg8::EpiBf16<0>, pg8::StaticOrder, true, true>(L, g, S, E); }
            xcd_barrier(bar);
            e1_rows(PROJ, args.in[5] + l * 64, args.in[6] + l * 64, gw, NGW, lane);
            xcd_barrier(bar);
            {
                unsigned* qctr = ctl + 64 * (1 + l * 2 + hf);
                for (;;) {
                    if (tid == 0) MISC[0] = atomicAdd(qctr, 1u);
                    __syncthreads();
                    const int u = (int)MISC[0];
                    __syncthreads();
                    if (u >= 912) break;
                    if (u < 144) {
                        int row0, len, r;
                        if (u < 16) { row0 = MP; len = SS; r = u; } else { const int s2 = u - 16; row0 = (s2 >> 4) * SP; len = SP; r = s2 & 15; }
                        const int mixer = r >> 3, h = (r >> 1) & 3, dir = r & 1;
                        if (mixer == 0) scan_unit<true>(L, PROJ, OBUF + (size_t)(1 + 2 * dir) * OB1, row0, len, h, dir, args.in[7] + (size_t)(l * 2 + dir) * 16 * 256, args.in[8] + (size_t)(l * 2 + dir) * 256, 0.f);
                        else { const int hh = dir == 0 ? h : 3 - h; const float lg = __logf(1.0f - __builtin_amdgcn_exp2f(-5.0f - (float)hh));
                               scan_unit<false>(L, PROJ, OBUF + (size_t)(2 + 2 * dir) * OB1, row0, len, h, dir, nullptr, nullptr, lg); }
                    } else {
                        const int au = u - 144; int row0, nt, hk, qb, hq;
                        if (au < 256) { row0 = MP; nt = SS / 64; hk = au >> 7; qb = (au >> 2) & 31; hq = au & 3; }
                        else { const int a2 = au - 256, r = a2 & 63; row0 = (a2 >> 6) * SP; nt = SP / 64; hk = r >> 5; qb = (r >> 2) & 7; hq = r & 3; }
                        const int h = hk * 4 + hq;
                        const attn_body::bf16* P = (const attn_body::bf16*)PROJ;
                        attn_body::attn_unit<8>(P + (size_t)(row0 + qb * 256) * PW + C_AQ + h * 64, P + (size_t)row0 * PW + C_AK + hk * 64, P + (size_t)row0 * PW + C_AV + hk * 64,
                                                (attn_body::bf16*)OBUF + (size_t)(row0 + qb * 256) * 512 + h * 64, nt, (char*)lds);
                    }
                }
            }
            xcd_barrier(bar);
            e2_rows(PROJ, OBUF, args.in[9] + l * 128, gw, NGW, lane);
            xcd_barrier(bar);
            { pg8::Gemm g{OBUF, Wbr_t, MH, 3 * DM, 512, 4, OB1 * 2}; pg8::StaticOrder S; S.init(MH, 3 * DM, G, bx);
              pg8::EpiBf16<0> E{PROJ, DM, DM, (size_t)MH * DM};
              pg8::gemm_phase<pg8::EpiBf16<0>, pg8::StaticOrder, true, true>(L, g, S, E); }
            xcd_barrier(bar);
            { pg8::Gemm g{XN, Wmerge_t, MH, 3 * DM, DM, 1 << 30, 0}; pg8::MergeOrder S; S.init(MH, G, bx);
              pg8::EpiMerge E{PROJ, (size_t)MH * DM, ACCF, MERGED};
              pg8::gemm_phase<pg8::EpiMerge, pg8::MergeOrder, true, true>(L, g, S, E); }
            xcd_barrier(bar);
            { pg8::Gemm g{MERGED, Wout_t, MH, DM, DM, 1 << 30, 0}; pg8::StaticOrder S; S.init(MH, DM, G, bx);
              pg8::EpiRes E{xp, xs, op, os};
              pg8::gemm_phase<pg8::EpiRes, pg8::StaticOrder, true, true>(L, g, S, E); }
            xcd_barrier(bar);
            norm_rows(op, os, args.in[3] + l * DM, XN, gw, NGW, lane);
            xcd_barrier(bar);
            { pg8::Gemm g{XN, Wup_t, MH, FF, DM, 1 << 30, 0}; pg8::StaticOrder S; S.init(MH, FF, G, bx);
              pg8::EpiBf16<2> E{PROJ, FF, 0, 0};
              pg8::gemm_phase<pg8::EpiBf16<2>, pg8::StaticOrder, true, true>(L, g, S, E); }
            xcd_barrier(bar);
            { pg8::Gemm g{PROJ, Wdown_t, MH, DM, FF, 1 << 30, 0}; pg8::StaticOrder S; S.init(MH, DM, G, bx);
              pg8::EpiRes E{op, os, op, os};
              pg8::gemm_phase<pg8::EpiRes, pg8::StaticOrder, true, true>(L, g, S, E); }
            xcd_barrier(bar);
        }
    }
    final_norm(out, args.in[15], gw, NGW, lane);
}

extern "C" void kernel_launch(void* const* d_in, const int* in_sizes, int n_in, void* d_out, int out_size, void* d_ws, size_t ws_size, hipStream_t stream) {
    static int grid = 0;
    if (grid == 0) {
        if (n_in != 16 || out_size != 2 * MH * DM || ws_size < WS_END) { fprintf(stderr, "kernel_launch: unexpected shapes (n_in %d, out %d, ws %zu)\n", n_in, out_size, ws_size); grid = -1; return; }
        int dev = 0, cus = 0, per_cu = 0;
        if (hipGetDevice(&dev) != hipSuccess || hipDeviceGetAttribute(&cus, hipDeviceAttributeMultiprocessorCount, dev) != hipSuccess) { grid = -1; return; }
        if (hipFuncSetAttribute((const void*)hybrid_fwd, hipFuncAttributeMaxDynamicSharedMemorySize, LDS_BYTES) != hipSuccess) { fprintf(stderr, "kernel_launch: hipFuncSetAttribute failed\n"); grid = -1; return; }
        if (hipOccupancyMaxActiveBlocksPerMultiprocessor(&per_cu, (const void*)hybrid_fwd, NWAVES * 64, LDS_BYTES) != hipSuccess || per_cu < 1) { fprintf(stderr, "kernel_launch: occupancy query says %d\n", per_cu); per_cu = 1; }
        (void)hipGetLastError();
        grid = cus;
    }
    if (grid < 0) return;
    if (hipMemsetAsync((char*)d_ws + WS_CTL, 0, CTL_ZERO_BYTES, stream) != hipSuccess) { fprintf(stderr, "kernel_launch: memset failed\n"); return; }
    Args a{};
    for (int i = 0; i < 16; ++i) a.in[i] = (const float*)d_in[i];
    a.out = (float*)d_out; a.ws = (unsigned char*)d_ws;
    void* kargs[] = {&a};
    const hipError_t le = hipLaunchCooperativeKernel((const void*)hybrid_fwd, dim3(grid), dim3(NWAVES * 64), kargs, LDS_BYTES, stream);
    if (le != hipSuccess) fprintf(stderr, "kernel_launch: cooperative launch failed: %s (grid %d)\n", hipGetErrorName(le), grid);
}
```

```cpp
#include <hip/hip_runtime.h>
#include <hip/hip_cooperative_groups.h>
#include <cstdio>
#include <cstdint>
namespace cg = cooperative_groups;
namespace pg8 {
#define PG8_LAS __attribute__((address_space(3)))
typedef unsigned short bf16_t;
typedef short bf16x8 __attribute__((ext_vector_type(8)));
typedef float f32x4 __attribute__((ext_vector_type(4)));
typedef unsigned u32x4 __attribute__((ext_vector_type(4)));
constexpr int BM = 256, BK = 64, HALF = 128, HTB = HALF * BK * 2  , STAGE_BYTES = 8 * HTB, NXCD = 8, WGM = 8;

__host__ __device__ __forceinline__ int lds_byte(int r, int c) { const int st = (r >> 4) * 2 + (c >> 5), rr = r & 15, cc = c & 31, ob = rr * 64 + cc * 2; return st * 1024 + (ob ^ (((ob >> 9) & 1) << 5)); }
__host__ __device__ __forceinline__ void stage_rc(int b, int& R, int& C) { const int st = b / 1024, sb = b % 1024, swz = sb ^ (((sb >> 9) & 1) << 5); R = (st >> 1) * 16 + swz / 64; C = (st & 1) * 32 + (swz % 64) / 2; }
__host__ __device__ __forceinline__ int perm32(int rho) { const int n = rho >> 4, i = rho & 15; return 8 * (i >> 2) + 4 * n + (i & 3); }

struct Unit { int pm, pn; };
struct Gemm { const bf16_t* A; const bf16_t* Bt; int M, N, K; int a_grp; size_t a_grp_bytes; };

struct StaticOrder {
    int nM, nN, nwg, G, c;
    __host__ __device__ void init(int M, int N, int G_, int c_) { nM = M / BM; nN = N / BM; nwg = nM * nN; G = G_; c = c_; }
    __host__ __device__ bool next(int i, Unit& u) const {
        const long L = (long)i * G + c; if (L >= nwg) return false;
        int wgid = (int)L; { const int q = nwg / NXCD, r = nwg % NXCD, xcd = wgid % NXCD, off = wgid / NXCD; wgid = (xcd < r ? xcd * (q + 1) : r * (q + 1) + (xcd - r) * q) + off; }
        const int nig = WGM * nN, gid = wgid / nig, fm = gid * WGM, gsz = (nM - fm) < WGM ? (nM - fm) : WGM;
        u.pm = fm + ((wgid % nig) % gsz); u.pn = (wgid % nig) / gsz; return true;
    }
    __device__ __forceinline__ void a_ready(const Unit&) const {}
    __device__ __forceinline__ void done(const Unit&) const {}
};

__device__ __forceinline__ unsigned cvt_pk_bf16(float lo, float hi) { unsigned r; asm volatile("v_cvt_pk_bf16_f32 %0, %1, %2" : "=v"(r) : "v"(lo), "v"(hi)); return r; }
typedef float f32x2 __attribute__((ext_vector_type(2)));
__device__ __forceinline__ float bflo(unsigned w) { return __builtin_bit_cast(float, w << 16); }
__device__ __forceinline__ float bfhi(unsigned w) { return __builtin_bit_cast(float, w & 0xffff0000u); }
template <int ACT> struct EpiBf16 {
    static constexpr bool PERM = true, AFTER_DRAIN = false;
    bf16_t* O; int ldc; int split_cols; size_t split_stride;
    __device__ __forceinline__ void operator()(const f32x4 (&acc)[2][2][4][2], const Unit& u, int wr, int wc, int fr, int fq) const {
        const int row0 = u.pm * BM + wr * 64 + fr; int colt = u.pn * BM; bf16_t* base = O;
        if (split_cols) { const int t = colt / split_cols; base += (size_t)t * split_stride; colt -= t * split_cols; }
        const int col0 = colt + wc * 32 + 8 * fq;
#pragma unroll
        for (int ai = 0; ai < 2; ++ai)
#pragma unroll
            for (int m = 0; m < 4; ++m) { bf16_t* rowp = base + (size_t)(row0 + ai * HALF + m * 16) * ldc + col0;
#pragma unroll
                for (int bj = 0; bj < 2; ++bj) { f32x4 v0 = acc[ai][bj][m][0], v1 = acc[ai][bj][m][1];
                    if (ACT == 2) {
#pragma unroll
                        for (int j = 0; j < 4; ++j) { const float a = fmaxf(v0[j], 0.f), b = fmaxf(v1[j], 0.f); v0[j] = a * a; v1[j] = b * b; } }
                    u32x4 w; w.x = cvt_pk_bf16(v0[0], v0[1]); w.y = cvt_pk_bf16(v0[2], v0[3]); w.z = cvt_pk_bf16(v1[0], v1[1]); w.w = cvt_pk_bf16(v1[2], v1[3]);
                    *(u32x4*)(rowp + bj * HALF) = w; } }
    }
};
struct EpiMerge {
    static constexpr bool PERM = true, AFTER_DRAIN = false;
    const bf16_t* Y; size_t ystride; float* accf; bf16_t* merged;
    __device__ __forceinline__ void operator()(const f32x4 (&acc)[2][2][4][2], const Unit& u, int wr, int wc, int fr, int fq) const {
        const int b = u.pn >> 2, ct = u.pn & 3;
        const int row0 = u.pm * BM + wr * 64 + fr, col0 = ct * BM + wc * 32 + 8 * fq;
        const bf16_t* Yb = Y + (size_t)b * ystride;
#pragma unroll
        for (int ai = 0; ai < 2; ++ai)
#pragma unroll
            for (int m = 0; m < 4; ++m) {
#pragma unroll
                for (int bj = 0; bj < 2; ++bj) { const size_t o = (size_t)(row0 + ai * HALF + m * 16) * 1024 + col0 + bj * HALF;
                    const u32x4 yv = *(const u32x4*)(Yb + o);
                    float y[8] = {bflo(yv.x), bfhi(yv.x), bflo(yv.y), bfhi(yv.y), bflo(yv.z), bfhi(yv.z), bflo(yv.w), bfhi(yv.w)};
                    float p[8];
#pragma unroll
                    for (int j = 0; j < 8; ++j) { const float a = j < 4 ? acc[ai][bj][m][0][j & 3] : acc[ai][bj][m][1][j & 3];
                        const float g = __builtin_amdgcn_rcpf(1.0f + __builtin_amdgcn_exp2f(-1.4426950408889634f * a)); p[j] = g * y[j]; }
                    if (b > 0) { const f32x4 c0 = *(const f32x4*)(accf + o), c1 = *(const f32x4*)(accf + o + 4);
#pragma unroll
                        for (int j = 0; j < 4; ++j) { p[j] += c0[j]; p[4 + j] += c1[j]; } }
                    if (b < 2) { *(f32x4*)(accf + o) = (f32x4){p[0], p[1], p[2], p[3]}; *(f32x4*)(accf + o + 4) = (f32x4){p[4], p[5], p[6], p[7]}; }
                    else { u32x4 w; w.x = cvt_pk_bf16(p[0], p[1]); w.y = cvt_pk_bf16(p[2], p[3]); w.z = cvt_pk_bf16(p[4], p[5]); w.w = cvt_pk_bf16(p[6], p[7]); *(u32x4*)(merged + o) = w; } } }
    }
};
struct EpiRes {
    static constexpr bool PERM = false, AFTER_DRAIN = false;
    const float* base_p; const float* base_s; float* out_p; float* out_s;
    __device__ __forceinline__ void operator()(const f32x4 (&acc)[2][2][4][2], const Unit& u, int wr, int wc, int fr, int fq) const {
        const bool smp = u.pm >= 64; const float* bs = smp ? base_s : base_p; float* ot = smp ? out_s : out_p;
        const int r0 = (smp ? u.pm - 64 : u.pm) * BM + wr * 64 + fr, col0 = u.pn * BM + wc * 32 + 4 * fq;
#pragma unroll
        for (int ai = 0; ai < 2; ++ai)
#pragma unroll
            for (int m = 0; m < 4; ++m) { const size_t off = (size_t)(r0 + ai * HALF + m * 16) * 1024 + col0;
#pragma unroll
                for (int bj = 0; bj < 2; ++bj)
#pragma unroll
                    for (int n = 0; n < 2; ++n) { const size_t o = off + bj * HALF + n * 16; const f32x4 v = *(const f32x4*)(bs + o) + acc[ai][bj][m][n]; *(f32x4*)(ot + o) = v; } }
    }
};
struct MergeOrder {
    int nM, nwg, G, c;
    __host__ __device__ void init(int M, int G_, int c_) { nM = M / BM; nwg = nM * 4; G = G_; c = c_; }
    __host__ __device__ bool next(int i, Unit& u) const {
        const int j = i / 3, b = i - 3 * j; const long L = (long)j * G + c; if (L >= nwg) return false;
        int wgid = (int)L; { const int q = nwg / NXCD, r = nwg % NXCD, xcd = wgid % NXCD, off = wgid / NXCD; wgid = (xcd < r ? xcd * (q + 1) : r * (q + 1) + (xcd - r) * q) + off; }
        const int nN = 4, nig = WGM * nN, gid = wgid / nig, fm = gid * WGM, gsz = (nM - fm) < WGM ? (nM - fm) : WGM;
        u.pm = fm + ((wgid % nig) % gsz); u.pn = b * 4 + (wgid % nig) / gsz; return true;
    }
    __device__ __forceinline__ void a_ready(const Unit&) const {}
    __device__ __forceinline__ void done(const Unit&) const {}
};
template <class Epi, class Sched, bool ALIGN_EPI = false, bool SP2 = false>
__device__ __forceinline__ void gemm_phase(PG8_LAS unsigned char* lds, const Gemm g, const Sched& S, const Epi& E) {
    int tid_ = threadIdx.x; asm volatile("" : "+v"(tid_)); const int tid = tid_, wid = __builtin_amdgcn_readfirstlane(tid >> 6), lane = tid & 63, wr = wid >> 2, wc = wid & 3, fr = lane & 15, fq = lane >> 4;
    const int K = g.K, nt = K / BK;
    unsigned voffA[2], voffB[2];
#pragma unroll
    for (int i = 0; i < 2; ++i) { int R, C; stage_rc(tid * 16 + i * 8192, R, C); const int Rb = Epi::PERM ? ((R & ~31) + perm32(R & 31)) : R;
        voffA[i] = (unsigned)(R * K + C) * 2u; voffB[i] = (unsigned)(Rb * K + C) * 2u; }
    const size_t kstep = (size_t)(BK * 2);
    const size_t hstep = (size_t)HALF * K * 2;
    const size_t tstep = 2 * hstep;
    const unsigned ldsw = (unsigned)wid * 1024u;
    const int aoff = lds_byte(wr * 64 + fr, fq * 8), boff = lds_byte(wc * 32 + fr, fq * 8);
#define PG8_SA(b, h) (((b) * 2 + (h)) * HTB)
#define PG8_SB(b, h) ((4 + (b) * 2 + (h)) * HTB)
#define PG8_STAGE(bufoff, gbase, voff) do { _Pragma("unroll") for (int _i = 0; _i < 2; ++_i) \
        __builtin_amdgcn_global_load_lds((const unsigned*)((const char*)(gbase) + (voff)[_i]), (PG8_LAS unsigned*)(lds + (bufoff) + ldsw + _i * 8192), 16, 0, 0); } while (0)
#define PG8_LDA(dst, b, h) do { _Pragma("unroll") for (int m = 0; m < 4; ++m) _Pragma("unroll") for (int k = 0; k < 2; ++k) dst[m][k] = *(const PG8_LAS bf16x8*)(lds + PG8_SA(b, h) + aoff + m * 2048 + k * 1024); } while (0)
#define PG8_LDB(dst, b, h) do { _Pragma("unroll") for (int n = 0; n < 2; ++n) _Pragma("unroll") for (int k = 0; k < 2; ++k) dst[n][k] = *(const PG8_LAS bf16x8*)(lds + PG8_SB(b, h) + boff + n * 2048 + k * 1024); } while (0)
#define PG8_MMA(ai, bj, At, Bt) do { __builtin_amdgcn_s_setprio(1); _Pragma("unroll") for (int m = 0; m < 4; ++m) _Pragma("unroll") for (int n = 0; n < 2; ++n) _Pragma("unroll") for (int k = 0; k < 2; ++k) \
        acc[ai][bj][m][n] = __builtin_amdgcn_mfma_f32_16x16x32_bf16(Bt[n][k], At[m][k], acc[ai][bj][m][n], 0, 0, 0); __builtin_amdgcn_s_setprio(0); } while (0)
#define PG8_WAIT_V(n) asm volatile("s_waitcnt vmcnt(" #n ")" ::: "memory")
#define PG8_WAIT_L(n) asm volatile("s_waitcnt lgkmcnt(" #n ")" ::: "memory")
#define PG8_BAR __builtin_amdgcn_s_barrier()
#define PG8_SCHED __builtin_amdgcn_sched_barrier(0)
    Unit cur, nxt; int ui = 0;
    if (!S.next(0, cur)) return;
    f32x4 acc[2][2][4][2];
#pragma unroll
    for (int a = 0; a < 2; ++a)
#pragma unroll
        for (int b = 0; b < 2; ++b)
#pragma unroll
            for (int m = 0; m < 4; ++m)
#pragma unroll
                for (int n = 0; n < 2; ++n) acc[a][b][m][n] = (f32x4){0.f, 0.f, 0.f, 0.f};
    bf16x8 At[4][2], B0[2][2], B1[2][2];
    const char* cA = (const char*)g.A + (size_t)(cur.pn / g.a_grp) * g.a_grp_bytes + (size_t)cur.pm * tstep; const char* cB = (const char*)g.Bt + (size_t)cur.pn * tstep;
    S.a_ready(cur);
    if constexpr (SP2) {
        PG8_STAGE(PG8_SB(0, 0), cB, voffB); PG8_STAGE(PG8_SB(0, 1), cB + hstep, voffB); PG8_STAGE(PG8_SA(0, 0), cA, voffA); PG8_STAGE(PG8_SA(0, 1), cA + hstep, voffA);
        if (wr == 1) PG8_BAR;
        PG8_WAIT_V(2); PG8_BAR;
        PG8_STAGE(PG8_SB(1, 0), cB + kstep, voffB); PG8_STAGE(PG8_SA(1, 0), cA + kstep, voffA); PG8_STAGE(PG8_SB(1, 1), cB + hstep + kstep, voffB);
        PG8_WAIT_V(6); PG8_BAR;
    } else {
        PG8_STAGE(PG8_SB(0, 0), cB, voffB); PG8_STAGE(PG8_SA(0, 0), cA, voffA); PG8_STAGE(PG8_SB(0, 1), cB + hstep, voffB); PG8_STAGE(PG8_SA(0, 1), cA + hstep, voffA);
        if (wr == 1) PG8_BAR;
        PG8_WAIT_V(4); PG8_BAR;
        PG8_STAGE(PG8_SB(1, 0), cB + kstep, voffB); PG8_STAGE(PG8_SA(1, 0), cA + kstep, voffA); PG8_STAGE(PG8_SB(1, 1), cB + hstep + kstep, voffB);
        PG8_WAIT_V(6); PG8_BAR;
    }
    for (;;) {
        const bool has_next = S.next(ui + 1, nxt);
        const char* nA = has_next ? (const char*)g.A + (size_t)(nxt.pn / g.a_grp) * g.a_grp_bytes + (size_t)nxt.pm * tstep : cA; const char* nB = has_next ? (const char*)g.Bt + (size_t)nxt.pn * tstep : cB;
        for (int t = 0; t < nt; t += 2) {
            const bool last = (t == nt - 2);
            const char* a1 = cA + (size_t)(t + 1) * kstep;
            const char* a2 = last ? nA : cA + (size_t)(t + 2) * kstep; const char* b2 = last ? nB : cB + (size_t)(t + 2) * kstep;
            const char* a3 = a2 + kstep; const char* b3 = b2 + kstep;
            if (last && has_next) S.a_ready(nxt);
            if constexpr (SP2) {
            PG8_LDB(B0, 0, 0); PG8_LDB(B1, 0, 1); PG8_SCHED; PG8_LDA(At, 0, 0); PG8_STAGE(PG8_SA(1, 1), a1 + hstep, voffA);
            PG8_WAIT_V(8); PG8_WAIT_L(0); PG8_BAR; PG8_MMA(0, 0, At, B0); PG8_MMA(0, 1, At, B1); PG8_BAR; PG8_SCHED;
            PG8_LDA(At, 0, 1); PG8_STAGE(PG8_SB(0, 0), b2, voffB); PG8_STAGE(PG8_SB(0, 1), b2 + hstep, voffB); PG8_STAGE(PG8_SA(0, 0), a2, voffA);
            PG8_WAIT_V(8); PG8_WAIT_L(0); PG8_BAR; PG8_MMA(1, 0, At, B0); PG8_MMA(1, 1, At, B1); PG8_BAR; PG8_SCHED;
            PG8_LDB(B0, 1, 0); PG8_LDB(B1, 1, 1); PG8_SCHED; PG8_LDA(At, 1, 0); PG8_STAGE(PG8_SA(0, 1), a2 + hstep, voffA);
            PG8_WAIT_V(8); PG8_WAIT_L(0); PG8_BAR; PG8_MMA(0, 0, At, B0); PG8_MMA(0, 1, At, B1); PG8_BAR; PG8_SCHED;
            PG8_LDA(At, 1, 1); PG8_STAGE(PG8_SB(1, 0), b3, voffB); PG8_STAGE(PG8_SB(1, 1), b3 + hstep, voffB); PG8_STAGE(PG8_SA(1, 0), a3, voffA);
            PG8_WAIT_V(8); PG8_WAIT_L(0); PG8_BAR; PG8_MMA(1, 0, At, B0); PG8_MMA(1, 1, At, B1); PG8_BAR; PG8_SCHED;
            } else {
            PG8_LDB(B0, 0, 0); PG8_SCHED; PG8_LDA(At, 0, 0); PG8_STAGE(PG8_SA(1, 1), a1 + hstep, voffA);
            PG8_WAIT_L(8); PG8_BAR; PG8_WAIT_L(0); PG8_MMA(0, 0, At, B0); PG8_BAR; PG8_SCHED;
            PG8_LDB(B1, 0, 1); PG8_STAGE(PG8_SB(0, 0), b2, voffB);
            PG8_BAR; PG8_WAIT_L(0); PG8_MMA(0, 1, At, B1); PG8_BAR;
            PG8_LDA(At, 0, 1); PG8_STAGE(PG8_SA(0, 0), a2, voffA);
            PG8_BAR; PG8_WAIT_L(0); PG8_MMA(1, 0, At, B0); PG8_BAR; PG8_SCHED;
            PG8_STAGE(PG8_SB(0, 1), b2 + hstep, voffB);
            PG8_WAIT_V(6); PG8_BAR; PG8_MMA(1, 1, At, B1); PG8_BAR;
            PG8_LDB(B0, 1, 0); PG8_SCHED; PG8_LDA(At, 1, 0); PG8_STAGE(PG8_SA(0, 1), a2 + hstep, voffA);
            PG8_WAIT_L(8); PG8_BAR; PG8_WAIT_L(0); PG8_MMA(0, 0, At, B0); PG8_BAR; PG8_SCHED;
            PG8_LDB(B1, 1, 1); PG8_STAGE(PG8_SB(1, 0), b3, voffB);
            PG8_BAR; PG8_WAIT_L(0); PG8_MMA(0, 1, At, B1); PG8_BAR;
            PG8_LDA(At, 1, 1); PG8_STAGE(PG8_SA(1, 0), a3, voffA);
            PG8_BAR; PG8_WAIT_L(0); PG8_MMA(1, 0, At, B0); PG8_BAR; PG8_SCHED;
            PG8_STAGE(PG8_SB(1, 1), b3 + hstep, voffB);
            PG8_WAIT_V(6); PG8_BAR; PG8_MMA(1, 1, At, B1); PG8_BAR;
            }
        }
        if constexpr (ALIGN_EPI) { if (wr == 0) PG8_BAR; }
        if constexpr (!Epi::AFTER_DRAIN) { E(acc, cur, wr, wc, fr, fq); S.done(cur); }
        if (!has_next) break;
#pragma unroll
        for (int a = 0; a < 2; ++a)
#pragma unroll
            for (int b = 0; b < 2; ++b)
#pragma unroll
                for (int m = 0; m < 4; ++m)
#pragma unroll
                    for (int n = 0; n < 2; ++n) acc[a][b][m][n] = (f32x4){0.f, 0.f, 0.f, 0.f};
        cur = nxt; cA = nA; cB = nB; ++ui;
        if constexpr (ALIGN_EPI) { if (wr == 1) PG8_BAR; }
    }
    PG8_WAIT_V(0);
    if constexpr (!ALIGN_EPI) { if (wr == 0) PG8_BAR; }
    PG8_BAR;
    if constexpr (Epi::AFTER_DRAIN) { E.fused(acc, cur, wr, wc, fr, fq, lds, wid, lane); S.done(cur); }
#undef PG8_SA
#undef PG8_SB
#undef PG8_STAGE
#undef PG8_LDA
#undef PG8_LDB
#undef PG8_MMA
#undef PG8_WAIT_V
#undef PG8_WAIT_L
#undef PG8_BAR
#undef PG8_SCHED
}
}
#include <hip/hip_bf16.h>
#include <cmath>
namespace attn_body {
using bf16=__hip_bfloat16;
using bf16x8=__attribute__((ext_vector_type(8)))short;
using s16x4=__attribute__((ext_vector_type(4)))short;
using f32x16=__attribute__((ext_vector_type(16)))float;
using u32x4=__attribute__((ext_vector_type(4)))unsigned;
constexpr int D=64,PQ=4096,PO=512;
constexpr int NW=8,QBLK=32,QB=QBLK*NW,KVBLK=64;
__device__ __forceinline__ int crow(int r,int hi){return (r&3)+8*(r>>2)+4*hi;}
#define SBAR() __builtin_amdgcn_sched_barrier(0)
constexpr int NSLOT=3, SLOTB=8192;
constexpr int LDS_K=0, LDS_V=NSLOT*SLOTB, LDS_WS=2*NSLOT*SLOTB, LDS_OST=LDS_WS+NW*64*4, LDS_BYTES=LDS_OST+NW*4096;
constexpr float C2=0.125f*1.4426950408889634f;
__device__ __forceinline__ void glds16(const void*gsrc,unsigned lds_dst){unsigned keep;
  asm volatile("s_mov_b32 %0, m0\n\ts_mov_b32 m0, %2\n\ts_nop 0\n\tglobal_load_lds_dwordx4 %1, off\n\ts_mov_b32 m0, %0":"=&s"(keep):"v"(gsrc),"s"(lds_dst):"memory");}
__device__ __forceinline__ float max3f(float a,float b,float c){float r;asm("v_max3_f32 %0, %1, %2, %3":"=v"(r):"v"(a),"v"(b),"v"(c));return r;}
__device__ __forceinline__ float max2f(float a,float b){float r;asm("v_max_f32_e32 %0, %1, %2":"=v"(r):"v"(a),"v"(b));return r;}
__device__ __forceinline__ float fadd_s(float a,float b){float r;asm("v_add_f32_e32 %0, %1, %2":"=v"(r):"v"(a),"v"(b));return r;}
__device__ __forceinline__ float fsub_s(float a,float b){float r;asm("v_sub_f32_e32 %0, %1, %2":"=v"(r):"v"(a),"v"(b));return r;}
typedef float f32x2_t __attribute__((ext_vector_type(2))); typedef __bf16 bf16x2_t __attribute__((ext_vector_type(2)));
__device__ __forceinline__ unsigned cvtpk_s(float lo,float hi){f32x2_t v={lo,hi};bf16x2_t b=__builtin_convertvector(v,bf16x2_t);return __builtin_bit_cast(unsigned,b);}
#define WAIT_BAR(N) asm volatile("s_waitcnt vmcnt(" #N ") lgkmcnt(0)\n\ts_barrier":::"memory")

__device__ __forceinline__ void qkt(f32x16&p0,f32x16&p1,const char*Kslot,const bf16x8*qr,const f32x16&negm,int r32,int hi){
  const char*kb=Kslot+hi*1024+r32*16;
  #pragma unroll
  for(int d0=0;d0<4;++d0){
    const bf16x8 b0=*reinterpret_cast<const bf16x8*>(kb+d0*2048);
    const bf16x8 b1=*reinterpret_cast<const bf16x8*>(kb+d0*2048+512);
    if(d0==0){p0=__builtin_amdgcn_mfma_f32_32x32x16_bf16(b0,qr[0],negm,0,0,0);p1=__builtin_amdgcn_mfma_f32_32x32x16_bf16(b1,qr[0],negm,0,0,0);}
    else{p0=__builtin_amdgcn_mfma_f32_32x32x16_bf16(b0,qr[d0],p0,0,0,0);p1=__builtin_amdgcn_mfma_f32_32x32x16_bf16(b1,qr[d0],p1,0,0,0);}}
}
typedef __attribute__((address_space(3))) const char* lds_cptr;
typedef short v4i16_t __attribute__((ext_vector_type(4)));
__device__ __forceinline__ void kload8(bf16x8*kf,lds_cptr kp){
  kf[0]=*(const __attribute__((address_space(3))) bf16x8*)(kp);      kf[1]=*(const __attribute__((address_space(3))) bf16x8*)(kp+512);
  kf[2]=*(const __attribute__((address_space(3))) bf16x8*)(kp+2048); kf[3]=*(const __attribute__((address_space(3))) bf16x8*)(kp+2560);
  kf[4]=*(const __attribute__((address_space(3))) bf16x8*)(kp+4096); kf[5]=*(const __attribute__((address_space(3))) bf16x8*)(kp+4608);
  kf[6]=*(const __attribute__((address_space(3))) bf16x8*)(kp+6144); kf[7]=*(const __attribute__((address_space(3))) bf16x8*)(kp+6656);
}
__device__ __forceinline__ void kload2(bf16x8*kf,lds_cptr kp,int j){ kf[2*j]=*(const __attribute__((address_space(3))) bf16x8*)(kp+j*2048); kf[2*j+1]=*(const __attribute__((address_space(3))) bf16x8*)(kp+j*2048+512); }
__device__ __forceinline__ s16x4 vtr(lds_cptr p){ return __builtin_bit_cast(s16x4,__builtin_amdgcn_ds_read_tr16_b64_v4i16((__attribute__((address_space(3))) v4i16_t*)p)); }
__device__ __forceinline__ float rowmax(const f32x16&p0,const f32x16&p1){
  float a=max3f(p0[0],p0[1],p1[0]),b=max3f(p0[2],p0[3],p1[1]);a=max3f(a,p1[2],p1[3]);
  #pragma unroll
  for(int r=4;r<16;r+=4){a=max3f(a,p0[r],p0[r+1]);b=max3f(b,p0[r+2],p0[r+3]);a=max3f(a,p1[r],p1[r+1]);b=max3f(b,p1[r+2],p1[r+3]);}
  const float m=max2f(a,b);
  auto rr=__builtin_amdgcn_permlane32_swap(__float_as_uint(m),__float_as_uint(m),false,false);
  return max2f(__uint_as_float(rr[0]),__uint_as_float(rr[1]));
}
__device__ __forceinline__ void pv(f32x16*o,int vb,bf16x8 pa0,bf16x8 pa1,bf16x8 pa2,bf16x8 pa3){
  #pragma unroll
  for(int d0=0;d0<2;++d0){s16x4 lo[4],hi[4];
    #pragma unroll
    for(int ks=0;ks<4;++ks){
      asm volatile("ds_read_b64_tr_b16 %0,%1 offset:%c2":"=&v"(lo[ks]):"v"(vb),"i"(d0*4096+ks*1024):"memory");
      asm volatile("ds_read_b64_tr_b16 %0,%1 offset:%c2":"=&v"(hi[ks]):"v"(vb),"i"(d0*4096+ks*1024+512):"memory");}
    asm volatile("s_waitcnt lgkmcnt(0)":::"memory");SBAR();
    #define PK(k) (bf16x8){lo[k][0],lo[k][1],lo[k][2],lo[k][3],hi[k][0],hi[k][1],hi[k][2],hi[k][3]}
    o[d0]=__builtin_amdgcn_mfma_f32_32x32x16_bf16(pa0,PK(0),o[d0],0,0,0);
    o[d0]=__builtin_amdgcn_mfma_f32_32x32x16_bf16(pa1,PK(1),o[d0],0,0,0);
    o[d0]=__builtin_amdgcn_mfma_f32_32x32x16_bf16(pa2,PK(2),o[d0],0,0,0);
    o[d0]=__builtin_amdgcn_mfma_f32_32x32x16_bf16(pa3,PK(3),o[d0],0,0,0);
    #undef PK
  }
}

#ifndef ATTN_STORE16
#define ATTN_STORE16(p,v) (*(u32x4*)(p)=(v))
#endif
template<int THRL> __device__ __forceinline__ void attn_unit(const bf16*Qu,const bf16*__restrict__ Kh,const bf16*__restrict__ Vh,bf16*Ou,const int NT,char*shm){
  int tid_=threadIdx.x; asm volatile("":"+v"(tid_)); const int tid=tid_,lane=tid&63,r32=lane&31,hi=lane>>5; const int wid=__builtin_amdgcn_readfirstlane(tid>>6);
  const bf16*Qw=Qu+(long)(wid*QBLK)*PQ;
  const unsigned lds0=(unsigned)(uintptr_t)shm;
  float*wsf=(float*)(shm+LDS_WS)+wid*64;
  const bf16*ksrc=Kh+(long)lane*PQ+wid*8;
  const bf16*vsrc=Vh+(long)(16*(wid&3)+(lane>>2))*PQ+(wid>>2)*32+(lane&3)*8;
  const unsigned kdst=lds0+LDS_K+wid*1024, vdst=lds0+LDS_V+wid*1024;
  #define DMA_K(t,slot) glds16(ksrc+(long)(t)*KVBLK*PQ,(unsigned)__builtin_amdgcn_readfirstlane(kdst+(slot)))
  #define DMA_V(t,slot) glds16(vsrc+(long)(t)*KVBLK*PQ,(unsigned)__builtin_amdgcn_readfirstlane(vdst+(slot)))
  const int vb0=(int)(lds0+LDS_V)+((lane>>4)&1)*32+(lane&3)*8+(4*hi+((lane&15)>>2))*64;
  const char*Kbase=shm+LDS_K; bf16x8 kf[8];
  const lds_cptr shm3=(lds_cptr)shm; const lds_cptr kp0=shm3+LDS_K+hi*1024+r32*16; const lds_cptr vp0=shm3+LDS_V+((lane>>4)&1)*32+(lane&3)*8+(4*hi+((lane&15)>>2))*64;
  DMA_K(0,0);DMA_V(0,0);DMA_K(1,SLOTB);
  bf16x8 qr[4];
  #pragma unroll
  for(int d0=0;d0<4;++d0)qr[d0]=*reinterpret_cast<const bf16x8*>(&Qw[(long)r32*PQ+d0*16+hi*8]);
  float mhat=0.f,l_reg=0.f;f32x16 o[2];o[0]=f32x16{};o[1]=f32x16{};f32x16 negm=f32x16{};asm volatile("":"+v"(negm));
  #define CMASK(P0,P1,t) do{}while(0)
  bool resc=false;
  #define START(P0,P1) do{ const float rm=rowmax(P0,P1); resc=false; \
    { const float dl=rm; mhat=fadd_s(mhat,dl); \
      _Pragma("unroll") for(int r=0;r<16;++r){P0[r]=fsub_s(P0[r],dl);P1[r]=fsub_s(P1[r],dl);} \
      _Pragma("unroll") for(int r=0;r<16;++r)negm[r]=-mhat; asm volatile("":"+v"(negm)); } \
    _Pragma("unroll") for(int r=0;r<16;++r)P0[r]=__builtin_amdgcn_exp2f(P0[r]); }while(0)
  #define RESC() do{ if(resc){ asm volatile("s_waitcnt lgkmcnt(0)":::"memory"); \
      _Pragma("unroll") for(int d_=0;d_<2;++d_) _Pragma("unroll") for(int r=0;r<16;++r)o[d_][r]*=wsf[crow(r,hi)]; } }while(0)
  f32x16 pA0,pA1,pB0,pB1;
  int sl_prev=0,sl_cur=0,sl_next=SLOTB;
  #define ROT() do{sl_prev=sl_cur;sl_cur=sl_next;sl_next=(sl_next==(NSLOT-1)*SLOTB)?0:sl_next+SLOTB;}while(0)
  DMA_K(2,2*SLOTB);
  WAIT_BAR(3);
  qkt(pA0,pA1,Kbase,qr,negm,r32,hi);asm volatile("s_nop 15\n\ts_nop 7":"+v"(pA0),"+v"(pA1));CMASK(pA0,pA1,0);
  START(pA0,pA1);
  _Pragma("unroll") for(int r=0;r<16;++r)pA1[r]=__builtin_amdgcn_exp2f(pA1[r]);
  WAIT_BAR(0);
  DMA_K(3,0);DMA_V(1,SLOTB);
  ROT();
  kload8(kf,kp0+sl_cur);
  WAIT_BAR(2);
  s16x4 vlo[8],vhi[8]; u32x4 pw0,pw1,pw2,pw3;
  #define PKW(P,B) cvtpk_s(P[B],P[B+1])
  #define PAF(k) __builtin_bit_cast(bf16x8,pw##k)
  #define VFR(i) (bf16x8){vlo[i][0],vlo[i][1],vlo[i][2],vlo[i][3],vhi[i][0],vhi[i][1],vhi[i][2],vhi[i][3]}
  #define PIN(x) asm volatile("":"+v"(x))
  #define MX3(a,b,c) __builtin_fmaxf(__builtin_fmaxf((a),(b)),(c))
  #define GAPA(MF,A0,A1,A2,A3,W0,W1,PW) do{ MF; sacc+=A0; sacc+=A1; sacc+=A2; sacc+=A3; PIN(sacc); W0; W1; PIN(PW); SBAR(); }while(0)
  #define EX(v) __builtin_amdgcn_exp2f(v)
  #define GAPB(MF,X,B) do{ MF; X[B]=EX(X[B]); X[B+1]=EX(X[B+1]); X[B+2]=EX(X[B+2]); X[B+3]=EX(X[B+3]); PIN(X); SBAR(); }while(0)
  #define VRD(i) do{ vlo[i]=vtr(vp_+(((i)>>2)*4096+((i)&3)*1024)); vhi[i]=vtr(vp_+(((i)>>2)*4096+((i)&3)*1024+512)); }while(0)
  #define KRD(G,j) do{ if(G){ kload2(kf,kp0+sl_next,j); SBAR(); } }while(0)
  #define STEP(C0,C1,P0,P1,t,GK,GV,GL) do{ SBAR(); \
    const lds_cptr vp_=vp0+sl_prev; \
    VRD(0); SBAR(); float sacc=(P0[0]+P0[1]); \
    GAPA(C0=__builtin_amdgcn_mfma_f32_32x32x16_bf16(kf[0],qr[0],negm,0,0,0), P0[2],P0[3],P0[4],P0[5],     pw0[0]=PKW(P0,0), pw0[1]=PKW(P0,2), pw0); \
    VRD(4); SBAR(); GAPA(C1=__builtin_amdgcn_mfma_f32_32x32x16_bf16(kf[1],qr[0],negm,0,0,0), P0[6],P0[7],P0[8],P0[9],     pw0[2]=PKW(P0,4), pw0[3]=PKW(P0,6), pw0); \
    VRD(1); SBAR(); GAPA(C0=__builtin_amdgcn_mfma_f32_32x32x16_bf16(kf[2],qr[1],C0,0,0,0),   P0[10],P0[11],P0[12],P0[13], pw1[0]=PKW(P0,8), pw1[1]=PKW(P0,10), pw1); \
    VRD(5); SBAR(); GAPA(C1=__builtin_amdgcn_mfma_f32_32x32x16_bf16(kf[3],qr[1],C1,0,0,0),   P0[14],P0[15],P1[0],P1[1],   pw1[2]=PKW(P0,12),pw1[3]=PKW(P0,14), pw1); \
    VRD(2); SBAR(); GAPA(C0=__builtin_amdgcn_mfma_f32_32x32x16_bf16(kf[4],qr[2],C0,0,0,0),   P1[2],P1[3],P1[4],P1[5],     pw2[0]=PKW(P1,0), pw2[1]=PKW(P1,2), pw2); \
    VRD(6); SBAR(); GAPA(C1=__builtin_amdgcn_mfma_f32_32x32x16_bf16(kf[5],qr[2],C1,0,0,0),   P1[6],P1[7],P1[8],P1[9],     pw2[2]=PKW(P1,4), pw2[3]=PKW(P1,6), pw2); \
    VRD(3); SBAR(); GAPA(C0=__builtin_amdgcn_mfma_f32_32x32x16_bf16(kf[6],qr[3],C0,0,0,0),   P1[10],P1[11],P1[12],P1[13], pw3[0]=PKW(P1,8), pw3[1]=PKW(P1,10), pw3); \
    VRD(7); SBAR(); GAPA(C1=__builtin_amdgcn_mfma_f32_32x32x16_bf16(kf[7],qr[3],C1,0,0,0),   P1[14],P1[15],0.f,0.f,       pw3[2]=PKW(P1,12),pw3[3]=PKW(P1,14), pw3); \
    l_reg+=sacc; \
    if(GK){DMA_K((t)+3,sl_cur);} if(GV){DMA_V((t)+1,sl_next);} \
    CMASK(C0,C1,t); \
    { float a=MX3(C0[0],C0[1],C1[0]),b=MX3(C0[2],C0[3],C1[1]); a=MX3(a,C1[2],C1[3]); \
      _Pragma("unroll") for(int r=4;r<16;r+=4){a=MX3(a,C0[r],C0[r+1]);b=MX3(b,C0[r+2],C0[r+3]);a=MX3(a,C1[r],C1[r+1]);b=MX3(b,C1[r+2],C1[r+3]);} \
      float rm=__builtin_fmaxf(a,b); { auto rr=__builtin_amdgcn_permlane32_swap(__float_as_uint(rm),__float_as_uint(rm),false,false); rm=__builtin_fmaxf(__uint_as_float(rr[0]),__uint_as_float(rr[1])); } \
      resc=false; \
      if(__builtin_expect(__any(rm>(float)THRL),0)){ const float dl=__builtin_fmaxf(rm,0.f); mhat+=dl; \
        _Pragma("unroll") for(int r=0;r<16;++r){C0[r]-=dl;C1[r]-=dl;} \
        _Pragma("unroll") for(int r=0;r<16;++r)negm[r]=-mhat; asm volatile("":"+v"(negm)); \
        const float f=__builtin_amdgcn_exp2f(-dl); l_reg*=f; if(hi==0)wsf[r32]=f; resc=true; } } \
    SBAR(); \
    GAPB(o[0]=__builtin_amdgcn_mfma_f32_32x32x16_bf16(PAF(0),VFR(0),o[0],0,0,0), C0,0); \
    GAPB(o[1]=__builtin_amdgcn_mfma_f32_32x32x16_bf16(PAF(0),VFR(4),o[1],0,0,0), C0,4); \
    KRD(GL,0); GAPB(o[0]=__builtin_amdgcn_mfma_f32_32x32x16_bf16(PAF(1),VFR(1),o[0],0,0,0), C0,8); \
    KRD(GL,1); GAPB(o[1]=__builtin_amdgcn_mfma_f32_32x32x16_bf16(PAF(1),VFR(5),o[1],0,0,0), C0,12); \
    KRD(GL,2); GAPB(o[0]=__builtin_amdgcn_mfma_f32_32x32x16_bf16(PAF(2),VFR(2),o[0],0,0,0), C1,0); \
    KRD(GL,3); GAPB(o[1]=__builtin_amdgcn_mfma_f32_32x32x16_bf16(PAF(2),VFR(6),o[1],0,0,0), C1,4); \
    GAPB(o[0]=__builtin_amdgcn_mfma_f32_32x32x16_bf16(PAF(3),VFR(3),o[0],0,0,0), C1,8); \
    GAPB(o[1]=__builtin_amdgcn_mfma_f32_32x32x16_bf16(PAF(3),VFR(7),o[1],0,0,0), C1,12); \
    }while(0)
  int t=1;
  #undef CMASK
  #define CMASK(P0,P1,t) do{}while(0)
  for(;t+5<NT;t+=2){
    STEP(pB0,pB1,pA0,pA1,t,true,true,true);     WAIT_BAR(2); RESC(); ROT();
    STEP(pA0,pA1,pB0,pB1,t+1,true,true,true);   WAIT_BAR(2); RESC(); ROT();
  }
  #undef CMASK
  #define CMASK(P0,P1,t) do{}while(0)
  #define ENDW(tt) do{ if((tt)+3<NT){WAIT_BAR(2);} else if((tt)+2<NT){WAIT_BAR(1);} else {WAIT_BAR(0);} }while(0)
  for(;t+1<NT;t+=2){
    STEP(pB0,pB1,pA0,pA1,t,(t+3<NT),(t+1<NT),(t+1<NT));       ENDW(t);   RESC(); ROT();
    STEP(pA0,pA1,pB0,pB1,t+1,(t+4<NT),(t+2<NT),(t+2<NT));     ENDW(t+1); RESC(); ROT();
  }
  STEP(pB0,pB1,pA0,pA1,NT-1,false,false,false); RESC();
  { float sacc=pB0[0]+pB0[1]; _Pragma("unroll") for(int r=2;r<16;++r)sacc+=pB0[r]; _Pragma("unroll") for(int r=0;r<16;++r)sacc+=pB1[r]; l_reg+=sacc;
    pw0=(u32x4){PKW(pB0,0),PKW(pB0,2),PKW(pB0,4),PKW(pB0,6)};pw1=(u32x4){PKW(pB0,8),PKW(pB0,10),PKW(pB0,12),PKW(pB0,14)};pw2=(u32x4){PKW(pB1,0),PKW(pB1,2),PKW(pB1,4),PKW(pB1,6)};pw3=(u32x4){PKW(pB1,8),PKW(pB1,10),PKW(pB1,12),PKW(pB1,14)};
    SBAR(); pv(o,vb0+sl_cur,PAF(0),PAF(1),PAF(2),PAF(3)); }
  #undef PKW
  #undef PAF
  #undef VFR
  #undef PIN
  #undef MX3
  #undef GAPA
  #undef GAPB
  #undef EX
  #undef VRD
  #undef KRD
  #undef STEP
  #undef ENDW
  {auto rr=__builtin_amdgcn_permlane32_swap(__float_as_uint(l_reg),__float_as_uint(l_reg),false,false);l_reg=__uint_as_float(rr[0])+__uint_as_float(rr[1]);}
  if(hi==0)wsf[32+r32]=l_reg;asm volatile("s_waitcnt lgkmcnt(0)":::"memory");
  float rli[16];
  #pragma unroll
  for(int r=0;r<16;++r)rli[r]=__builtin_amdgcn_rcpf(wsf[32+crow(r,hi)]);
  bf16*Ow=Ou+(long)(wid*QBLK)*PO;
  { bf16*stg=(bf16*)(shm+LDS_OST)+wid*2048;
    #pragma unroll
    for(int r=0;r<16;++r){const int orow=crow(r,hi);
      #pragma unroll
      for(int d0=0;d0<2;++d0)stg[orow*64+d0*32+r32]=__float2bfloat16(o[d0][r]*rli[r]);}
    asm volatile("s_waitcnt lgkmcnt(0)":::"memory");
    #pragma unroll
    for(int i=0;i<4;++i){const int row=i*8+(lane>>3),ch=lane&7; const u32x4 v=*(const u32x4*)(stg+row*64+ch*8); ATTN_STORE16(Ow+(long)row*PO+ch*8,v);} }
  asm volatile("s_waitcnt lgkmcnt(0)\n\ts_barrier":::"memory");
  #undef DMA_K
  #undef DMA_V
  #undef CMASK
  #undef START
  #undef RESC
  #undef ROT
}
constexpr int ATTN_LDS_BYTES=LDS_BYTES;
#undef SBAR
#undef WAIT_BAR
}
#define GAS __attribute__((address_space(1)))
#define LAS __attribute__((address_space(3)))
typedef unsigned short bf16;
typedef unsigned v4u __attribute__((ext_vector_type(4)));
typedef unsigned v2u __attribute__((ext_vector_type(2)));
typedef float f32x4 __attribute__((ext_vector_type(4)));
typedef short bf16x8 __attribute__((ext_vector_type(8)));
#define LDS_WAIT() asm volatile("s_waitcnt lgkmcnt(0)" ::: "memory")

constexpr int NWAVES = 8;
constexpr int DM = 1024, FF = 4096, DEPTH = 2;
constexpr int MH = 24576, MP = 16384;
constexpr int SP = 2048, SS = 8192;
constexpr int PW = 4096, INW = 3872;
constexpr int C_AQ = 0, C_AK = 512, C_AV = 640, C_GQ = 768, C_GK = 1024, C_GV = 1280, C_GA = 1792, C_GG = 1824, C_RQ = 2336, C_RK = 2592, C_RV = 2848, C_RG = 3360;
constexpr float EPS = 1e-6f;
constexpr float ATT_C2 = 0.125f * 1.4426950408889634f;

constexpr size_t MiB = 1u << 20;
constexpr size_t WS_CTL = 0, CTL_ZERO_BYTES = 65536;
constexpr int CW_BAR = 4096;
constexpr size_t WS_W = 1 * MiB, LW = 35 * MiB;
constexpr size_t OW_IN = 0, OW_MERGE = 8 * MiB, OW_BR = 14 * MiB, OW_OUT = 17 * MiB, OW_UP = 19 * MiB, OW_DOWN = 27 * MiB;
constexpr size_t WS_XN = 71 * MiB;
constexpr size_t WS_PROJ = 119 * MiB;
constexpr size_t WS_MERGED = WS_PROJ + 144 * MiB;
constexpr size_t WS_OBUF = 311 * MiB;
constexpr size_t OB1 = (size_t)MH * 512;
constexpr size_t WS_SCF = 431 * MiB, WS_SCD = 443 * MiB;
constexpr size_t WS_END = 444 * MiB;

constexpr int RING_BYTES = 131072, MISC_OFF = RING_BYTES + 320, LDS_BYTES = 147456;

__device__ __forceinline__ unsigned f2bf(float f) { unsigned u = __builtin_bit_cast(unsigned, f); return (u + 0x7fffu + ((u >> 16) & 1u)) >> 16; }
__device__ __forceinline__ unsigned pk2(float lo, float hi) { return f2bf(lo) | (f2bf(hi) << 16); }
__device__ __forceinline__ float bf_lo(unsigned w) { return __builtin_bit_cast(float, w << 16); }
__device__ __forceinline__ float bf_hi(unsigned w) { return __builtin_bit_cast(float, w & 0xffff0000u); }
__device__ __forceinline__ float bf1(unsigned short h) { return __builtin_bit_cast(float, (unsigned)h << 16); }
__device__ __forceinline__ void unpack8(const v4u w, float (&v)[8]) { v[0] = bf_lo(w.x); v[1] = bf_hi(w.x); v[2] = bf_lo(w.y); v[3] = bf_hi(w.y); v[4] = bf_lo(w.z); v[5] = bf_hi(w.z); v[6] = bf_lo(w.w); v[7] = bf_hi(w.w); }
__device__ __forceinline__ v4u pack8(const float (&v)[8]) { v4u w; w.x = pk2(v[0], v[1]); w.y = pk2(v[2], v[3]); w.z = pk2(v[4], v[5]); w.w = pk2(v[6], v[7]); return w; }
__device__ __forceinline__ float wave_sum(float v) {
#pragma unroll
    for (int o = 1; o < 64; o <<= 1) v += __shfl_xor(v, o);
    return v;
}
__device__ __forceinline__ float sigmoidf_fast(float a) { return __builtin_amdgcn_rcpf(1.0f + __builtin_amdgcn_exp2f(-1.4426950408889634f * a)); }

__device__ __forceinline__ void p0_transpose_item(const float* W, int K, int N, bf16* WT, int row_off, LAS float* scr, int item, int lane) {
    const int nblk = N / 32, kb = item / nblk, nb = item % nblk, k0 = 64 * kb, n0 = 32 * nb;
#pragma unroll 8
    for (int i = 0; i < 32; ++i) { const int kk = 2 * i + (lane >> 5); scr[kk * 33 + (lane & 31)] = W[(size_t)(k0 + kk) * N + n0 + (lane & 31)]; }
    LDS_WAIT(); asm volatile("" ::: "memory");
    const int c = lane & 7;
#pragma unroll
    for (int j = 0; j < 4; ++j) { const int n = (lane >> 3) + 8 * j; const LAS float* s = scr + (8 * c) * 33 + n;
        v4u o; o.x = pk2(s[0 * 33], s[1 * 33]); o.y = pk2(s[2 * 33], s[3 * 33]); o.z = pk2(s[4 * 33], s[5 * 33]); o.w = pk2(s[6 * 33], s[7 * 33]);
        *(v4u*)(WT + (size_t)(row_off + n0 + n) * K + k0 + 8 * c) = o; }
    LDS_WAIT(); asm volatile("" ::: "memory");
}

__device__ __forceinline__ void norm_rows(const float* xp, const float* xs, const float* gain, bf16* XN, int gw, int NGW, int lane_in) {
    int lane = lane_in; asm volatile("" : "+v"(lane)); asm volatile("" : "+s"(gw));
    f32x4 g[4];
#pragma unroll
    for (int j = 0; j < 4; ++j) g[j] = *((const f32x4*)gain + lane + 64 * j);
    for (int m = gw; m < MH; m += NGW) {
        const float* xrow = m < MP ? xp + (size_t)m * DM : xs + (size_t)(m - MP) * DM;
        const f32x4* xr = (const f32x4*)xrow + lane;
        f32x4 v[4]; float s = 0.f;
#pragma unroll
        for (int j = 0; j < 4; ++j) { v[j] = xr[64 * j]; s += (v[j].x * v[j].x + v[j].y * v[j].y) + (v[j].z * v[j].z + v[j].w * v[j].w); }
        const float rstd = 1.0f / sqrtf(wave_sum(s) * (1.f / DM) + EPS);
        unsigned long long* o8 = (unsigned long long*)(XN + (size_t)m * DM) + lane;
#pragma unroll
        for (int j = 0; j < 4; ++j) { const f32x4 y = v[j] * rstd * g[j]; o8[64 * j] = (unsigned long long)pk2(y.x, y.y) | ((unsigned long long)pk2(y.z, y.w) << 32); }
    }
}
__device__ __forceinline__ void final_norm(float* out, const float* gain, int gw, int NGW, int lane_in) {
    int lane = lane_in; asm volatile("" : "+v"(lane)); asm volatile("" : "+s"(gw));
    f32x4 g[4];
#pragma unroll
    for (int j = 0; j < 4; ++j) g[j] = *((const f32x4*)gain + lane + 64 * j);
    for (int m = gw; m < 2 * MH; m += NGW) {
        f32x4* xr = (f32x4*)(out + (size_t)m * DM) + lane;
        f32x4 v[4]; float s = 0.f;
#pragma unroll
        for (int j = 0; j < 4; ++j) { v[j] = xr[64 * j]; s += (v[j].x * v[j].x + v[j].y * v[j].y) + (v[j].z * v[j].z + v[j].w * v[j].w); }
        const float rstd = 1.0f / sqrtf(wave_sum(s) * (1.f / DM) + EPS);
#pragma unroll
        for (int j = 0; j < 4; ++j) xr[64 * j] = v[j] * rstd * g[j];
    }
}

__device__ __forceinline__ void rope8(float (&v)[8], int lane, int t) {
    const int sub = lane & 7;
    const float pos = (float)((sub & 4) ? (t & 63) : (t >> 6));
    const bool upper = (sub & 2) != 0;
    const int i0 = 8 * (sub & 1);
#pragma unroll
    for (int e = 0; e < 8; ++e) {
        const float partner = __shfl_xor(v[e], 2);
        const float inv = __builtin_amdgcn_exp2f(-(float)(i0 + e) * 0.8304820237218406f);
        const float ang = pos * inv, s = __sinf(ang), c = __cosf(ang);
        v[e] = v[e] * c + (upper ? partner : -partner) * s;
    }
}
__device__ __forceinline__ float sum8lanes(float s) { s += __shfl_xor(s, 1); s += __shfl_xor(s, 2); s += __shfl_xor(s, 4); return s; }
__device__ __forceinline__ void e1_rows(bf16* proj, const float* qg, const float* kg, int gw, int NGW, int lane_in) {
    int lane = lane_in; asm volatile("" : "+v"(lane)); asm volatile("" : "+s"(gw));
    float gq[8], gk[8];
#pragma unroll
    for (int e = 0; e < 8; ++e) { gq[e] = qg[8 * (lane & 7) + e]; gk[e] = kg[8 * (lane & 7) + e]; }
    for (int m = gw; m < MH; m += NGW) {
        const int t = m < MP ? (m & (SP - 1)) : (m - MP);
        bf16* row = proj + (size_t)m * PW;
        { v4u w = *(const v4u*)(row + C_AQ + 8 * lane); float v[8]; unpack8(w, v);
          float s = 0.f;
#pragma unroll
          for (int e = 0; e < 8; ++e) s += v[e] * v[e];
          const float rstd = 1.0f / sqrtf(sum8lanes(s) * (1.f / 64.f) + EPS);
#pragma unroll
          for (int e = 0; e < 8; ++e) v[e] = v[e] * rstd * gq[e];
          rope8(v, lane, t);
#pragma unroll
          for (int e = 0; e < 8; ++e) v[e] *= ATT_C2;
          *(v4u*)(row + C_AQ + 8 * lane) = pack8(v); }
        { const int l2 = lane & 15; v4u w = *(const v4u*)(row + C_AK + 8 * l2); float v[8]; unpack8(w, v);
          float s = 0.f;
#pragma unroll
          for (int e = 0; e < 8; ++e) s += v[e] * v[e];
          const float rstd = 1.0f / sqrtf(sum8lanes(s) * (1.f / 64.f) + EPS);
#pragma unroll
          for (int e = 0; e < 8; ++e) v[e] = v[e] * rstd * gk[e];
          rope8(v, lane, t);
          if (lane < 16) *(v4u*)(row + C_AK + 8 * l2) = pack8(v); }
        { const int l2 = lane & 31;
          if (lane < 32) { v4u w = *(const v4u*)(row + C_GQ + 8 * l2); float v[8]; unpack8(w, v);
#pragma unroll
              for (int e = 0; e < 8; ++e) v[e] *= 0.125f;
              *(v4u*)(row + C_GQ + 8 * l2) = pack8(v); }
          bf16* p = row + (lane < 32 ? C_RQ : C_RK) + 8 * l2;
          v4u w = *(const v4u*)p; float v[8]; unpack8(w, v);
          rope8(v, lane, t);
          const float sc = lane < 32 ? 1.0f : 0.125f;
#pragma unroll
          for (int e = 0; e < 8; ++e) v[e] *= sc;
          *(v4u*)p = pack8(v); }
    }
}

__device__ __forceinline__ float sum16lanes(float s) { s += __shfl_xor(s, 1); s += __shfl_xor(s, 2); s += __shfl_xor(s, 4); s += __shfl_xor(s, 8); return s; }
__device__ __forceinline__ void e2_rows(const bf16* proj, bf16* obuf, const float* ggain, int gw, int NGW, int lane_in) {
    int lane = lane_in; asm volatile("" : "+v"(lane)); asm volatile("" : "+s"(gw));
    float gn[8];
#pragma unroll
    for (int e = 0; e < 8; ++e) gn[e] = ggain[8 * (lane & 15) + e];
    for (int m = gw; m < MH; m += NGW) {
        const bf16* prow = proj + (size_t)m * PW; const size_t o = (size_t)m * 512 + 8 * lane;
        { float a[8], b[8], g[8]; unpack8(*(const v4u*)(obuf + 1 * OB1 + o), a); unpack8(*(const v4u*)(obuf + 3 * OB1 + o), b); unpack8(*(const v4u*)(prow + C_GG + 8 * lane), g);
          float s = 0.f;
#pragma unroll
          for (int e = 0; e < 8; ++e) { a[e] += b[e]; s += a[e] * a[e]; }
          const float rstd = 1.0f / sqrtf(sum16lanes(s) * (1.f / 128.f) + EPS);
#pragma unroll
          for (int e = 0; e < 8; ++e) a[e] = a[e] * rstd * gn[e] * (g[e] * sigmoidf_fast(g[e]));
          *(v4u*)(obuf + 1 * OB1 + o) = pack8(a); }
        { float a[8], b[8], g[8]; unpack8(*(const v4u*)(obuf + 2 * OB1 + o), a); unpack8(*(const v4u*)(obuf + 4 * OB1 + o), b); unpack8(*(const v4u*)(prow + C_RG + 8 * lane), g);
          float s = 0.f;
#pragma unroll
          for (int e = 0; e < 8; ++e) { a[e] += b[e]; s += a[e]; }
          const float mu = sum16lanes(s) * (1.f / 128.f); float q = 0.f;
#pragma unroll
          for (int e = 0; e < 8; ++e) { a[e] -= mu; q += a[e] * a[e]; }
          const float rstd = 1.0f / sqrtf(sum16lanes(q) * (1.f / 128.f) + EPS);
#pragma unroll
          for (int e = 0; e < 8; ++e) a[e] = a[e] * rstd * (g[e] * sigmoidf_fast(g[e]));
          *(v4u*)(obuf + 2 * OB1 + o) = pack8(a); }
    }
}

constexpr int SC_LD = 72;
constexpr int SC_QIN = 0, SC_KIN = 9216, SC_QB = 18432, SC_KDT = 27648, SC_SM = 36864, SC_VT = 46080, SC_TOT = 64512, SC_DEC = 66560, SC_ZS = 66816, SC_END = 70912;
template <bool GLA, bool STATE_ONLY> __device__ __forceinline__ void scan_unit(LAS unsigned char* shm, const bf16* proj, bf16* outb, int row0, int len, int h, int dir,
                                                              const float* wg, const float* bg, float lgam, int c0, int c1, const float* Fprev, const float* Dprev, int nprev, float* Fout, float* Dout) {
    int tid_ = threadIdx.x; asm volatile("" : "+v"(tid_)); const int tid = tid_, lane = tid & 63, wid = __builtin_amdgcn_readfirstlane(tid >> 6), fr = lane & 15, fq = lane >> 4;
    const int cq = (GLA ? C_GQ : C_RQ) + h * 64, ck = (GLA ? C_GK : C_RK) + h * 64, cv = (GLA ? C_GV : C_RV) + h * 128, cz = C_GA + dir * 16;
    LAS bf16* qin = (LAS bf16*)(shm + SC_QIN); LAS bf16* kin = (LAS bf16*)(shm + SC_KIN); LAS bf16* qb = (LAS bf16*)(shm + SC_QB);
    LAS bf16* kdT = (LAS bf16*)(shm + SC_KDT); LAS bf16* sm = (LAS bf16*)(shm + SC_SM); LAS bf16* vT = (LAS bf16*)(shm + SC_VT);
    LAS float* tot = (LAS float*)(shm + SC_TOT); LAS float* dec = (LAS float*)(shm + SC_DEC); LAS float* zs = (LAS float*)(shm + SC_ZS);
    float w[16]; float bias = 0.f;
    if (GLA) {
#pragma unroll
        for (int r = 0; r < 16; ++r) w[r] = wg[r * 256 + h * 64 + lane];
        bias = bg[h * 64 + lane];
    }
    f32x4 S[4];
#pragma unroll
    for (int i = 0; i < 4; ++i) S[i] = (f32x4){0.f, 0.f, 0.f, 0.f};
    if (!STATE_ONLY) {
        for (int s = 0; s < nprev; ++s) {
#pragma unroll
            for (int db = 0; db < 4; ++db)
#pragma unroll
                for (int r = 0; r < 4; ++r) { const int d = db * 16 + 4 * fq + r; S[db][r] = S[db][r] * Dprev[s * 64 + d] + Fprev[(size_t)s * 8192 + d * 128 + 16 * wid + fr]; }
        }
    }
    float sumlog = 0.f;
    unsigned short qr[8], kr[8]; v4u vr0, vr1, zr;
    unsigned short qn[8], kn[8]; v4u vn0, vn1, zn;
#define SC_ROW(c, i) (dir == 0 ? row0 + (c) * 64 + (i) : row0 + len - 1 - ((c) * 64 + (i)))
#define SC_LOAD(c, Q, K, V0, V1, Z) do { \
        _Pragma("unroll") for (int e = 0; e < 8; ++e) { const bf16* rp = proj + (size_t)SC_ROW(c, 8 * wid + e) * PW; if (!STATE_ONLY) Q[e] = rp[cq + lane]; K[e] = rp[ck + lane]; } \
        { const bf16* rp = proj + (size_t)SC_ROW(c, lane) * PW + cv + 16 * wid; V0 = *(const v4u*)rp; V1 = *(const v4u*)(rp + 8); } \
        if (GLA) { if (tid < 128) Z = *(const v4u*)(proj + (size_t)SC_ROW(c, tid >> 1) * PW + cz + 8 * (tid & 1)); } } while (0)
    zr = (v4u){0u, 0u, 0u, 0u}; zn = zr;
#pragma unroll
    for (int e = 0; e < 8; ++e) { qr[e] = 0; qn[e] = 0; }
    SC_LOAD(c0, qr, kr, vr0, vr1, zr);
    for (int c = c0; c < c1; ++c) {
        float la[8];
        if (GLA) {
            if (tid < 128) { float z[8]; unpack8(zr, z); LAS float* zp = zs + (tid >> 1) * 16 + 8 * (tid & 1);
                *(LAS f32x4*)zp = (f32x4){z[0], z[1], z[2], z[3]}; *(LAS f32x4*)(zp + 4) = (f32x4){z[4], z[5], z[6], z[7]}; }
            __syncthreads();
#pragma unroll
            for (int e = 0; e < 8; ++e) { const LAS f32x4* zp = (const LAS f32x4*)(zs + (8 * wid + e) * 16); float a = bias;
#pragma unroll
                for (int r4 = 0; r4 < 4; ++r4) { const f32x4 zz = zp[r4]; a += zz.x * w[4 * r4] + zz.y * w[4 * r4 + 1] + zz.z * w[4 * r4 + 2] + zz.w * w[4 * r4 + 3]; }
                la[e] = (fminf(a, 0.f) - __logf(1.0f + __expf(-fabsf(a)))) * 0.0625f; }
        } else {
#pragma unroll
            for (int e = 0; e < 8; ++e) la[e] = lgam;
        }
        float p[8]; p[0] = la[0];
#pragma unroll
        for (int e = 1; e < 8; ++e) p[e] = p[e - 1] + la[e];
        tot[wid * 64 + lane] = p[7];
        __syncthreads();
        float off = 0.f, bref = 0.f, blast = 0.f;
#pragma unroll
        for (int g = 0; g < 8; ++g) { const float tg = tot[g * 64 + lane]; if (g < wid) off += tg; if (g < 4) bref += tg; blast += tg; }
        {
            unsigned kdp[4];
            float kdv[8];
#pragma unroll
            for (int e = 0; e < 8; ++e) { const float b = off + p[e], q = bf1(qr[e]), k = bf1(kr[e]); const int i = 8 * wid + e;
                if (!STATE_ONLY) {
                qin[i * SC_LD + lane] = (bf16)f2bf(q * __expf(b - bref));
                kin[i * SC_LD + lane] = (bf16)f2bf(k * __expf(bref - b));
                qb[i * SC_LD + lane] = (bf16)f2bf(q * __expf(b)); }
                kdv[e] = k * __expf(blast - b); }
#pragma unroll
            for (int e = 0; e < 4; ++e) kdp[e] = pk2(kdv[2 * e], kdv[2 * e + 1]);
            *(LAS v4u*)(kdT + lane * SC_LD + 8 * wid) = (v4u){kdp[0], kdp[1], kdp[2], kdp[3]};
            if (wid == 0) dec[lane] = __expf(blast);
            sumlog += blast;
            const unsigned vw[8] = {vr0.x, vr0.y, vr0.z, vr0.w, vr1.x, vr1.y, vr1.z, vr1.w};
#pragma unroll
            for (int e = 0; e < 8; ++e) { vT[(16 * wid + 2 * e) * SC_LD + lane] = (bf16)(vw[e] & 0xffffu); vT[(16 * wid + 2 * e + 1) * SC_LD + lane] = (bf16)(vw[e] >> 16); }
        }
        __syncthreads();
        if (c + 1 < c1) SC_LOAD(c + 1, qn, kn, vn0, vn1, zn);
        if (!STATE_ONLY) {
#pragma unroll
        for (int tt = 0; tt < 2; ++tt) { const int idx = 2 * wid + tt, ti = idx >> 2, tj = idx & 3;
            f32x4 a = (f32x4){0.f, 0.f, 0.f, 0.f};
            if (tj <= ti) {
#pragma unroll
                for (int ks = 0; ks < 2; ++ks) { const bf16x8 A = *(const LAS bf16x8*)(qin + (ti * 16 + fr) * SC_LD + 32 * ks + 8 * fq), B = *(const LAS bf16x8*)(kin + (tj * 16 + fr) * SC_LD + 32 * ks + 8 * fq);
                    a = __builtin_amdgcn_mfma_f32_16x16x32_bf16(A, B, a, 0, 0, 0); } }
            const int j = tj * 16 + fr;
#pragma unroll
            for (int r = 0; r < 4; ++r) { const int i = ti * 16 + 4 * fq + r; sm[i * SC_LD + j] = (bf16)f2bf(j <= i ? a[r] : 0.f); } }
        __syncthreads();
        }
        {
            bf16x8 bv[2];
#pragma unroll
            for (int ks = 0; ks < 2; ++ks) bv[ks] = *(const LAS bf16x8*)(vT + (16 * wid + fr) * SC_LD + 32 * ks + 8 * fq);
            if (!STATE_ONLY) {
            f32x4 o[4];
#pragma unroll
            for (int ib = 0; ib < 4; ++ib) { o[ib] = (f32x4){0.f, 0.f, 0.f, 0.f};
#pragma unroll
                for (int ks = 0; ks < 2; ++ks) { const bf16x8 A = *(const LAS bf16x8*)(sm + (ib * 16 + fr) * SC_LD + 32 * ks + 8 * fq); o[ib] = __builtin_amdgcn_mfma_f32_16x16x32_bf16(A, bv[ks], o[ib], 0, 0, 0); } }
#pragma unroll
            for (int ks = 0; ks < 2; ++ks) {
                v4u sw; sw.x = pk2(S[2 * ks][0], S[2 * ks][1]); sw.y = pk2(S[2 * ks][2], S[2 * ks][3]); sw.z = pk2(S[2 * ks + 1][0], S[2 * ks + 1][1]); sw.w = pk2(S[2 * ks + 1][2], S[2 * ks + 1][3]);
                const bf16x8 Bs = __builtin_bit_cast(bf16x8, sw);
#pragma unroll
                for (int ib = 0; ib < 4; ++ib) { const v2u lo = *(const LAS v2u*)(qb + (ib * 16 + fr) * SC_LD + 32 * ks + 4 * fq), hi = *(const LAS v2u*)(qb + (ib * 16 + fr) * SC_LD + 32 * ks + 16 + 4 * fq);
                    const bf16x8 A = __builtin_bit_cast(bf16x8, ((v4u){lo.x, lo.y, hi.x, hi.y})); o[ib] = __builtin_amdgcn_mfma_f32_16x16x32_bf16(A, Bs, o[ib], 0, 0, 0); } }
#pragma unroll
            for (int ib = 0; ib < 4; ++ib)
#pragma unroll
                for (int r = 0; r < 4; ++r) { const int i = ib * 16 + 4 * fq + r; outb[(size_t)SC_ROW(c, i) * 512 + h * 128 + 16 * wid + fr] = (bf16)f2bf(o[ib][r]); }
            }
#pragma unroll
            for (int db = 0; db < 4; ++db) {
#pragma unroll
                for (int r = 0; r < 4; ++r) S[db][r] *= dec[db * 16 + 4 * fq + r];
#pragma unroll
                for (int ks = 0; ks < 2; ++ks) { const bf16x8 A = *(const LAS bf16x8*)(kdT + (db * 16 + fr) * SC_LD + 32 * ks + 8 * fq); S[db] = __builtin_amdgcn_mfma_f32_16x16x32_bf16(A, bv[ks], S[db], 0, 0, 0); } }
        }
#pragma unroll
        for (int e = 0; e < 8; ++e) { qr[e] = qn[e]; kr[e] = kn[e]; }
        vr0 = vn0; vr1 = vn1; zr = zn;
    }
    if (STATE_ONLY) {
#pragma unroll
        for (int db = 0; db < 4; ++db)
#pragma unroll
            for (int r = 0; r < 4; ++r) Fout[(db * 16 + 4 * fq + r) * 128 + 16 * wid + fr] = S[db][r];
        if (wid == 0) Dout[lane] = __expf(sumlog);
    }
    __syncthreads();
#undef SC_ROW
#undef SC_LOAD
}

#define XB_TMO      128
#define XB_XCNT(j)  (256  + 64 * (j))
#define XB_XSUB(j)  (1280 + 64 * (j))
#define XB_XGEN(j)  (2304 + 64 * (j))
#define XB_TOP      3328
#define XB_TOPGEN   3392
#define XCD_BAR_WORDS 3456
#define XB_SPIN_CAP (1u << 18)

__device__ __forceinline__ unsigned xb_ld(unsigned* p)              { return __hip_atomic_load(p, __ATOMIC_RELAXED, __HIP_MEMORY_SCOPE_AGENT); }
__device__ __forceinline__ unsigned xb_add(unsigned* p, unsigned v) { return __hip_atomic_fetch_add(p, v, __ATOMIC_RELAXED, __HIP_MEMORY_SCOPE_AGENT); }
__device__ __forceinline__ unsigned xb_xcc_id() { return (unsigned)__builtin_amdgcn_s_getreg((3 << 11) | 20) & 0xFu; }
#define XB_SPIN(cond, bar) do { unsigned _sp = 0; while (cond) { __builtin_amdgcn_s_sleep(1); \
    if ((++_sp & 255u) == 0u) { if (xb_ld(&(bar)[XB_TMO])) break; if (_sp > XB_SPIN_CAP) { atomicAdd(&(bar)[XB_TMO], 1u); break; } } } } while (0)

struct XcdBarrier {
    unsigned* bar; unsigned x;
    volatile LAS unsigned* st;
};

__device__ __forceinline__ XcdBarrier xcd_barrier_post(unsigned* bar, volatile LAS unsigned* st) {
    XcdBarrier b; b.bar = bar; b.x = xb_xcc_id(); b.st = st;
    if (threadIdx.x == 0) (void)xb_add(&bar[XB_XCNT(b.x)], 1u);
    return b;
}
__device__ __forceinline__ void xcd_barrier_complete(unsigned* bar, unsigned x, unsigned& nloc, unsigned& nx) {
    const unsigned G = gridDim.x * gridDim.y * gridDim.z;
    unsigned sum, cnt, mine, sp = 0u;
    for (;;) {
        sum = 0u; cnt = 0u; mine = 0u;
#pragma unroll
        for (unsigned j = 0; j < 16; ++j) { const unsigned c = xb_ld(&bar[XB_XCNT(j)]); sum += c; cnt += (c > 0u) ? 1u : 0u; mine = (j == x) ? c : mine; }
        if (sum == G) break;
        __builtin_amdgcn_s_sleep(1);
        if ((++sp & 255u) == 0u) { if (xb_ld(&bar[XB_TMO])) break; if (sp > XB_SPIN_CAP) { atomicAdd(&bar[XB_TMO], 1u); break; } }
    }
    nloc = mine > 0u ? mine : 1u; nx = cnt > 0u ? cnt : 1u;
}

__device__ __forceinline__ void xcd_barrier(const XcdBarrier& b) {
    asm volatile("s_waitcnt vmcnt(0)" ::: "memory");
    __syncthreads();
    if (threadIdx.x == 0) {
        unsigned* bar = b.bar;
        __builtin_amdgcn_s_waitcnt(0);
        unsigned nloc = b.st[0], nx = b.st[1];
        if (nloc == 0u) { xcd_barrier_complete(bar, b.x, nloc, nx); b.st[0] = nloc; b.st[1] = nx; }
        const unsigned old = xb_add(&bar[XB_XSUB(b.x)], 1u);
        const unsigned gen = old / nloc;
        if (old + 1u == (gen + 1u) * nloc) {
            __builtin_amdgcn_fence(__ATOMIC_RELEASE, "agent");
            asm volatile("s_waitcnt vmcnt(0)" ::: "memory");
            const unsigned og = xb_add(&bar[XB_TOP], 1u);
            const unsigned tg = og / nx;
            if (og + 1u == (tg + 1u) * nx) xb_add(&bar[XB_TOPGEN], 1u);
            else XB_SPIN(xb_ld(&bar[XB_TOPGEN]) == tg, bar);
            __builtin_amdgcn_fence(__ATOMIC_ACQUIRE, "agent");
            xb_add(&bar[XB_XGEN(b.x)], 1u);
            asm volatile("s_waitcnt vmcnt(0)" ::: "memory");
        } else {
            XB_SPIN(xb_ld(&bar[XB_XGEN(b.x)]) == gen, bar);
            __builtin_amdgcn_fence(__ATOMIC_ACQUIRE, "agent");
            asm volatile("s_waitcnt vmcnt(0)" ::: "memory");
        }
    }
    __syncthreads();
}

struct Args { const float* in[16]; float* out; unsigned char* ws; };
__global__ void __launch_bounds__(NWAVES * 64, 2) hybrid_fwd(Args args) {
    extern __shared__ __attribute__((aligned(16))) unsigned char lds[];
    cg::grid_group grid = cg::this_grid();
    LAS unsigned char* L = (LAS unsigned char*)lds;
    volatile LAS unsigned* MISC = (volatile LAS unsigned*)(L + MISC_OFF);
    const int tid = threadIdx.x, lane = tid & 63, wave = __builtin_amdgcn_readfirstlane(tid >> 6);
    const int G = gridDim.x, bx = blockIdx.x;
    const int vcu = (G % 8 == 0) ? (bx % 8) * (G / 8) + bx / 8 : bx;
    const int gw = vcu * NWAVES + wave, NGW = G * NWAVES;
    unsigned char* ws = args.ws;
    unsigned* ctl = (unsigned*)(ws + WS_CTL);
    bf16* XN = (bf16*)(ws + WS_XN); bf16* PROJ = (bf16*)(ws + WS_PROJ); bf16* MERGED = (bf16*)(ws + WS_MERGED); bf16* OBUF = (bf16*)(ws + WS_OBUF);
    float* ACCF = (float*)(ws + WS_OBUF);
    float* SCF = (float*)(ws + WS_SCF); float* SCD = (float*)(ws + WS_SCD);
    float* out = args.out;
    for (int u = tid; u < (LDS_BYTES - RING_BYTES) / 4; u += NWAVES * 64) ((LAS unsigned*)(L + RING_BYTES))[u] = 0u;
    __syncthreads();
    XcdBarrier bar = xcd_barrier_post(ctl + CW_BAR, MISC + 8);

    {
        LAS float* scr = (LAS float*)(L + wave * 16384);
        for (int l = 0; l < DEPTH; ++l) {
            unsigned char* wl = ws + WS_W + (size_t)l * LW;
            const float* src[8] = {args.in[4] + (size_t)l * DM * INW, args.in[11] + (size_t)l * DM * 3 * DM, args.in[10] + (size_t)(l * 3 + 0) * 512 * DM, args.in[10] + (size_t)(l * 3 + 1) * 512 * DM,
                                   args.in[10] + (size_t)(l * 3 + 2) * 512 * DM, args.in[12] + (size_t)l * DM * DM, args.in[13] + (size_t)l * DM * FF, args.in[14] + (size_t)l * FF * DM};
            const int Ks[8] = {DM, DM, 512, 512, 512, DM, DM, FF}, Ns[8] = {INW, 3 * DM, DM, DM, DM, DM, FF, DM}, roff[8] = {0, 0, 0, DM, 2 * DM, 0, 0, 0};
            const size_t doff[8] = {OW_IN, OW_MERGE, OW_BR, OW_BR, OW_BR, OW_OUT, OW_UP, OW_DOWN};
#pragma unroll
            for (int mi = 0; mi < 8; ++mi) {
                const int nit = (Ks[mi] / 64) * (Ns[mi] / 32);
                for (int it = gw; it < nit; it += NGW) p0_transpose_item(src[mi], Ks[mi], Ns[mi], (bf16*)(wl + doff[mi]), roff[mi], scr, it, lane);
            }
            v4u* z = (v4u*)(wl + OW_IN + (size_t)INW * DM * 2);
            for (int i = gw * 64 + lane; i < (PW - INW) * DM * 2 / 16; i += NGW * 64) z[i] = (v4u){0u, 0u, 0u, 0u};
        }
    }
    grid.sync();

    for (int l = 0; l < DEPTH; ++l) {
        unsigned char* wl = ws + WS_W + (size_t)l * LW;
        const bf16* Win_t = (const bf16*)(wl + OW_IN); const bf16* Wmerge_t = (const bf16*)(wl + OW_MERGE); const bf16* Wbr_t = (const bf16*)(wl + OW_BR);
        const bf16* Wout_t = (const bf16*)(wl + OW_OUT); const bf16* Wup_t = (const bf16*)(wl + OW_UP); const bf16* Wdown_t = (const bf16*)(wl + OW_DOWN);
        for (int hf = 0; hf < 2; ++hf) {
            float* op = out + (size_t)hf * MP * DM; float* os = out + (size_t)(2 * MP + hf * SS) * DM;
            const float* xp = l == 0 ? args.in[0] + (size_t)hf * MP * DM : op; const float* xs = l == 0 ? args.in[1] + (size_t)hf * SS * DM : os;
            norm_rows(xp, xs, args.in[2] + l * DM, XN, gw, NGW, lane);
            xcd_barrier(bar);
            { pg8::Gemm g{XN, Win_t, MH, PW, DM, 1 << 30, 0}; pg8::StaticOrder S; S.init(MH, PW, G, bx);
              pg8::EpiBf16<0> E{PROJ, PW, 0, 0};
              pg8::gemm_phase<pg8::EpiBf16<0>, pg8::StaticOrder, true, true>(L, g, S, E); }
            xcd_barrier(bar);
            e1_rows(PROJ, args.in[5] + l * 64, args.in[6] + l * 64, gw, NGW, lane);
            xcd_barrier(bar);
            for (int pass = 0; pass < 2; ++pass) {
                unsigned* qctr = ctl + 64 * (1 + (l * 2 + hf) * 2 + pass);
                const int NU = pass == 0 ? 560 : 832;
                for (;;) {
                    if (tid == 0) MISC[0] = atomicAdd(qctr, 1u);
                    __syncthreads();
                    const int u = (int)MISC[0];
                    __syncthreads();
                    if (u >= NU) break;
                    int kind, r = 0, seg = 0, row0 = 0, len = 0, slot0 = 0, au = 0;
                    if (pass == 0) {
                        if (u < 256) { kind = 1; au = u; }
                        else if (u < 368) { kind = 0; r = (u - 256) / 7; seg = (u - 256) % 7; row0 = MP; len = SS; slot0 = r * 8; }
                        else if (u < 496) { kind = 0; const int s2 = u - 368; r = s2 & 15; seg = 0; row0 = (s2 >> 4) * SP; len = SP; slot0 = 128 + s2 * 2; }
                        else { kind = 1; au = 256 + (u - 496); }
                    } else {
                        if (u < 128) { kind = 0; r = u >> 3; seg = u & 7; row0 = MP; len = SS; slot0 = r * 8; }
                        else if (u < 384) { kind = 0; const int s2 = (u - 128) >> 1; r = s2 & 15; seg = (u - 128) & 1; row0 = (s2 >> 4) * SP; len = SP; slot0 = 128 + s2 * 2; }
                        else { kind = 1; au = 320 + (u - 384); }
                    }
                    if (kind == 0) {
                        const int mixer = r >> 3, h = (r >> 1) & 3, dir = r & 1;
                        float* Fs = SCF + (size_t)slot0 * 8192; float* Ds = SCD + (size_t)slot0 * 64;
                        const int c0 = seg * 16, c1 = c0 + 16;
                        if (mixer == 0) {
                            const float* wgp = args.in[7] + (size_t)(l * 2 + dir) * 16 * 256; const float* bgp = args.in[8] + (size_t)(l * 2 + dir) * 256; bf16* ob = OBUF + (size_t)(1 + 2 * dir) * OB1;
                            if (pass == 0) scan_unit<true, true>(L, PROJ, ob, row0, len, h, dir, wgp, bgp, 0.f, c0, c1, Fs, Ds, 0, Fs + (size_t)seg * 8192, Ds + seg * 64);
                            else scan_unit<true, false>(L, PROJ, ob, row0, len, h, dir, wgp, bgp, 0.f, c0, c1, Fs, Ds, seg, nullptr, nullptr);
                        } else {
                            const int hh = dir == 0 ? h : 3 - h; const float lg = __logf(1.0f - __builtin_amdgcn_exp2f(-5.0f - (float)hh)); bf16* ob = OBUF + (size_t)(2 + 2 * dir) * OB1;
                            if (pass == 0) scan_unit<false, true>(L, PROJ, ob, row0, len, h, dir, nullptr, nullptr, lg, c0, c1, Fs, Ds, 0, Fs + (size_t)seg * 8192, Ds + seg * 64);
                            else scan_unit<false, false>(L, PROJ, ob, row0, len, h, dir, nullptr, nullptr, lg, c0, c1, Fs, Ds, seg, nullptr, nullptr);
                        }
                    } else {
                        int nt, hk, qb, hq;
                        if (au < 256) { row0 = MP; nt = SS / 64; hk = au >> 7; qb = (au >> 2) & 31; hq = au & 3; }
                        else { const int a2 = au - 256, rr = a2 & 63; row0 = (a2 >> 6) * SP; nt = SP / 64; hk = rr >> 5; qb = (rr >> 2) & 7; hq = rr & 3; }
                        const int h = hk * 4 + hq;
                        const attn_body::bf16* P = (const attn_body::bf16*)PROJ;
                        attn_body::attn_unit<8>(P + (size_t)(row0 + qb * 256) * PW + C_AQ + h * 64, P + (size_t)row0 * PW + C_AK + hk * 64, P + (size_t)row0 * PW + C_AV + hk * 64,
                                                (attn_body::bf16*)OBUF + (size_t)(row0 + qb * 256) * 512 + h * 64, nt, (char*)lds);
                    }
                }
                xcd_barrier(bar);
            }
            e2_rows(PROJ, OBUF, args.in[9] + l * 128, gw, NGW, lane);
            xcd_barrier(bar);
            { pg8::Gemm g{OBUF, Wbr_t, MH, 3 * DM, 512, 4, OB1 * 2}; pg8::StaticOrder S; S.init(MH, 3 * DM, G, bx);
              pg8::EpiBf16<0> E{PROJ, DM, DM, (size_t)MH * DM};
              pg8::gemm_phase<pg8::EpiBf16<0>, pg8::StaticOrder, true, true>(L, g, S, E); }
            xcd_barrier(bar);
            { pg8::Gemm g{XN, Wmerge_t, MH, 3 * DM, DM, 1 << 30, 0}; pg8::MergeOrder S; S.init(MH, G, bx);
              pg8::EpiMerge E{PROJ, (size_t)MH * DM, ACCF, MERGED};
              pg8::gemm_phase<pg8::EpiMerge, pg8::MergeOrder, true, true>(L, g, S, E); }
            xcd_barrier(bar);
            { pg8::Gemm g{MERGED, Wout_t, MH, DM, DM, 1 << 30, 0}; pg8::StaticOrder S; S.init(MH, DM, G, bx);
              pg8::EpiRes E{xp, xs, op, os};
              pg8::gemm_phase<pg8::EpiRes, pg8::StaticOrder, true, true>(L, g, S, E); }
            xcd_barrier(bar);
            norm_rows(op, os, args.in[3] + l * DM, XN, gw, NGW, lane);
            xcd_barrier(bar);
            { pg8::Gemm g{XN, Wup_t, MH, FF, DM, 1 << 30, 0}; pg8::StaticOrder S; S.init(MH, FF, G, bx);
              pg8::EpiBf16<2> E{PROJ, FF, 0, 0};
              pg8::gemm_phase<pg8::EpiBf16<2>, pg8::StaticOrder, true, true>(L, g, S, E); }
            xcd_barrier(bar);
            { pg8::Gemm g{PROJ, Wdown_t, MH, DM, FF, 1 << 30, 0}; pg8::StaticOrder S; S.init(MH, DM, G, bx);
              pg8::EpiRes E{op, os, op, os};
              pg8::gemm_phase<pg8::EpiRes, pg8::StaticOrder, true, true>(L, g, S, E); }
            xcd_barrier(bar);
        }
    }
    final_norm(out, args.in[15], gw, NGW, lane);
}

extern "C" void kernel_launch(void* const* d_in, const int* in_sizes, int n_in, void* d_out, int out_size, void* d_ws, size_t ws_size, hipStream_t stream) {
    static int grid = 0;
    if (grid == 0) {
        if (n_in != 16 || out_size != 2 * MH * DM || ws_size < WS_END) { fprintf(stderr, "kernel_launch: unexpected shapes (n_in %d, out %d, ws %zu)\n", n_in, out_size, ws_size); grid = -1; return; }
        int dev = 0, cus = 0, per_cu = 0;
        if (hipGetDevice(&dev) != hipSuccess || hipDeviceGetAttribute(&cus, hipDeviceAttributeMultiprocessorCount, dev) != hipSuccess) { grid = -1; return; }
        if (hipFuncSetAttribute((const void*)hybrid_fwd, hipFuncAttributeMaxDynamicSharedMemorySize, LDS_BYTES) != hipSuccess) { fprintf(stderr, "kernel_launch: hipFuncSetAttribute failed\n"); grid = -1; return; }
        if (hipOccupancyMaxActiveBlocksPerMultiprocessor(&per_cu, (const void*)hybrid_fwd, NWAVES * 64, LDS_BYTES) != hipSuccess || per_cu < 1) { fprintf(stderr, "kernel_launch: occupancy query says %d\n", per_cu); per_cu = 1; }
        (void)hipGetLastError();
        grid = cus;
    }
    if (grid < 0) return;
    if (hipMemsetAsync((char*)d_ws + WS_CTL, 0, CTL_ZERO_BYTES, stream) != hipSuccess) { fprintf(stderr, "kernel_launch: memset failed\n"); return; }
    Args a{};
    for (int i = 0; i < 16; ++i) a.in[i] = (const float*)d_in[i];
    a.out = (float*)d_out; a.ws = (unsigned char*)d_ws;
    void* kargs[] = {&a};
    const hipError_t le = hipLaunchCooperativeKernel((const void*)hybrid_fwd, dim3(grid), dim3(NWAVES * 64), kargs, LDS_BYTES, stream);
    if (le != hipSuccess) fprintf(stderr, "kernel_launch: cooperative launch failed: %s (grid %d)\n", hipGetErrorName(le), grid);
}
```

```cpp
#include <hip/hip_runtime.h>
#include <hip/hip_cooperative_groups.h>
#include <cstdio>
#include <cstdint>
namespace cg = cooperative_groups;
namespace pg8 {
#define PG8_LAS __attribute__((address_space(3)))
typedef unsigned short bf16_t;
typedef short bf16x8 __attribute__((ext_vector_type(8)));
typedef float f32x4 __attribute__((ext_vector_type(4)));
typedef unsigned u32x4 __attribute__((ext_vector_type(4)));
constexpr int BM = 256, BK = 64, HALF = 128, HTB = HALF * BK * 2  , STAGE_BYTES = 8 * HTB, NXCD = 8, WGM = 8;

__host__ __device__ __forceinline__ int lds_byte(int r, int c) { const int st = (r >> 4) * 2 + (c >> 5), rr = r & 15, cc = c & 31, ob = rr * 64 + cc * 2; return st * 1024 + (ob ^ (((ob >> 9) & 1) << 5)); }
__host__ __device__ __forceinline__ void stage_rc(int b, int& R, int& C) { const int st = b / 1024, sb = b % 1024, swz = sb ^ (((sb >> 9) & 1) << 5); R = (st >> 1) * 16 + swz / 64; C = (st & 1) * 32 + (swz % 64) / 2; }
__host__ __device__ __forceinline__ int perm32(int rho) { const int n = rho >> 4, i = rho & 15; return 8 * (i >> 2) + 4 * n + (i & 3); }

struct Unit { int pm, pn, k0, nt; };
struct Gemm { const bf16_t* A; const bf16_t* Bt; int M, N, K; int a_grp; size_t a_grp_bytes; };

struct StaticOrder {
    int nM, nN, nwg, G, c;
    __host__ __device__ void init(int M, int N, int G_, int c_) { nM = M / BM; nN = N / BM; nwg = nM * nN; G = G_; c = c_; }
    __host__ __device__ bool next(int i, Unit& u) const {
        const long L = (long)i * G + c; if (L >= nwg) return false;
        int wgid = (int)L; { const int q = nwg / NXCD, r = nwg % NXCD, xcd = wgid % NXCD, off = wgid / NXCD; wgid = (xcd < r ? xcd * (q + 1) : r * (q + 1) + (xcd - r) * q) + off; }
        const int nig = WGM * nN, gid = wgid / nig, fm = gid * WGM, gsz = (nM - fm) < WGM ? (nM - fm) : WGM;
        u.pm = fm + ((wgid % nig) % gsz); u.pn = (wgid % nig) / gsz; u.k0 = 0; u.nt = 0; return true;
    }
    __device__ __forceinline__ void a_ready(const Unit&) const {}
    __device__ __forceinline__ void done(const Unit&) const {}
};

__device__ __forceinline__ unsigned cvt_pk_bf16(float lo, float hi) { unsigned r; asm volatile("v_cvt_pk_bf16_f32 %0, %1, %2" : "=v"(r) : "v"(lo), "v"(hi)); return r; }
typedef float f32x2 __attribute__((ext_vector_type(2)));
__device__ __forceinline__ float bflo(unsigned w) { return __builtin_bit_cast(float, w << 16); }
__device__ __forceinline__ float bfhi(unsigned w) { return __builtin_bit_cast(float, w & 0xffff0000u); }
template <int ACT> struct EpiBf16 {
    static constexpr bool PERM = true, AFTER_DRAIN = false;
    bf16_t* O; int ldc; int split_cols; size_t split_stride;
    __device__ __forceinline__ void operator()(const f32x4 (&acc)[2][2][4][2], const Unit& u, int wr, int wc, int fr, int fq) const {
        const int row0 = u.pm * BM + wr * 64 + fr; int colt = u.pn * BM; bf16_t* base = O;
        if (split_cols) { const int t = colt / split_cols; base += (size_t)t * split_stride; colt -= t * split_cols; }
        const int col0 = colt + wc * 32 + 8 * fq;
#pragma unroll
        for (int ai = 0; ai < 2; ++ai)
#pragma unroll
            for (int m = 0; m < 4; ++m) { bf16_t* rowp = base + (size_t)(row0 + ai * HALF + m * 16) * ldc + col0;
#pragma unroll
                for (int bj = 0; bj < 2; ++bj) { f32x4 v0 = acc[ai][bj][m][0], v1 = acc[ai][bj][m][1];
                    if (ACT == 2) {
#pragma unroll
                        for (int j = 0; j < 4; ++j) { const float a = fmaxf(v0[j], 0.f), b = fmaxf(v1[j], 0.f); v0[j] = a * a; v1[j] = b * b; } }
                    u32x4 w; w.x = cvt_pk_bf16(v0[0], v0[1]); w.y = cvt_pk_bf16(v0[2], v0[3]); w.z = cvt_pk_bf16(v1[0], v1[1]); w.w = cvt_pk_bf16(v1[2], v1[3]);
                    *(u32x4*)(rowp + bj * HALF) = w; } }
    }
};
struct EpiMerge {
    static constexpr bool PERM = true, AFTER_DRAIN = false;
    const bf16_t* Y; size_t ystride; float* accf; bf16_t* merged;
    __device__ __forceinline__ void operator()(const f32x4 (&acc)[2][2][4][2], const Unit& u, int wr, int wc, int fr, int fq) const {
        const int b = u.pn >> 2, ct = u.pn & 3;
        const int row0 = u.pm * BM + wr * 64 + fr, col0 = ct * BM + wc * 32 + 8 * fq;
        const bf16_t* Yb = Y + (size_t)b * ystride;
#pragma unroll
        for (int ai = 0; ai < 2; ++ai)
#pragma unroll
            for (int m = 0; m < 4; ++m) {
#pragma unroll
                for (int bj = 0; bj < 2; ++bj) { const size_t o = (size_t)(row0 + ai * HALF + m * 16) * 1024 + col0 + bj * HALF;
                    const u32x4 yv = *(const u32x4*)(Yb + o);
                    float y[8] = {bflo(yv.x), bfhi(yv.x), bflo(yv.y), bfhi(yv.y), bflo(yv.z), bfhi(yv.z), bflo(yv.w), bfhi(yv.w)};
                    float p[8];
#pragma unroll
                    for (int j = 0; j < 8; ++j) { const float a = j < 4 ? acc[ai][bj][m][0][j & 3] : acc[ai][bj][m][1][j & 3];
                        const float g = __builtin_amdgcn_rcpf(1.0f + __builtin_amdgcn_exp2f(-1.4426950408889634f * a)); p[j] = g * y[j]; }
                    if (b > 0) { const f32x4 c0 = *(const f32x4*)(accf + o), c1 = *(const f32x4*)(accf + o + 4);
#pragma unroll
                        for (int j = 0; j < 4; ++j) { p[j] += c0[j]; p[4 + j] += c1[j]; } }
                    if (b < 2) { *(f32x4*)(accf + o) = (f32x4){p[0], p[1], p[2], p[3]}; *(f32x4*)(accf + o + 4) = (f32x4){p[4], p[5], p[6], p[7]}; }
                    else { u32x4 w; w.x = cvt_pk_bf16(p[0], p[1]); w.y = cvt_pk_bf16(p[2], p[3]); w.z = cvt_pk_bf16(p[4], p[5]); w.w = cvt_pk_bf16(p[6], p[7]); *(u32x4*)(merged + o) = w; } } }
    }
};
struct EpiRes {
    static constexpr bool PERM = false, AFTER_DRAIN = false;
    const float* base_p; const float* base_s; float* out_p; float* out_s; int full_nt;
    __device__ __forceinline__ void operator()(const f32x4 (&acc)[2][2][4][2], const Unit& u, int wr, int wc, int fr, int fq) const {
        const bool smp = u.pm >= 64; const float* bs = smp ? base_s : base_p; float* ot = smp ? out_s : out_p;
        const int r0 = (smp ? u.pm - 64 : u.pm) * BM + wr * 64 + fr, col0 = u.pn * BM + wc * 32 + 4 * fq;
#pragma unroll
        for (int ai = 0; ai < 2; ++ai)
#pragma unroll
            for (int m = 0; m < 4; ++m) { const size_t off = (size_t)(r0 + ai * HALF + m * 16) * 1024 + col0;
#pragma unroll
                for (int bj = 0; bj < 2; ++bj)
#pragma unroll
                    for (int n = 0; n < 2; ++n) { const size_t o = off + bj * HALF + n * 16;
                        if (u.nt != full_nt) {
#pragma unroll
                            for (int j = 0; j < 4; ++j) unsafeAtomicAdd(ot + o + j, acc[ai][bj][m][n][j]);
                        } else { const f32x4 v = *(const f32x4*)(bs + o) + acc[ai][bj][m][n]; *(f32x4*)(ot + o) = v; } } }
    }
};
struct MergeOrder {
    int nM, nwg, G, c;
    __host__ __device__ void init(int M, int G_, int c_) { nM = M / BM; nwg = nM * 4; G = G_; c = c_; }
    __host__ __device__ bool next(int i, Unit& u) const {
        const int j = i / 3, b = i - 3 * j; const long L = (long)j * G + c; if (L >= nwg) return false;
        int wgid = (int)L; { const int q = nwg / NXCD, r = nwg % NXCD, xcd = wgid % NXCD, off = wgid / NXCD; wgid = (xcd < r ? xcd * (q + 1) : r * (q + 1) + (xcd - r) * q) + off; }
        const int nN = 4, nig = WGM * nN, gid = wgid / nig, fm = gid * WGM, gsz = (nM - fm) < WGM ? (nM - fm) : WGM;
        u.pm = fm + ((wgid % nig) % gsz); u.pn = b * 4 + (wgid % nig) / gsz; u.k0 = 0; u.nt = 0; return true;
    }
    __device__ __forceinline__ void a_ready(const Unit&) const {}
    __device__ __forceinline__ void done(const Unit&) const {}
};
struct SplitOrder {
    int nM, nN, nwg, G, c, ntk;
    __host__ __device__ void init(int M, int N, int K, int G_, int c_) { nM = M / BM; nN = N / BM; nwg = nM * nN; G = G_; c = c_; ntk = K / BK; }
    __host__ __device__ bool next(int i, Unit& u) const {
        long L;
        if (i == 0) { L = c; u.k0 = 0; u.nt = ntk; }
        else if (i == 1) { L = (long)G + (c >> 1); u.nt = ntk / 2; u.k0 = (c & 1) * (ntk / 2); }
        else return false;
        if (L >= nwg) return false;
        int wgid = (int)L; { const int q = nwg / NXCD, r = nwg % NXCD, xcd = wgid % NXCD, off = wgid / NXCD; wgid = (xcd < r ? xcd * (q + 1) : r * (q + 1) + (xcd - r) * q) + off; }
        const int nig = WGM * nN, gid = wgid / nig, fm = gid * WGM, gsz = (nM - fm) < WGM ? (nM - fm) : WGM;
        u.pm = fm + ((wgid % nig) % gsz); u.pn = (wgid % nig) / gsz; return true;
    }
    __device__ __forceinline__ void a_ready(const Unit&) const {}
    __device__ __forceinline__ void done(const Unit&) const {}
};
template <class Epi, class Sched, bool ALIGN_EPI = false, bool SP2 = false>
__device__ __forceinline__ void gemm_phase(PG8_LAS unsigned char* lds, const Gemm g, const Sched& S, const Epi& E) {
    int tid_ = threadIdx.x; asm volatile("" : "+v"(tid_)); const int tid = tid_, wid = __builtin_amdgcn_readfirstlane(tid >> 6), lane = tid & 63, wr = wid >> 2, wc = wid & 3, fr = lane & 15, fq = lane >> 4;
    const int K = g.K, nt = K / BK;
    unsigned voffA[2], voffB[2];
#pragma unroll
    for (int i = 0; i < 2; ++i) { int R, C; stage_rc(tid * 16 + i * 8192, R, C); const int Rb = Epi::PERM ? ((R & ~31) + perm32(R & 31)) : R;
        voffA[i] = (unsigned)(R * K + C) * 2u; voffB[i] = (unsigned)(Rb * K + C) * 2u; }
    const size_t kstep = (size_t)(BK * 2);
    const size_t hstep = (size_t)HALF * K * 2;
    const size_t tstep = 2 * hstep;
    const unsigned ldsw = (unsigned)wid * 1024u;
    const int aoff = lds_byte(wr * 64 + fr, fq * 8), boff = lds_byte(wc * 32 + fr, fq * 8);
#define PG8_SA(b, h) (((b) * 2 + (h)) * HTB)
#define PG8_SB(b, h) ((4 + (b) * 2 + (h)) * HTB)
#define PG8_STAGE(bufoff, gbase, voff) do { _Pragma("unroll") for (int _i = 0; _i < 2; ++_i) \
        __builtin_amdgcn_global_load_lds((const unsigned*)((const char*)(gbase) + (voff)[_i]), (PG8_LAS unsigned*)(lds + (bufoff) + ldsw + _i * 8192), 16, 0, 0); } while (0)
#define PG8_LDA(dst, b, h) do { _Pragma("unroll") for (int m = 0; m < 4; ++m) _Pragma("unroll") for (int k = 0; k < 2; ++k) dst[m][k] = *(const PG8_LAS bf16x8*)(lds + PG8_SA(b, h) + aoff + m * 2048 + k * 1024); } while (0)
#define PG8_LDB(dst, b, h) do { _Pragma("unroll") for (int n = 0; n < 2; ++n) _Pragma("unroll") for (int k = 0; k < 2; ++k) dst[n][k] = *(const PG8_LAS bf16x8*)(lds + PG8_SB(b, h) + boff + n * 2048 + k * 1024); } while (0)
#define PG8_MMA(ai, bj, At, Bt) do { __builtin_amdgcn_s_setprio(1); _Pragma("unroll") for (int m = 0; m < 4; ++m) _Pragma("unroll") for (int n = 0; n < 2; ++n) _Pragma("unroll") for (int k = 0; k < 2; ++k) \
        acc[ai][bj][m][n] = __builtin_amdgcn_mfma_f32_16x16x32_bf16(Bt[n][k], At[m][k], acc[ai][bj][m][n], 0, 0, 0); __builtin_amdgcn_s_setprio(0); } while (0)
#define PG8_WAIT_V(n) asm volatile("s_waitcnt vmcnt(" #n ")" ::: "memory")
#define PG8_WAIT_L(n) asm volatile("s_waitcnt lgkmcnt(" #n ")" ::: "memory")
#define PG8_BAR __builtin_amdgcn_s_barrier()
#define PG8_SCHED __builtin_amdgcn_sched_barrier(0)
    Unit cur, nxt; int ui = 0;
    if (!S.next(0, cur)) return;
    if (cur.nt == 0) cur.nt = nt;
    f32x4 acc[2][2][4][2];
#pragma unroll
    for (int a = 0; a < 2; ++a)
#pragma unroll
        for (int b = 0; b < 2; ++b)
#pragma unroll
            for (int m = 0; m < 4; ++m)
#pragma unroll
                for (int n = 0; n < 2; ++n) acc[a][b][m][n] = (f32x4){0.f, 0.f, 0.f, 0.f};
    bf16x8 At[4][2], B0[2][2], B1[2][2];
    const char* cA = (const char*)g.A + (size_t)(cur.pn / g.a_grp) * g.a_grp_bytes + (size_t)cur.pm * tstep + (size_t)cur.k0 * kstep; const char* cB = (const char*)g.Bt + (size_t)cur.pn * tstep + (size_t)cur.k0 * kstep;
    S.a_ready(cur);
    if constexpr (SP2) {
        PG8_STAGE(PG8_SB(0, 0), cB, voffB); PG8_STAGE(PG8_SB(0, 1), cB + hstep, voffB); PG8_STAGE(PG8_SA(0, 0), cA, voffA); PG8_STAGE(PG8_SA(0, 1), cA + hstep, voffA);
        if (wr == 1) PG8_BAR;
        PG8_WAIT_V(2); PG8_BAR;
        PG8_STAGE(PG8_SB(1, 0), cB + kstep, voffB); PG8_STAGE(PG8_SA(1, 0), cA + kstep, voffA); PG8_STAGE(PG8_SB(1, 1), cB + hstep + kstep, voffB);
        PG8_WAIT_V(6); PG8_BAR;
    } else {
        PG8_STAGE(PG8_SB(0, 0), cB, voffB); PG8_STAGE(PG8_SA(0, 0), cA, voffA); PG8_STAGE(PG8_SB(0, 1), cB + hstep, voffB); PG8_STAGE(PG8_SA(0, 1), cA + hstep, voffA);
        if (wr == 1) PG8_BAR;
        PG8_WAIT_V(4); PG8_BAR;
        PG8_STAGE(PG8_SB(1, 0), cB + kstep, voffB); PG8_STAGE(PG8_SA(1, 0), cA + kstep, voffA); PG8_STAGE(PG8_SB(1, 1), cB + hstep + kstep, voffB);
        PG8_WAIT_V(6); PG8_BAR;
    }
    for (;;) {
        const bool has_next = S.next(ui + 1, nxt);
        if (has_next && nxt.nt == 0) nxt.nt = nt;
        const char* nA = has_next ? (const char*)g.A + (size_t)(nxt.pn / g.a_grp) * g.a_grp_bytes + (size_t)nxt.pm * tstep + (size_t)nxt.k0 * kstep : cA; const char* nB = has_next ? (const char*)g.Bt + (size_t)nxt.pn * tstep + (size_t)nxt.k0 * kstep : cB;
        const int unt = cur.nt;
        for (int t = 0; t < unt; t += 2) {
            const bool last = (t == unt - 2);
            const char* a1 = cA + (size_t)(t + 1) * kstep;
            const char* a2 = last ? nA : cA + (size_t)(t + 2) * kstep; const char* b2 = last ? nB : cB + (size_t)(t + 2) * kstep;
            const char* a3 = a2 + kstep; const char* b3 = b2 + kstep;
            if (last && has_next) S.a_ready(nxt);
            if constexpr (SP2) {
            PG8_LDB(B0, 0, 0); PG8_LDB(B1, 0, 1); PG8_SCHED; PG8_LDA(At, 0, 0); PG8_STAGE(PG8_SA(1, 1), a1 + hstep, voffA);
            PG8_WAIT_V(8); PG8_WAIT_L(0); PG8_BAR; PG8_MMA(0, 0, At, B0); PG8_MMA(0, 1, At, B1); PG8_BAR; PG8_SCHED;
            PG8_LDA(At, 0, 1); PG8_STAGE(PG8_SB(0, 0), b2, voffB); PG8_STAGE(PG8_SB(0, 1), b2 + hstep, voffB); PG8_STAGE(PG8_SA(0, 0), a2, voffA);
            PG8_WAIT_V(8); PG8_WAIT_L(0); PG8_BAR; PG8_MMA(1, 0, At, B0); PG8_MMA(1, 1, At, B1); PG8_BAR; PG8_SCHED;
            PG8_LDB(B0, 1, 0); PG8_LDB(B1, 1, 1); PG8_SCHED; PG8_LDA(At, 1, 0); PG8_STAGE(PG8_SA(0, 1), a2 + hstep, voffA);
            PG8_WAIT_V(8); PG8_WAIT_L(0); PG8_BAR; PG8_MMA(0, 0, At, B0); PG8_MMA(0, 1, At, B1); PG8_BAR; PG8_SCHED;
            PG8_LDA(At, 1, 1); PG8_STAGE(PG8_SB(1, 0), b3, voffB); PG8_STAGE(PG8_SB(1, 1), b3 + hstep, voffB); PG8_STAGE(PG8_SA(1, 0), a3, voffA);
            PG8_WAIT_V(8); PG8_WAIT_L(0); PG8_BAR; PG8_MMA(1, 0, At, B0); PG8_MMA(1, 1, At, B1); PG8_BAR; PG8_SCHED;
            } else {
            PG8_LDB(B0, 0, 0); PG8_SCHED; PG8_LDA(At, 0, 0); PG8_STAGE(PG8_SA(1, 1), a1 + hstep, voffA);
            PG8_WAIT_L(8); PG8_BAR; PG8_WAIT_L(0); PG8_MMA(0, 0, At, B0); PG8_BAR; PG8_SCHED;
            PG8_LDB(B1, 0, 1); PG8_STAGE(PG8_SB(0, 0), b2, voffB);
            PG8_BAR; PG8_WAIT_L(0); PG8_MMA(0, 1, At, B1); PG8_BAR;
            PG8_LDA(At, 0, 1); PG8_STAGE(PG8_SA(0, 0), a2, voffA);
            PG8_BAR; PG8_WAIT_L(0); PG8_MMA(1, 0, At, B0); PG8_BAR; PG8_SCHED;
            PG8_STAGE(PG8_SB(0, 1), b2 + hstep, voffB);
            PG8_WAIT_V(6); PG8_BAR; PG8_MMA(1, 1, At, B1); PG8_BAR;
            PG8_LDB(B0, 1, 0); PG8_SCHED; PG8_LDA(At, 1, 0); PG8_STAGE(PG8_SA(0, 1), a2 + hstep, voffA);
            PG8_WAIT_L(8); PG8_BAR; PG8_WAIT_L(0); PG8_MMA(0, 0, At, B0); PG8_BAR; PG8_SCHED;
            PG8_LDB(B1, 1, 1); PG8_STAGE(PG8_SB(1, 0), b3, voffB);
            PG8_BAR; PG8_WAIT_L(0); PG8_MMA(0, 1, At, B1); PG8_BAR;
            PG8_LDA(At, 1, 1); PG8_STAGE(PG8_SA(1, 0), a3, voffA);
            PG8_BAR; PG8_WAIT_L(0); PG8_MMA(1, 0, At, B0); PG8_BAR; PG8_SCHED;
            PG8_STAGE(PG8_SB(1, 1), b3 + hstep, voffB);
            PG8_WAIT_V(6); PG8_BAR; PG8_MMA(1, 1, At, B1); PG8_BAR;
            }
        }
        if constexpr (ALIGN_EPI) { if (wr == 0) PG8_BAR; }
        if constexpr (!Epi::AFTER_DRAIN) { E(acc, cur, wr, wc, fr, fq); S.done(cur); }
        if (!has_next) break;
#pragma unroll
        for (int a = 0; a < 2; ++a)
#pragma unroll
            for (int b = 0; b < 2; ++b)
#pragma unroll
                for (int m = 0; m < 4; ++m)
#pragma unroll
                    for (int n = 0; n < 2; ++n) acc[a][b][m][n] = (f32x4){0.f, 0.f, 0.f, 0.f};
        cur = nxt; cA = nA; cB = nB; ++ui;
        if constexpr (ALIGN_EPI) { if (wr == 1) PG8_BAR; }
    }
    PG8_WAIT_V(0);
    if constexpr (!ALIGN_EPI) { if (wr == 0) PG8_BAR; }
    PG8_BAR;
    if constexpr (Epi::AFTER_DRAIN) { E.fused(acc, cur, wr, wc, fr, fq, lds, wid, lane); S.done(cur); }
#undef PG8_SA
#undef PG8_SB
#undef PG8_STAGE
#undef PG8_LDA
#undef PG8_LDB
#undef PG8_MMA
#undef PG8_WAIT_V
#undef PG8_WAIT_L
#undef PG8_BAR
#undef PG8_SCHED
}
}
#include <hip/hip_bf16.h>
#include <cmath>
namespace attn_body {
using bf16=__hip_bfloat16;
using bf16x8=__attribute__((ext_vector_type(8)))short;
using s16x4=__attribute__((ext_vector_type(4)))short;
using f32x16=__attribute__((ext_vector_type(16)))float;
using u32x4=__attribute__((ext_vector_type(4)))unsigned;
constexpr int D=64,PQ=4096,PO=512;
constexpr int NW=8,QBLK=32,QB=QBLK*NW,KVBLK=64;
__device__ __forceinline__ int crow(int r,int hi){return (r&3)+8*(r>>2)+4*hi;}
#define SBAR() __builtin_amdgcn_sched_barrier(0)
constexpr int NSLOT=3, SLOTB=8192;
constexpr int LDS_K=0, LDS_V=NSLOT*SLOTB, LDS_WS=2*NSLOT*SLOTB, LDS_OST=LDS_WS+NW*64*4, LDS_BYTES=LDS_OST+NW*4096;
constexpr float C2=0.125f*1.4426950408889634f;
__device__ __forceinline__ void glds16(const void*gsrc,unsigned lds_dst){unsigned keep;
  asm volatile("s_mov_b32 %0, m0\n\ts_mov_b32 m0, %2\n\ts_nop 0\n\tglobal_load_lds_dwordx4 %1, off\n\ts_mov_b32 m0, %0":"=&s"(keep):"v"(gsrc),"s"(lds_dst):"memory");}
__device__ __forceinline__ float max3f(float a,float b,float c){float r;asm("v_max3_f32 %0, %1, %2, %3":"=v"(r):"v"(a),"v"(b),"v"(c));return r;}
__device__ __forceinline__ float max2f(float a,float b){float r;asm("v_max_f32_e32 %0, %1, %2":"=v"(r):"v"(a),"v"(b));return r;}
__device__ __forceinline__ float fadd_s(float a,float b){float r;asm("v_add_f32_e32 %0, %1, %2":"=v"(r):"v"(a),"v"(b));return r;}
__device__ __forceinline__ float fsub_s(float a,float b){float r;asm("v_sub_f32_e32 %0, %1, %2":"=v"(r):"v"(a),"v"(b));return r;}
typedef float f32x2_t __attribute__((ext_vector_type(2))); typedef __bf16 bf16x2_t __attribute__((ext_vector_type(2)));
__device__ __forceinline__ unsigned cvtpk_s(float lo,float hi){f32x2_t v={lo,hi};bf16x2_t b=__builtin_convertvector(v,bf16x2_t);return __builtin_bit_cast(unsigned,b);}
#define WAIT_BAR(N) asm volatile("s_waitcnt vmcnt(" #N ") lgkmcnt(0)\n\ts_barrier":::"memory")

__device__ __forceinline__ void qkt(f32x16&p0,f32x16&p1,const char*Kslot,const bf16x8*qr,const f32x16&negm,int r32,int hi){
  const char*kb=Kslot+hi*1024+r32*16;
  #pragma unroll
  for(int d0=0;d0<4;++d0){
    const bf16x8 b0=*reinterpret_cast<const bf16x8*>(kb+d0*2048);
    const bf16x8 b1=*reinterpret_cast<const bf16x8*>(kb+d0*2048+512);
    if(d0==0){p0=__builtin_amdgcn_mfma_f32_32x32x16_bf16(b0,qr[0],negm,0,0,0);p1=__builtin_amdgcn_mfma_f32_32x32x16_bf16(b1,qr[0],negm,0,0,0);}
    else{p0=__builtin_amdgcn_mfma_f32_32x32x16_bf16(b0,qr[d0],p0,0,0,0);p1=__builtin_amdgcn_mfma_f32_32x32x16_bf16(b1,qr[d0],p1,0,0,0);}}
}
typedef __attribute__((address_space(3))) const char* lds_cptr;
typedef short v4i16_t __attribute__((ext_vector_type(4)));
__device__ __forceinline__ void kload8(bf16x8*kf,lds_cptr kp){
  kf[0]=*(const __attribute__((address_space(3))) bf16x8*)(kp);      kf[1]=*(const __attribute__((address_space(3))) bf16x8*)(kp+512);
  kf[2]=*(const __attribute__((address_space(3))) bf16x8*)(kp+2048); kf[3]=*(const __attribute__((address_space(3))) bf16x8*)(kp+2560);
  kf[4]=*(const __attribute__((address_space(3))) bf16x8*)(kp+4096); kf[5]=*(const __attribute__((address_space(3))) bf16x8*)(kp+4608);
  kf[6]=*(const __attribute__((address_space(3))) bf16x8*)(kp+6144); kf[7]=*(const __attribute__((address_space(3))) bf16x8*)(kp+6656);
}
__device__ __forceinline__ void kload2(bf16x8*kf,lds_cptr kp,int j){ kf[2*j]=*(const __attribute__((address_space(3))) bf16x8*)(kp+j*2048); kf[2*j+1]=*(const __attribute__((address_space(3))) bf16x8*)(kp+j*2048+512); }
__device__ __forceinline__ s16x4 vtr(lds_cptr p){ return __builtin_bit_cast(s16x4,__builtin_amdgcn_ds_read_tr16_b64_v4i16((__attribute__((address_space(3))) v4i16_t*)p)); }
__device__ __forceinline__ float rowmax(const f32x16&p0,const f32x16&p1){
  float a=max3f(p0[0],p0[1],p1[0]),b=max3f(p0[2],p0[3],p1[1]);a=max3f(a,p1[2],p1[3]);
  #pragma unroll
  for(int r=4;r<16;r+=4){a=max3f(a,p0[r],p0[r+1]);b=max3f(b,p0[r+2],p0[r+3]);a=max3f(a,p1[r],p1[r+1]);b=max3f(b,p1[r+2],p1[r+3]);}
  const float m=max2f(a,b);
  auto rr=__builtin_amdgcn_permlane32_swap(__float_as_uint(m),__float_as_uint(m),false,false);
  return max2f(__uint_as_float(rr[0]),__uint_as_float(rr[1]));
}
__device__ __forceinline__ void pv(f32x16*o,int vb,bf16x8 pa0,bf16x8 pa1,bf16x8 pa2,bf16x8 pa3){
  #pragma unroll
  for(int d0=0;d0<2;++d0){s16x4 lo[4],hi[4];
    #pragma unroll
    for(int ks=0;ks<4;++ks){
      asm volatile("ds_read_b64_tr_b16 %0,%1 offset:%c2":"=&v"(lo[ks]):"v"(vb),"i"(d0*4096+ks*1024):"memory");
      asm volatile("ds_read_b64_tr_b16 %0,%1 offset:%c2":"=&v"(hi[ks]):"v"(vb),"i"(d0*4096+ks*1024+512):"memory");}
    asm volatile("s_waitcnt lgkmcnt(0)":::"memory");SBAR();
    #define PK(k) (bf16x8){lo[k][0],lo[k][1],lo[k][2],lo[k][3],hi[k][0],hi[k][1],hi[k][2],hi[k][3]}
    o[d0]=__builtin_amdgcn_mfma_f32_32x32x16_bf16(pa0,PK(0),o[d0],0,0,0);
    o[d0]=__builtin_amdgcn_mfma_f32_32x32x16_bf16(pa1,PK(1),o[d0],0,0,0);
    o[d0]=__builtin_amdgcn_mfma_f32_32x32x16_bf16(pa2,PK(2),o[d0],0,0,0);
    o[d0]=__builtin_amdgcn_mfma_f32_32x32x16_bf16(pa3,PK(3),o[d0],0,0,0);
    #undef PK
  }
}

#ifndef ATTN_STORE16
#define ATTN_STORE16(p,v) (*(u32x4*)(p)=(v))
#endif
template<int THRL> __device__ __forceinline__ void attn_unit(const bf16*Qu,const bf16*__restrict__ Kh,const bf16*__restrict__ Vh,bf16*Ou,const int NT,char*shm){
  int tid_=threadIdx.x; asm volatile("":"+v"(tid_)); const int tid=tid_,lane=tid&63,r32=lane&31,hi=lane>>5; const int wid=__builtin_amdgcn_readfirstlane(tid>>6);
  const bf16*Qw=Qu+(long)(wid*QBLK)*PQ;
  const unsigned lds0=(unsigned)(uintptr_t)shm;
  float*wsf=(float*)(shm+LDS_WS)+wid*64;
  const bf16*ksrc=Kh+(long)lane*PQ+wid*8;
  const bf16*vsrc=Vh+(long)(16*(wid&3)+(lane>>2))*PQ+(wid>>2)*32+(lane&3)*8;
  const unsigned kdst=lds0+LDS_K+wid*1024, vdst=lds0+LDS_V+wid*1024;
  #define DMA_K(t,slot) glds16(ksrc+(long)(t)*KVBLK*PQ,(unsigned)__builtin_amdgcn_readfirstlane(kdst+(slot)))
  #define DMA_V(t,slot) glds16(vsrc+(long)(t)*KVBLK*PQ,(unsigned)__builtin_amdgcn_readfirstlane(vdst+(slot)))
  const int vb0=(int)(lds0+LDS_V)+((lane>>4)&1)*32+(lane&3)*8+(4*hi+((lane&15)>>2))*64;
  const char*Kbase=shm+LDS_K; bf16x8 kf[8];
  const lds_cptr shm3=(lds_cptr)shm; const lds_cptr kp0=shm3+LDS_K+hi*1024+r32*16; const lds_cptr vp0=shm3+LDS_V+((lane>>4)&1)*32+(lane&3)*8+(4*hi+((lane&15)>>2))*64;
  DMA_K(0,0);DMA_V(0,0);DMA_K(1,SLOTB);
  bf16x8 qr[4];
  #pragma unroll
  for(int d0=0;d0<4;++d0)qr[d0]=*reinterpret_cast<const bf16x8*>(&Qw[(long)r32*PQ+d0*16+hi*8]);
  float mhat=0.f,l_reg=0.f;f32x16 o[2];o[0]=f32x16{};o[1]=f32x16{};f32x16 negm=f32x16{};asm volatile("":"+v"(negm));
  #define CMASK(P0,P1,t) do{}while(0)
  bool resc=false;
  #define START(P0,P1) do{ const float rm=rowmax(P0,P1); resc=false; \
    { const float dl=rm; mhat=fadd_s(mhat,dl); \
      _Pragma("unroll") for(int r=0;r<16;++r){P0[r]=fsub_s(P0[r],dl);P1[r]=fsub_s(P1[r],dl);} \
      _Pragma("unroll") for(int r=0;r<16;++r)negm[r]=-mhat; asm volatile("":"+v"(negm)); } \
    _Pragma("unroll") for(int r=0;r<16;++r)P0[r]=__builtin_amdgcn_exp2f(P0[r]); }while(0)
  #define RESC() do{ if(resc){ asm volatile("s_waitcnt lgkmcnt(0)":::"memory"); \
      _Pragma("unroll") for(int d_=0;d_<2;++d_) _Pragma("unroll") for(int r=0;r<16;++r)o[d_][r]*=wsf[crow(r,hi)]; } }while(0)
  f32x16 pA0,pA1,pB0,pB1;
  int sl_prev=0,sl_cur=0,sl_next=SLOTB;
  #define ROT() do{sl_prev=sl_cur;sl_cur=sl_next;sl_next=(sl_next==(NSLOT-1)*SLOTB)?0:sl_next+SLOTB;}while(0)
  DMA_K(2,2*SLOTB);
  WAIT_BAR(3);
  qkt(pA0,pA1,Kbase,qr,negm,r32,hi);asm volatile("s_nop 15\n\ts_nop 7":"+v"(pA0),"+v"(pA1));CMASK(pA0,pA1,0);
  START(pA0,pA1);
  _Pragma("unroll") for(int r=0;r<16;++r)pA1[r]=__builtin_amdgcn_exp2f(pA1[r]);
  WAIT_BAR(0);
  DMA_K(3,0);DMA_V(1,SLOTB);
  ROT();
  kload8(kf,kp0+sl_cur);
  WAIT_BAR(2);
  s16x4 vlo[8],vhi[8]; u32x4 pw0,pw1,pw2,pw3;
  #define PKW(P,B) cvtpk_s(P[B],P[B+1])
  #define PAF(k) __builtin_bit_cast(bf16x8,pw##k)
  #define VFR(i) (bf16x8){vlo[i][0],vlo[i][1],vlo[i][2],vlo[i][3],vhi[i][0],vhi[i][1],vhi[i][2],vhi[i][3]}
  #define PIN(x) asm volatile("":"+v"(x))
  #define MX3(a,b,c) __builtin_fmaxf(__builtin_fmaxf((a),(b)),(c))
  #define GAPA(MF,A0,A1,A2,A3,W0,W1,PW) do{ MF; sacc+=A0; sacc+=A1; sacc+=A2; sacc+=A3; PIN(sacc); W0; W1; PIN(PW); SBAR(); }while(0)
  #define EX(v) __builtin_amdgcn_exp2f(v)
  #define GAPB(MF,X,B) do{ MF; X[B]=EX(X[B]); X[B+1]=EX(X[B+1]); X[B+2]=EX(X[B+2]); X[B+3]=EX(X[B+3]); PIN(X); SBAR(); }while(0)
  #define VRD(i) do{ vlo[i]=vtr(vp_+(((i)>>2)*4096+((i)&3)*1024)); vhi[i]=vtr(vp_+(((i)>>2)*4096+((i)&3)*1024+512)); }while(0)
  #define KRD(G,j) do{ if(G){ kload2(kf,kp0+sl_next,j); SBAR(); } }while(0)
  #define STEP(C0,C1,P0,P1,t,GK,GV,GL) do{ SBAR(); \
    const lds_cptr vp_=vp0+sl_prev; \
    VRD(0); SBAR(); float sacc=(P0[0]+P0[1]); \
    GAPA(C0=__builtin_amdgcn_mfma_f32_32x32x16_bf16(kf[0],qr[0],negm,0,0,0), P0[2],P0[3],P0[4],P0[5],     pw0[0]=PKW(P0,0), pw0[1]=PKW(P0,2), pw0); \
    VRD(4); SBAR(); GAPA(C1=__builtin_amdgcn_mfma_f32_32x32x16_bf16(kf[1],qr[0],negm,0,0,0), P0[6],P0[7],P0[8],P0[9],     pw0[2]=PKW(P0,4), pw0[3]=PKW(P0,6), pw0); \
    VRD(1); SBAR(); GAPA(C0=__builtin_amdgcn_mfma_f32_32x32x16_bf16(kf[2],qr[1],C0,0,0,0),   P0[10],P0[11],P0[12],P0[13], pw1[0]=PKW(P0,8), pw1[1]=PKW(P0,10), pw1); \
    VRD(5); SBAR(); GAPA(C1=__builtin_amdgcn_mfma_f32_32x32x16_bf16(kf[3],qr[1],C1,0,0,0),   P0[14],P0[15],P1[0],P1[1],   pw1[2]=PKW(P0,12),pw1[3]=PKW(P0,14), pw1); \
    VRD(2); SBAR(); GAPA(C0=__builtin_amdgcn_mfma_f32_32x32x16_bf16(kf[4],qr[2],C0,0,0,0),   P1[2],P1[3],P1[4],P1[5],     pw2[0]=PKW(P1,0), pw2[1]=PKW(P1,2), pw2); \
    VRD(6); SBAR(); GAPA(C1=__builtin_amdgcn_mfma_f32_32x32x16_bf16(kf[5],qr[2],C1,0,0,0),   P1[6],P1[7],P1[8],P1[9],     pw2[2]=PKW(P1,4), pw2[3]=PKW(P1,6), pw2); \
    VRD(3); SBAR(); GAPA(C0=__builtin_amdgcn_mfma_f32_32x32x16_bf16(kf[6],qr[3],C0,0,0,0),   P1[10],P1[11],P1[12],P1[13], pw3[0]=PKW(P1,8), pw3[1]=PKW(P1,10), pw3); \
    VRD(7); SBAR(); GAPA(C1=__builtin_amdgcn_mfma_f32_32x32x16_bf16(kf[7],qr[3],C1,0,0,0),   P1[14],P1[15],0.f,0.f,       pw3[2]=PKW(P1,12),pw3[3]=PKW(P1,14), pw3); \
    l_reg+=sacc; \
    if(GK){DMA_K((t)+3,sl_cur);} if(GV){DMA_V((t)+1,sl_next);} \
    CMASK(C0,C1,t); \
    { float a=MX3(C0[0],C0[1],C1[0]),b=MX3(C0[2],C0[3],C1[1]); a=MX3(a,C1[2],C1[3]); \
      _Pragma("unroll") for(int r=4;r<16;r+=4){a=MX3(a,C0[r],C0[r+1]);b=MX3(b,C0[r+2],C0[r+3]);a=MX3(a,C1[r],C1[r+1]);b=MX3(b,C1[r+2],C1[r+3]);} \
      float rm=__builtin_fmaxf(a,b); { auto rr=__builtin_amdgcn_permlane32_swap(__float_as_uint(rm),__float_as_uint(rm),false,false); rm=__builtin_fmaxf(__uint_as_float(rr[0]),__uint_as_float(rr[1])); } \
      resc=false; \
      if(__builtin_expect(__any(rm>(float)THRL),0)){ const float dl=__builtin_fmaxf(rm,0.f); mhat+=dl; \
        _Pragma("unroll") for(int r=0;r<16;++r){C0[r]-=dl;C1[r]-=dl;} \
        _Pragma("unroll") for(int r=0;r<16;++r)negm[r]=-mhat; asm volatile("":"+v"(negm)); \
        const float f=__builtin_amdgcn_exp2f(-dl); l_reg*=f; if(hi==0)wsf[r32]=f; resc=true; } } \
    SBAR(); \
    GAPB(o[0]=__builtin_amdgcn_mfma_f32_32x32x16_bf16(PAF(0),VFR(0),o[0],0,0,0), C0,0); \
    GAPB(o[1]=__builtin_amdgcn_mfma_f32_32x32x16_bf16(PAF(0),VFR(4),o[1],0,0,0), C0,4); \
    KRD(GL,0); GAPB(o[0]=__builtin_amdgcn_mfma_f32_32x32x16_bf16(PAF(1),VFR(1),o[0],0,0,0), C0,8); \
    KRD(GL,1); GAPB(o[1]=__builtin_amdgcn_mfma_f32_32x32x16_bf16(PAF(1),VFR(5),o[1],0,0,0), C0,12); \
    KRD(GL,2); GAPB(o[0]=__builtin_amdgcn_mfma_f32_32x32x16_bf16(PAF(2),VFR(2),o[0],0,0,0), C1,0); \
    KRD(GL,3); GAPB(o[1]=__builtin_amdgcn_mfma_f32_32x32x16_bf16(PAF(2),VFR(6),o[1],0,0,0), C1,4); \
    GAPB(o[0]=__builtin_amdgcn_mfma_f32_32x32x16_bf16(PAF(3),VFR(3),o[0],0,0,0), C1,8); \
    GAPB(o[1]=__builtin_amdgcn_mfma_f32_32x32x16_bf16(PAF(3),VFR(7),o[1],0,0,0), C1,12); \
    }while(0)
  int t=1;
  #undef CMASK
  #define CMASK(P0,P1,t) do{}while(0)
  for(;t+5<NT;t+=2){
    STEP(pB0,pB1,pA0,pA1,t,true,true,true);     WAIT_BAR(2); RESC(); ROT();
    STEP(pA0,pA1,pB0,pB1,t+1,true,true,true);   WAIT_BAR(2); RESC(); ROT();
  }
  #undef CMASK
  #define CMASK(P0,P1,t) do{}while(0)
  #define ENDW(tt) do{ if((tt)+3<NT){WAIT_BAR(2);} else if((tt)+2<NT){WAIT_BAR(1);} else {WAIT_BAR(0);} }while(0)
  for(;t+1<NT;t+=2){
    STEP(pB0,pB1,pA0,pA1,t,(t+3<NT),(t+1<NT),(t+1<NT));       ENDW(t);   RESC(); ROT();
    STEP(pA0,pA1,pB0,pB1,t+1,(t+4<NT),(t+2<NT),(t+2<NT));     ENDW(t+1); RESC(); ROT();
  }
  STEP(pB0,pB1,pA0,pA1,NT-1,false,false,false); RESC();
  { float sacc=pB0[0]+pB0[1]; _Pragma("unroll") for(int r=2;r<16;++r)sacc+=pB0[r]; _Pragma("unroll") for(int r=0;r<16;++r)sacc+=pB1[r]; l_reg+=sacc;
    pw0=(u32x4){PKW(pB0,0),PKW(pB0,2),PKW(pB0,4),PKW(pB0,6)};pw1=(u32x4){PKW(pB0,8),PKW(pB0,10),PKW(pB0,12),PKW(pB0,14)};pw2=(u32x4){PKW(pB1,0),PKW(pB1,2),PKW(pB1,4),PKW(pB1,6)};pw3=(u32x4){PKW(pB1,8),PKW(pB1,10),PKW(pB1,12),PKW(pB1,14)};
    SBAR(); pv(o,vb0+sl_cur,PAF(0),PAF(1),PAF(2),PAF(3)); }
  #undef PKW
  #undef PAF
  #undef VFR
  #undef PIN
  #undef MX3
  #undef GAPA
  #undef GAPB
  #undef EX
  #undef VRD
  #undef KRD
  #undef STEP
  #undef ENDW
  {auto rr=__builtin_amdgcn_permlane32_swap(__float_as_uint(l_reg),__float_as_uint(l_reg),false,false);l_reg=__uint_as_float(rr[0])+__uint_as_float(rr[1]);}
  if(hi==0)wsf[32+r32]=l_reg;asm volatile("s_waitcnt lgkmcnt(0)":::"memory");
  float rli[16];
  #pragma unroll
  for(int r=0;r<16;++r)rli[r]=__builtin_amdgcn_rcpf(wsf[32+crow(r,hi)]);
  bf16*Ow=Ou+(long)(wid*QBLK)*PO;
  { bf16*stg=(bf16*)(shm+LDS_OST)+wid*2048;
    #pragma unroll
    for(int r=0;r<16;++r){const int orow=crow(r,hi);
      #pragma unroll
      for(int d0=0;d0<2;++d0)stg[orow*64+d0*32+r32]=__float2bfloat16(o[d0][r]*rli[r]);}
    asm volatile("s_waitcnt lgkmcnt(0)":::"memory");
    #pragma unroll
    for(int i=0;i<4;++i){const int row=i*8+(lane>>3),ch=lane&7; const u32x4 v=*(const u32x4*)(stg+row*64+ch*8); ATTN_STORE16(Ow+(long)row*PO+ch*8,v);} }
  asm volatile("s_waitcnt lgkmcnt(0)\n\ts_barrier":::"memory");
  #undef DMA_K
  #undef DMA_V
  #undef CMASK
  #undef START
  #undef RESC
  #undef ROT
}
constexpr int ATTN_LDS_BYTES=LDS_BYTES;
#undef SBAR
#undef WAIT_BAR
}
#define GAS __attribute__((address_space(1)))
#define LAS __attribute__((address_space(3)))
typedef unsigned short bf16;
typedef unsigned v4u __attribute__((ext_vector_type(4)));
typedef unsigned v2u __attribute__((ext_vector_type(2)));
typedef float f32x4 __attribute__((ext_vector_type(4)));
typedef short bf16x8 __attribute__((ext_vector_type(8)));
#define LDS_WAIT() asm volatile("s_waitcnt lgkmcnt(0)" ::: "memory")
#define LDS_BARRIER() do { asm volatile("s_waitcnt lgkmcnt(0)" ::: "memory"); __builtin_amdgcn_s_barrier(); asm volatile("" ::: "memory"); } while (0)

constexpr int NWAVES = 8;
constexpr int DM = 1024, FF = 4096, DEPTH = 2;
constexpr int MH = 24576, MP = 16384;
constexpr int SP = 2048, SS = 8192;
constexpr int PW = 4096, INW = 3872;
constexpr int C_AQ = 0, C_AK = 512, C_AV = 640, C_GQ = 768, C_GK = 1024, C_GV = 1280, C_GA = 1792, C_GG = 1824, C_RQ = 2336, C_RK = 2592, C_RV = 2848, C_RG = 3360;
constexpr float EPS = 1e-6f;
constexpr float ATT_C2 = 0.125f * 1.4426950408889634f;

constexpr size_t MiB = 1u << 20;
constexpr size_t WS_CTL = 0, CTL_ZERO_BYTES = 65536;
constexpr int CW_BAR = 4096;
constexpr size_t WS_W = 1 * MiB, LW = 35 * MiB;
constexpr size_t OW_IN = 0, OW_MERGE = 8 * MiB, OW_BR = 14 * MiB, OW_OUT = 17 * MiB, OW_UP = 19 * MiB, OW_DOWN = 27 * MiB;
constexpr size_t WS_XN = 71 * MiB;
constexpr size_t WS_PROJ = 119 * MiB;
constexpr size_t WS_MERGED = WS_PROJ + 144 * MiB;
constexpr size_t WS_OBUF = 311 * MiB;
constexpr size_t OB1 = (size_t)MH * 512;
constexpr size_t WS_SCF = 431 * MiB, WS_SCD = 443 * MiB;
constexpr size_t WS_END = 444 * MiB;

constexpr int RING_BYTES = 131072, MISC_OFF = RING_BYTES + 320, LDS_BYTES = 147456;

__device__ __forceinline__ unsigned f2bf(float f) { unsigned u = __builtin_bit_cast(unsigned, f); return (u + 0x7fffu + ((u >> 16) & 1u)) >> 16; }
typedef float f32x2_t_ __attribute__((ext_vector_type(2))); typedef __bf16 bf16x2_t_ __attribute__((ext_vector_type(2)));
__device__ __forceinline__ unsigned pk2(float lo, float hi) { const f32x2_t_ v = {lo, hi}; const bf16x2_t_ b = __builtin_convertvector(v, bf16x2_t_); return __builtin_bit_cast(unsigned, b); }
__device__ __forceinline__ float bf_lo(unsigned w) { return __builtin_bit_cast(float, w << 16); }
__device__ __forceinline__ float bf_hi(unsigned w) { return __builtin_bit_cast(float, w & 0xffff0000u); }
__device__ __forceinline__ float bf1(unsigned short h) { return __builtin_bit_cast(float, (unsigned)h << 16); }
__device__ __forceinline__ void unpack8(const v4u w, float (&v)[8]) { v[0] = bf_lo(w.x); v[1] = bf_hi(w.x); v[2] = bf_lo(w.y); v[3] = bf_hi(w.y); v[4] = bf_lo(w.z); v[5] = bf_hi(w.z); v[6] = bf_lo(w.w); v[7] = bf_hi(w.w); }
__device__ __forceinline__ v4u pack8(const float (&v)[8]) { v4u w; w.x = pk2(v[0], v[1]); w.y = pk2(v[2], v[3]); w.z = pk2(v[4], v[5]); w.w = pk2(v[6], v[7]); return w; }
__device__ __forceinline__ float wave_sum(float v) {
#pragma unroll
    for (int o = 1; o < 64; o <<= 1) v += __shfl_xor(v, o);
    return v;
}
__device__ __forceinline__ float sigmoidf_fast(float a) { return __builtin_amdgcn_rcpf(1.0f + __builtin_amdgcn_exp2f(-1.4426950408889634f * a)); }

__device__ __forceinline__ void p0_transpose_item(const float* W, int K, int N, bf16* WT, int row_off, LAS float* scr, int item, int lane) {
    const int nblk = N / 32, kb = item / nblk, nb = item % nblk, k0 = 64 * kb, n0 = 32 * nb;
#pragma unroll 8
    for (int i = 0; i < 32; ++i) { const int kk = 2 * i + (lane >> 5); scr[kk * 33 + (lane & 31)] = W[(size_t)(k0 + kk) * N + n0 + (lane & 31)]; }
    LDS_WAIT(); asm volatile("" ::: "memory");
    const int c = lane & 7;
#pragma unroll
    for (int j = 0; j < 4; ++j) { const int n = (lane >> 3) + 8 * j; const LAS float* s = scr + (8 * c) * 33 + n;
        v4u o; o.x = pk2(s[0 * 33], s[1 * 33]); o.y = pk2(s[2 * 33], s[3 * 33]); o.z = pk2(s[4 * 33], s[5 * 33]); o.w = pk2(s[6 * 33], s[7 * 33]);
        *(v4u*)(WT + (size_t)(row_off + n0 + n) * K + k0 + 8 * c) = o; }
    LDS_WAIT(); asm volatile("" ::: "memory");
}

__device__ __forceinline__ void norm_rows(const float* xp, const float* xs, const float* gain, bf16* XN, int gw, int NGW, int lane_in) {
    int lane = lane_in; asm volatile("" : "+v"(lane)); asm volatile("" : "+s"(gw));
    f32x4 g[4];
#pragma unroll
    for (int j = 0; j < 4; ++j) g[j] = *((const f32x4*)gain + lane + 64 * j);
    for (int m0 = gw; m0 < MH; m0 += 4 * NGW) {
        f32x4 v[4][4]; float s[4];
#pragma unroll
        for (int r = 0; r < 4; ++r) { const int m = m0 + r * NGW; s[r] = 0.f;
            if (m < MH) { const float* xrow = m < MP ? xp + (size_t)m * DM : xs + (size_t)(m - MP) * DM; const f32x4* xr = (const f32x4*)xrow + lane;
#pragma unroll
                for (int j = 0; j < 4; ++j) v[r][j] = xr[64 * j]; } }
#pragma unroll
        for (int r = 0; r < 4; ++r) { const int m = m0 + r * NGW;
            if (m < MH) {
#pragma unroll
                for (int j = 0; j < 4; ++j) s[r] += (v[r][j].x * v[r][j].x + v[r][j].y * v[r][j].y) + (v[r][j].z * v[r][j].z + v[r][j].w * v[r][j].w);
                const float rstd = 1.0f / sqrtf(wave_sum(s[r]) * (1.f / DM) + EPS);
                unsigned long long* o8 = (unsigned long long*)(XN + (size_t)m * DM) + lane;
#pragma unroll
                for (int j = 0; j < 4; ++j) { const f32x4 y = v[r][j] * rstd * g[j]; o8[64 * j] = (unsigned long long)pk2(y.x, y.y) | ((unsigned long long)pk2(y.z, y.w) << 32); } } }
    }
}
__device__ __forceinline__ void final_norm(float* out, const float* gain, int gw, int NGW, int lane_in) {
    int lane = lane_in; asm volatile("" : "+v"(lane)); asm volatile("" : "+s"(gw));
    f32x4 g[4];
#pragma unroll
    for (int j = 0; j < 4; ++j) g[j] = *((const f32x4*)gain + lane + 64 * j);
    for (int m0 = gw; m0 < 2 * MH; m0 += 4 * NGW) {
        f32x4 v[4][4]; float s[4];
#pragma unroll
        for (int r = 0; r < 4; ++r) { const int m = m0 + r * NGW; s[r] = 0.f;
            if (m < 2 * MH) { const f32x4* xr = (const f32x4*)(out + (size_t)m * DM) + lane;
#pragma unroll
                for (int j = 0; j < 4; ++j) v[r][j] = xr[64 * j]; } }
#pragma unroll
        for (int r = 0; r < 4; ++r) { const int m = m0 + r * NGW;
            if (m < 2 * MH) { f32x4* xr = (f32x4*)(out + (size_t)m * DM) + lane;
#pragma unroll
                for (int j = 0; j < 4; ++j) s[r] += (v[r][j].x * v[r][j].x + v[r][j].y * v[r][j].y) + (v[r][j].z * v[r][j].z + v[r][j].w * v[r][j].w);
                const float rstd = 1.0f / sqrtf(wave_sum(s[r]) * (1.f / DM) + EPS);
#pragma unroll
                for (int j = 0; j < 4; ++j) xr[64 * j] = v[r][j] * rstd * g[j]; } }
    }
}

__device__ __forceinline__ void rope8(float (&v)[8], int lane, int t) {
    const int sub = lane & 7;
    const float pos = (float)((sub & 4) ? (t & 63) : (t >> 6));
    const bool upper = (sub & 2) != 0;
    const int i0 = 8 * (sub & 1);
#pragma unroll
    for (int e = 0; e < 8; ++e) {
        const float partner = __shfl_xor(v[e], 2);
        const float inv = __builtin_amdgcn_exp2f(-(float)(i0 + e) * 0.8304820237218406f);
        const float ang = pos * inv, s = __sinf(ang), c = __cosf(ang);
        v[e] = v[e] * c + (upper ? partner : -partner) * s;
    }
}
__device__ __forceinline__ float sum8lanes(float s) { s += __shfl_xor(s, 1); s += __shfl_xor(s, 2); s += __shfl_xor(s, 4); return s; }
__device__ __forceinline__ void e1_rows(bf16* proj, const float* qg, const float* kg, int gw, int NGW, int lane_in) {
    int lane = lane_in; asm volatile("" : "+v"(lane)); asm volatile("" : "+s"(gw));
    float gq[8], gk[8];
#pragma unroll
    for (int e = 0; e < 8; ++e) { gq[e] = qg[8 * (lane & 7) + e]; gk[e] = kg[8 * (lane & 7) + e]; }
    for (int m0 = gw; m0 < MH; m0 += 2 * NGW) {
        v4u wq[2], wk[2], wg2[2], wr[2];
#pragma unroll
        for (int rr = 0; rr < 2; ++rr) { const int m = (m0 + rr * NGW) < MH ? (m0 + rr * NGW) : m0; bf16* row = proj + (size_t)m * PW;
            wq[rr] = *(const v4u*)(row + C_AQ + 8 * lane); wk[rr] = *(const v4u*)(row + C_AK + 8 * (lane & 15));
            wg2[rr] = *(const v4u*)(row + C_GQ + 8 * (lane & 31)); wr[rr] = *(const v4u*)(row + (lane < 32 ? C_RQ : C_RK) + 8 * (lane & 31)); }
#pragma unroll
        for (int rr = 0; rr < 2; ++rr) { const int m = m0 + rr * NGW; if (m >= MH) break;
        const int t = m < MP ? (m & (SP - 1)) : (m - MP);
        bf16* row = proj + (size_t)m * PW;
        { float v[8]; unpack8(wq[rr], v);
          float s = 0.f;
#pragma unroll
          for (int e = 0; e < 8; ++e) s += v[e] * v[e];
          const float rstd = 1.0f / sqrtf(sum8lanes(s) * (1.f / 64.f) + EPS);
#pragma unroll
          for (int e = 0; e < 8; ++e) v[e] = v[e] * rstd * gq[e];
          rope8(v, lane, t);
#pragma unroll
          for (int e = 0; e < 8; ++e) v[e] *= ATT_C2;
          *(v4u*)(row + C_AQ + 8 * lane) = pack8(v); }
        { const int l2 = lane & 15; float v[8]; unpack8(wk[rr], v);
          float s = 0.f;
#pragma unroll
          for (int e = 0; e < 8; ++e) s += v[e] * v[e];
          const float rstd = 1.0f / sqrtf(sum8lanes(s) * (1.f / 64.f) + EPS);
#pragma unroll
          for (int e = 0; e < 8; ++e) v[e] = v[e] * rstd * gk[e];
          rope8(v, lane, t);
          if (lane < 16) *(v4u*)(row + C_AK + 8 * l2) = pack8(v); }
        { const int l2 = lane & 31;
          if (lane < 32) { float v[8]; unpack8(wg2[rr], v);
#pragma unroll
              for (int e = 0; e < 8; ++e) v[e] *= 0.125f;
              *(v4u*)(row + C_GQ + 8 * l2) = pack8(v); }
          bf16* p = row + (lane < 32 ? C_RQ : C_RK) + 8 * l2;
          float v[8]; unpack8(wr[rr], v);
          rope8(v, lane, t);
          const float sc = lane < 32 ? 1.0f : 0.125f;
#pragma unroll
          for (int e = 0; e < 8; ++e) v[e] *= sc;
          *(v4u*)p = pack8(v); }
        }
    }
}

__device__ __forceinline__ float sum16lanes(float s) { s += __shfl_xor(s, 1); s += __shfl_xor(s, 2); s += __shfl_xor(s, 4); s += __shfl_xor(s, 8); return s; }
__device__ __forceinline__ void e2_rows(const bf16* proj, bf16* obuf, const float* ggain, int gw, int NGW, int lane_in) {
    int lane = lane_in; asm volatile("" : "+v"(lane)); asm volatile("" : "+s"(gw));
    float gn[8];
#pragma unroll
    for (int e = 0; e < 8; ++e) gn[e] = ggain[8 * (lane & 15) + e];
    for (int m0 = gw; m0 < MH; m0 += 2 * NGW) {
        v4u la_[2], lb_[2], lg_[2], ra_[2], rb_[2], rg_[2];
#pragma unroll
        for (int rr = 0; rr < 2; ++rr) { const int m = (m0 + rr * NGW) < MH ? (m0 + rr * NGW) : m0; const bf16* prow = proj + (size_t)m * PW; const size_t o = (size_t)m * 512 + 8 * lane;
            la_[rr] = *(const v4u*)(obuf + 1 * OB1 + o); lb_[rr] = *(const v4u*)(obuf + 3 * OB1 + o); lg_[rr] = *(const v4u*)(prow + C_GG + 8 * lane);
            ra_[rr] = *(const v4u*)(obuf + 2 * OB1 + o); rb_[rr] = *(const v4u*)(obuf + 4 * OB1 + o); rg_[rr] = *(const v4u*)(prow + C_RG + 8 * lane); }
#pragma unroll
        for (int rr = 0; rr < 2; ++rr) { const int m = m0 + rr * NGW; if (m >= MH) break;
        const size_t o = (size_t)m * 512 + 8 * lane;
        { float a[8], b[8], g[8]; unpack8(la_[rr], a); unpack8(lb_[rr], b); unpack8(lg_[rr], g);
          float s = 0.f;
#pragma unroll
          for (int e = 0; e < 8; ++e) { a[e] += b[e]; s += a[e] * a[e]; }
          const float rstd = 1.0f / sqrtf(sum16lanes(s) * (1.f / 128.f) + EPS);
#pragma unroll
          for (int e = 0; e < 8; ++e) a[e] = a[e] * rstd * gn[e] * (g[e] * sigmoidf_fast(g[e]));
          *(v4u*)(obuf + 1 * OB1 + o) = pack8(a); }
        { float a[8], b[8], g[8]; unpack8(ra_[rr], a); unpack8(rb_[rr], b); unpack8(rg_[rr], g);
          float s = 0.f;
#pragma unroll
          for (int e = 0; e < 8; ++e) { a[e] += b[e]; s += a[e]; }
          const float mu = sum16lanes(s) * (1.f / 128.f); float q = 0.f;
#pragma unroll
          for (int e = 0; e < 8; ++e) { a[e] -= mu; q += a[e] * a[e]; }
          const float rstd = 1.0f / sqrtf(sum16lanes(q) * (1.f / 128.f) + EPS);
#pragma unroll
          for (int e = 0; e < 8; ++e) a[e] = a[e] * rstd * (g[e] * sigmoidf_fast(g[e]));
          *(v4u*)(obuf + 2 * OB1 + o) = pack8(a); }
        }
    }
}

constexpr int SC_LD = 72;
constexpr int SC_QIN = 0, SC_KIN = 9216, SC_QB = 18432, SC_KDT = 27648, SC_SM = 36864, SC_VT = 46080, SC_TOT = 64512, SC_DEC = 66560, SC_ZS = 66816, SC_END = 70912;
template <bool GLA, bool STATE_ONLY> __device__ __forceinline__ void scan_unit(LAS unsigned char* shm, const bf16* proj, bf16* outb, int row0, int len, int h, int dir,
                                                              const float* wg, const float* bg, float lgam, int c0, int c1, const float* Fprev, const float* Dprev, int nprev, float* Fout, float* Dout) {
    int tid_ = threadIdx.x; asm volatile("" : "+v"(tid_)); const int tid = tid_, lane = tid & 63, wid = __builtin_amdgcn_readfirstlane(tid >> 6), fr = lane & 15, fq = lane >> 4;
    const int cq = (GLA ? C_GQ : C_RQ) + h * 64, ck = (GLA ? C_GK : C_RK) + h * 64, cv = (GLA ? C_GV : C_RV) + h * 128, cz = C_GA + dir * 16;
    LAS bf16* qin = (LAS bf16*)(shm + SC_QIN); LAS bf16* kin = (LAS bf16*)(shm + SC_KIN); LAS bf16* qb = (LAS bf16*)(shm + SC_QB);
    LAS bf16* kdT = (LAS bf16*)(shm + SC_KDT); LAS bf16* sm = (LAS bf16*)(shm + SC_SM); LAS bf16* vT = (LAS bf16*)(shm + SC_VT);
    LAS float* tot = (LAS float*)(shm + SC_TOT); LAS float* dec = (LAS float*)(shm + SC_DEC); LAS float* zs = (LAS float*)(shm + SC_ZS);
    float w[16]; float bias = 0.f;
    if (GLA) {
#pragma unroll
        for (int r = 0; r < 16; ++r) w[r] = wg[r * 256 + h * 64 + lane];
        bias = bg[h * 64 + lane];
    }
    f32x4 S[4];
#pragma unroll
    for (int i = 0; i < 4; ++i) S[i] = (f32x4){0.f, 0.f, 0.f, 0.f};
    if (!STATE_ONLY) {
        for (int s = 0; s < nprev; ++s) {
#pragma unroll
            for (int db = 0; db < 4; ++db)
#pragma unroll
                for (int r = 0; r < 4; ++r) { const int d = db * 16 + 4 * fq + r; S[db][r] = S[db][r] * Dprev[s * 64 + d] + Fprev[(size_t)s * 8192 + d * 128 + 16 * wid + fr]; }
        }
    }
    float sumlog = 0.f;
    unsigned short qr[8], kr[8]; v4u vr0, vr1, zr;
    unsigned short qn[8], kn[8]; v4u vn0, vn1, zn;
    unsigned short qm[8], km[8]; v4u vm0, vm1, zm;
#define SC_ROW(c, i) (dir == 0 ? row0 + (c) * 64 + (i) : row0 + len - 1 - ((c) * 64 + (i)))
#define SC_LOAD(c, Q, K, V0, V1, Z) do { \
        _Pragma("unroll") for (int e = 0; e < 8; ++e) { const bf16* rp = proj + (size_t)SC_ROW(c, 8 * wid + e) * PW; if (!STATE_ONLY) Q[e] = rp[cq + lane]; K[e] = rp[ck + lane]; } \
        { const bf16* rp = proj + (size_t)SC_ROW(c, lane) * PW + cv + 16 * wid; V0 = *(const v4u*)rp; V1 = *(const v4u*)(rp + 8); } \
        if (GLA) { if (tid < 128) Z = *(const v4u*)(proj + (size_t)SC_ROW(c, tid >> 1) * PW + cz + 8 * (tid & 1)); } } while (0)
    zr = (v4u){0u, 0u, 0u, 0u}; zn = zr; zm = zr; vn0 = zr; vn1 = zr; vm0 = zr; vm1 = zr;
#pragma unroll
    for (int e = 0; e < 8; ++e) { qr[e] = 0; qn[e] = 0; qm[e] = 0; kn[e] = 0; km[e] = 0; }
    SC_LOAD(c0, qr, kr, vr0, vr1, zr);
    if (c0 + 1 < c1) SC_LOAD(c0 + 1, qn, kn, vn0, vn1, zn);
    for (int cb = c0; cb < c1; cb += 3) {
      { const int c = cb;
        float la[8];
        if (GLA) {
            if (tid < 128) { float z[8]; unpack8(zr, z); LAS float* zp = zs + (tid >> 1) * 16 + 8 * (tid & 1);
                *(LAS f32x4*)zp = (f32x4){z[0], z[1], z[2], z[3]}; *(LAS f32x4*)(zp + 4) = (f32x4){z[4], z[5], z[6], z[7]}; }
            LDS_BARRIER();
#pragma unroll
            for (int e = 0; e < 8; ++e) { const LAS f32x4* zp = (const LAS f32x4*)(zs + (8 * wid + e) * 16); float a = bias;
#pragma unroll
                for (int r4 = 0; r4 < 4; ++r4) { const f32x4 zz = zp[r4]; a += zz.x * w[4 * r4] + zz.y * w[4 * r4 + 1] + zz.z * w[4 * r4 + 2] + zz.w * w[4 * r4 + 3]; }
                la[e] = (fminf(a, 0.f) - __logf(1.0f + __expf(-fabsf(a)))) * 0.0625f; }
        } else {
#pragma unroll
            for (int e = 0; e < 8; ++e) la[e] = lgam;
        }
        float p[8]; p[0] = la[0];
#pragma unroll
        for (int e = 1; e < 8; ++e) p[e] = p[e - 1] + la[e];
        tot[wid * 64 + lane] = p[7];
        LDS_BARRIER();
        float off = 0.f, bref = 0.f, blast = 0.f;
#pragma unroll
        for (int g = 0; g < 8; ++g) { const float tg = tot[g * 64 + lane]; if (g < wid) off += tg; if (g < 4) bref += tg; blast += tg; }
        {
            const float ebref = __expf(bref), eblr = __expf(blast - bref);
            const bool odd = (lane & 1) != 0; const int prow = odd ? 1 : 0, pcol = lane & ~1;
            float kdv[8];
#pragma unroll
            for (int e = 0; e < 8; e += 2) {
                float xq[2], xk[2], xb[2];
#pragma unroll
                for (int u = 0; u < 2; ++u) { const float bb = off + p[e + u], q = bf1(qr[e + u]), k = bf1(kr[e + u]);
                    const float E = __expf(bb - bref), R = __builtin_amdgcn_rcpf(E);
                    xq[u] = q * E; xk[u] = k * R; xb[u] = q * (E * ebref); kdv[e + u] = k * (R * eblr); }
                if (!STATE_ONLY) {
                    const int o32 = (8 * wid + e + prow) * SC_LD + pcol;
                    { const unsigned w2 = pk2(xq[0], xq[1]), rv = (unsigned)__builtin_amdgcn_mov_dpp((int)w2, 0xB1, 0xF, 0xF, false);
                      *(LAS unsigned*)(qin + o32) = odd ? ((rv >> 16) | (w2 & 0xffff0000u)) : ((w2 & 0xffffu) | (rv << 16)); }
                    { const unsigned w2 = pk2(xk[0], xk[1]), rv = (unsigned)__builtin_amdgcn_mov_dpp((int)w2, 0xB1, 0xF, 0xF, false);
                      *(LAS unsigned*)(kin + o32) = odd ? ((rv >> 16) | (w2 & 0xffff0000u)) : ((w2 & 0xffffu) | (rv << 16)); }
                    { const unsigned w2 = pk2(xb[0], xb[1]), rv = (unsigned)__builtin_amdgcn_mov_dpp((int)w2, 0xB1, 0xF, 0xF, false);
                      *(LAS unsigned*)(qb + o32) = odd ? ((rv >> 16) | (w2 & 0xffff0000u)) : ((w2 & 0xffffu) | (rv << 16)); }
                }
            }
            *(LAS v4u*)(kdT + lane * SC_LD + 8 * wid) = (v4u){pk2(kdv[0], kdv[1]), pk2(kdv[2], kdv[3]), pk2(kdv[4], kdv[5]), pk2(kdv[6], kdv[7])};
            if (wid == 0) dec[lane] = ebref * eblr;
            sumlog += blast;
            const unsigned vw[8] = {vr0.x, vr0.y, vr0.z, vr0.w, vr1.x, vr1.y, vr1.z, vr1.w};
#pragma unroll
            for (int e = 0; e < 8; ++e) { const unsigned w2 = vw[e], rv = (unsigned)__builtin_amdgcn_mov_dpp((int)w2, 0xB1, 0xF, 0xF, false);
                *(LAS unsigned*)(vT + (16 * wid + 2 * e + prow) * SC_LD + pcol) = odd ? ((rv >> 16) | (w2 & 0xffff0000u)) : ((w2 & 0xffffu) | (rv << 16)); }
        }
        LDS_BARRIER();
        if (c + 2 < c1) SC_LOAD(c + 2, qm, km, vm0, vm1, zm);
        if (!STATE_ONLY) {
#pragma unroll
        for (int tt = 0; tt < 2; ++tt) { const int idx = 2 * wid + tt, ti = idx >> 2, tj = idx & 3;
            f32x4 a = (f32x4){0.f, 0.f, 0.f, 0.f};
            if (tj <= ti) {
#pragma unroll
                for (int ks = 0; ks < 2; ++ks) { const bf16x8 A = *(const LAS bf16x8*)(qin + (ti * 16 + fr) * SC_LD + 32 * ks + 8 * fq), B = *(const LAS bf16x8*)(kin + (tj * 16 + fr) * SC_LD + 32 * ks + 8 * fq);
                    a = __builtin_amdgcn_mfma_f32_16x16x32_bf16(B, A, a, 0, 0, 0); } }
            const int i = ti * 16 + fr, j0 = tj * 16 + 4 * fq;
#pragma unroll
            for (int r = 0; r < 4; ++r) a[r] = (j0 + r <= i) ? a[r] : 0.f;
            *(LAS v2u*)(sm + i * SC_LD + j0) = (v2u){pk2(a[0], a[1]), pk2(a[2], a[3])}; }
        LDS_BARRIER();
        }
        {
            bf16x8 bv[2];
#pragma unroll
            for (int ks = 0; ks < 2; ++ks) bv[ks] = *(const LAS bf16x8*)(vT + (16 * wid + fr) * SC_LD + 32 * ks + 8 * fq);
            if (!STATE_ONLY) {
            f32x4 o[4];
#pragma unroll
            for (int ib = 0; ib < 4; ++ib) { o[ib] = (f32x4){0.f, 0.f, 0.f, 0.f};
#pragma unroll
                for (int ks = 0; ks < 2; ++ks) { const bf16x8 A = *(const LAS bf16x8*)(sm + (ib * 16 + fr) * SC_LD + 32 * ks + 8 * fq); o[ib] = __builtin_amdgcn_mfma_f32_16x16x32_bf16(bv[ks], A, o[ib], 0, 0, 0); } }
#pragma unroll
            for (int ks = 0; ks < 2; ++ks) {
                v4u sw; sw.x = pk2(S[2 * ks][0], S[2 * ks][1]); sw.y = pk2(S[2 * ks][2], S[2 * ks][3]); sw.z = pk2(S[2 * ks + 1][0], S[2 * ks + 1][1]); sw.w = pk2(S[2 * ks + 1][2], S[2 * ks + 1][3]);
                const bf16x8 Bs = __builtin_bit_cast(bf16x8, sw);
#pragma unroll
                for (int ib = 0; ib < 4; ++ib) { const v2u lo = *(const LAS v2u*)(qb + (ib * 16 + fr) * SC_LD + 32 * ks + 4 * fq), hi = *(const LAS v2u*)(qb + (ib * 16 + fr) * SC_LD + 32 * ks + 16 + 4 * fq);
                    const bf16x8 A = __builtin_bit_cast(bf16x8, ((v4u){lo.x, lo.y, hi.x, hi.y})); o[ib] = __builtin_amdgcn_mfma_f32_16x16x32_bf16(Bs, A, o[ib], 0, 0, 0); } }
#pragma unroll
            for (int ib = 0; ib < 4; ++ib) { const int i = ib * 16 + fr;
                *(v2u*)(outb + (size_t)SC_ROW(c, i) * 512 + h * 128 + 16 * wid + 4 * fq) = (v2u){pk2(o[ib][0], o[ib][1]), pk2(o[ib][2], o[ib][3])}; }
            }
#pragma unroll
            for (int db = 0; db < 4; ++db) {
#pragma unroll
                for (int r = 0; r < 4; ++r) S[db][r] *= dec[db * 16 + 4 * fq + r];
#pragma unroll
                for (int ks = 0; ks < 2; ++ks) { const bf16x8 A = *(const LAS bf16x8*)(kdT + (db * 16 + fr) * SC_LD + 32 * ks + 8 * fq); S[db] = __builtin_amdgcn_mfma_f32_16x16x32_bf16(A, bv[ks], S[db], 0, 0, 0); } }
        }
      }
      if (cb + 1 < c1) { const int c = cb + 1;
        float la[8];
        if (GLA) {
            if (tid < 128) { float z[8]; unpack8(zn, z); LAS float* zp = zs + (tid >> 1) * 16 + 8 * (tid & 1);
                *(LAS f32x4*)zp = (f32x4){z[0], z[1], z[2], z[3]}; *(LAS f32x4*)(zp + 4) = (f32x4){z[4], z[5], z[6], z[7]}; }
            LDS_BARRIER();
#pragma unroll
            for (int e = 0; e < 8; ++e) { const LAS f32x4* zp = (const LAS f32x4*)(zs + (8 * wid + e) * 16); float a = bias;
#pragma unroll
                for (int r4 = 0; r4 < 4; ++r4) { const f32x4 zz = zp[r4]; a += zz.x * w[4 * r4] + zz.y * w[4 * r4 + 1] + zz.z * w[4 * r4 + 2] + zz.w * w[4 * r4 + 3]; }
                la[e] = (fminf(a, 0.f) - __logf(1.0f + __expf(-fabsf(a)))) * 0.0625f; }
        } else {
#pragma unroll
            for (int e = 0; e < 8; ++e) la[e] = lgam;
        }
        float p[8]; p[0] = la[0];
#pragma unroll
        for (int e = 1; e < 8; ++e) p[e] = p[e - 1] + la[e];
        tot[wid * 64 + lane] = p[7];
        LDS_BARRIER();
        float off = 0.f, bref = 0.f, blast = 0.f;
#pragma unroll
        for (int g = 0; g < 8; ++g) { const float tg = tot[g * 64 + lane]; if (g < wid) off += tg; if (g < 4) bref += tg; blast += tg; }
        {
            const float ebref = __expf(bref), eblr = __expf(blast - bref);
            const bool odd = (lane & 1) != 0; const int prow = odd ? 1 : 0, pcol = lane & ~1;
            float kdv[8];
#pragma unroll
            for (int e = 0; e < 8; e += 2) {
                float xq[2], xk[2], xb[2];
#pragma unroll
                for (int u = 0; u < 2; ++u) { const float bb = off + p[e + u], q = bf1(qn[e + u]), k = bf1(kn[e + u]);
                    const float E = __expf(bb - bref), R = __builtin_amdgcn_rcpf(E);
                    xq[u] = q * E; xk[u] = k * R; xb[u] = q * (E * ebref); kdv[e + u] = k * (R * eblr); }
                if (!STATE_ONLY) {
                    const int o32 = (8 * wid + e + prow) * SC_LD + pcol;
                    { const unsigned w2 = pk2(xq[0], xq[1]), rv = (unsigned)__builtin_amdgcn_mov_dpp((int)w2, 0xB1, 0xF, 0xF, false);
                      *(LAS unsigned*)(qin + o32) = odd ? ((rv >> 16) | (w2 & 0xffff0000u)) : ((w2 & 0xffffu) | (rv << 16)); }
                    { const unsigned w2 = pk2(xk[0], xk[1]), rv = (unsigned)__builtin_amdgcn_mov_dpp((int)w2, 0xB1, 0xF, 0xF, false);
                      *(LAS unsigned*)(kin + o32) = odd ? ((rv >> 16) | (w2 & 0xffff0000u)) : ((w2 & 0xffffu) | (rv << 16)); }
                    { const unsigned w2 = pk2(xb[0], xb[1]), rv = (unsigned)__builtin_amdgcn_mov_dpp((int)w2, 0xB1, 0xF, 0xF, false);
                      *(LAS unsigned*)(qb + o32) = odd ? ((rv >> 16) | (w2 & 0xffff0000u)) : ((w2 & 0xffffu) | (rv << 16)); }
                }
            }
            *(LAS v4u*)(kdT + lane * SC_LD + 8 * wid) = (v4u){pk2(kdv[0], kdv[1]), pk2(kdv[2], kdv[3]), pk2(kdv[4], kdv[5]), pk2(kdv[6], kdv[7])};
            if (wid == 0) dec[lane] = ebref * eblr;
            sumlog += blast;
            const unsigned vw[8] = {vn0.x, vn0.y, vn0.z, vn0.w, vn1.x, vn1.y, vn1.z, vn1.w};
#pragma unroll
            for (int e = 0; e < 8; ++e) { const unsigned w2 = vw[e], rv = (unsigned)__builtin_amdgcn_mov_dpp((int)w2, 0xB1, 0xF, 0xF, false);
                *(LAS unsigned*)(vT + (16 * wid + 2 * e + prow) * SC_LD + pcol) = odd ? ((rv >> 16) | (w2 & 0xffff0000u)) : ((w2 & 0xffffu) | (rv << 16)); }
        }
        LDS_BARRIER();
        if (c + 2 < c1) SC_LOAD(c + 2, qr, kr, vr0, vr1, zr);
        if (!STATE_ONLY) {
#pragma unroll
        for (int tt = 0; tt < 2; ++tt) { const int idx = 2 * wid + tt, ti = idx >> 2, tj = idx & 3;
            f32x4 a = (f32x4){0.f, 0.f, 0.f, 0.f};
            if (tj <= ti) {
#pragma unroll
                for (int ks = 0; ks < 2; ++ks) { const bf16x8 A = *(const LAS bf16x8*)(qin + (ti * 16 + fr) * SC_LD + 32 * ks + 8 * fq), B = *(const LAS bf16x8*)(kin + (tj * 16 + fr) * SC_LD + 32 * ks + 8 * fq);
                    a = __builtin_amdgcn_mfma_f32_16x16x32_bf16(B, A, a, 0, 0, 0); } }
            const int i = ti * 16 + fr, j0 = tj * 16 + 4 * fq;
#pragma unroll
            for (int r = 0; r < 4; ++r) a[r] = (j0 + r <= i) ? a[r] : 0.f;
            *(LAS v2u*)(sm + i * SC_LD + j0) = (v2u){pk2(a[0], a[1]), pk2(a[2], a[3])}; }
        LDS_BARRIER();
        }
        {
            bf16x8 bv[2];
#pragma unroll
            for (int ks = 0; ks < 2; ++ks) bv[ks] = *(const LAS bf16x8*)(vT + (16 * wid + fr) * SC_LD + 32 * ks + 8 * fq);
            if (!STATE_ONLY) {
            f32x4 o[4];
#pragma unroll
            for (int ib = 0; ib < 4; ++ib) { o[ib] = (f32x4){0.f, 0.f, 0.f, 0.f};
#pragma unroll
                for (int ks = 0; ks < 2; ++ks) { const bf16x8 A = *(const LAS bf16x8*)(sm + (ib * 16 + fr) * SC_LD + 32 * ks + 8 * fq); o[ib] = __builtin_amdgcn_mfma_f32_16x16x32_bf16(bv[ks], A, o[ib], 0, 0, 0); } }
#pragma unroll
            for (int ks = 0; ks < 2; ++ks) {
                v4u sw; sw.x = pk2(S[2 * ks][0], S[2 * ks][1]); sw.y = pk2(S[2 * ks][2], S[2 * ks][3]); sw.z = pk2(S[2 * ks + 1][0], S[2 * ks + 1][1]); sw.w = pk2(S[2 * ks + 1][2], S[2 * ks + 1][3]);
                const bf16x8 Bs = __builtin_bit_cast(bf16x8, sw);
#pragma unroll
                for (int ib = 0; ib < 4; ++ib) { const v2u lo = *(const LAS v2u*)(qb + (ib * 16 + fr) * SC_LD + 32 * ks + 4 * fq), hi = *(const LAS v2u*)(qb + (ib * 16 + fr) * SC_LD + 32 * ks + 16 + 4 * fq);
                    const bf16x8 A = __builtin_bit_cast(bf16x8, ((v4u){lo.x, lo.y, hi.x, hi.y})); o[ib] = __builtin_amdgcn_mfma_f32_16x16x32_bf16(Bs, A, o[ib], 0, 0, 0); } }
#pragma unroll
            for (int ib = 0; ib < 4; ++ib) { const int i = ib * 16 + fr;
                *(v2u*)(outb + (size_t)SC_ROW(c, i) * 512 + h * 128 + 16 * wid + 4 * fq) = (v2u){pk2(o[ib][0], o[ib][1]), pk2(o[ib][2], o[ib][3])}; }
            }
#pragma unroll
            for (int db = 0; db < 4; ++db) {
#pragma unroll
                for (int r = 0; r < 4; ++r) S[db][r] *= dec[db * 16 + 4 * fq + r];
#pragma unroll
                for (int ks = 0; ks < 2; ++ks) { const bf16x8 A = *(const LAS bf16x8*)(kdT + (db * 16 + fr) * SC_LD + 32 * ks + 8 * fq); S[db] = __builtin_amdgcn_mfma_f32_16x16x32_bf16(A, bv[ks], S[db], 0, 0, 0); } }
        }
      }
      if (cb + 2 < c1) { const int c = cb + 2;
        float la[8];
        if (GLA) {
            if (tid < 128) { float z[8]; unpack8(zm, z); LAS float* zp = zs + (tid >> 1) * 16 + 8 * (tid & 1);
                *(LAS f32x4*)zp = (f32x4){z[0], z[1], z[2], z[3]}; *(LAS f32x4*)(zp + 4) = (f32x4){z[4], z[5], z[6], z[7]}; }
            LDS_BARRIER();
#pragma unroll
            for (int e = 0; e < 8; ++e) { const LAS f32x4* zp = (const LAS f32x4*)(zs + (8 * wid + e) * 16); float a = bias;
#pragma unroll
                for (int r4 = 0; r4 < 4; ++r4) { const f32x4 zz = zp[r4]; a += zz.x * w[4 * r4] + zz.y * w[4 * r4 + 1] + zz.z * w[4 * r4 + 2] + zz.w * w[4 * r4 + 3]; }
                la[e] = (fminf(a, 0.f) - __logf(1.0f + __expf(-fabsf(a)))) * 0.0625f; }
        } else {
#pragma unroll
            for (int e = 0; e < 8; ++e) la[e] = lgam;
        }
        float p[8]; p[0] = la[0];
#pragma unroll
        for (int e = 1; e < 8; ++e) p[e] = p[e - 1] + la[e];
        tot[wid * 64 + lane] = p[7];
        LDS_BARRIER();
        float off = 0.f, bref = 0.f, blast = 0.f;
#pragma unroll
        for (int g = 0; g < 8; ++g) { const float tg = tot[g * 64 + lane]; if (g < wid) off += tg; if (g < 4) bref += tg; blast += tg; }
        {
            const float ebref = __expf(bref), eblr = __expf(blast - bref);
            const bool odd = (lane & 1) != 0; const int prow = odd ? 1 : 0, pcol = lane & ~1;
            float kdv[8];
#pragma unroll
            for (int e = 0; e < 8; e += 2) {
                float xq[2], xk[2], xb[2];
#pragma unroll
                for (int u = 0; u < 2; ++u) { const float bb = off + p[e + u], q = bf1(qm[e + u]), k = bf1(km[e + u]);
                    const float E = __expf(bb - bref), R = __builtin_amdgcn_rcpf(E);
                    xq[u] = q * E; xk[u] = k * R; xb[u] = q * (E * ebref); kdv[e + u] = k * (R * eblr); }
                if (!STATE_ONLY) {
                    const int o32 = (8 * wid + e + prow) * SC_LD + pcol;
                    { const unsigned w2 = pk2(xq[0], xq[1]), rv = (unsigned)__builtin_amdgcn_mov_dpp((int)w2, 0xB1, 0xF, 0xF, false);
                      *(LAS unsigned*)(qin + o32) = odd ? ((rv >> 16) | (w2 & 0xffff0000u)) : ((w2 & 0xffffu) | (rv << 16)); }
                    { const unsigned w2 = pk2(xk[0], xk[1]), rv = (unsigned)__builtin_amdgcn_mov_dpp((int)w2, 0xB1, 0xF, 0xF, false);
                      *(LAS unsigned*)(kin + o32) = odd ? ((rv >> 16) | (w2 & 0xffff0000u)) : ((w2 & 0xffffu) | (rv << 16)); }
                    { const unsigned w2 = pk2(xb[0], xb[1]), rv = (unsigned)__builtin_amdgcn_mov_dpp((int)w2, 0xB1, 0xF, 0xF, false);
                      *(LAS unsigned*)(qb + o32) = odd ? ((rv >> 16) | (w2 & 0xffff0000u)) : ((w2 & 0xffffu) | (rv << 16)); }
                }
            }
            *(LAS v4u*)(kdT + lane * SC_LD + 8 * wid) = (v4u){pk2(kdv[0], kdv[1]), pk2(kdv[2], kdv[3]), pk2(kdv[4], kdv[5]), pk2(kdv[6], kdv[7])};
            if (wid == 0) dec[lane] = ebref * eblr;
            sumlog += blast;
            const unsigned vw[8] = {vm0.x, vm0.y, vm0.z, vm0.w, vm1.x, vm1.y, vm1.z, vm1.w};
#pragma unroll
            for (int e = 0; e < 8; ++e) { const unsigned w2 = vw[e], rv = (unsigned)__builtin_amdgcn_mov_dpp((int)w2, 0xB1, 0xF, 0xF, false);
                *(LAS unsigned*)(vT + (16 * wid + 2 * e + prow) * SC_LD + pcol) = odd ? ((rv >> 16) | (w2 & 0xffff0000u)) : ((w2 & 0xffffu) | (rv << 16)); }
        }
        LDS_BARRIER();
        if (c + 2 < c1) SC_LOAD(c + 2, qn, kn, vn0, vn1, zn);
        if (!STATE_ONLY) {
#pragma unroll
        for (int tt = 0; tt < 2; ++tt) { const int idx = 2 * wid + tt, ti = idx >> 2, tj = idx & 3;
            f32x4 a = (f32x4){0.f, 0.f, 0.f, 0.f};
            if (tj <= ti) {
#pragma unroll
                for (int ks = 0; ks < 2; ++ks) { const bf16x8 A = *(const LAS bf16x8*)(qin + (ti * 16 + fr) * SC_LD + 32 * ks + 8 * fq), B = *(const LAS bf16x8*)(kin + (tj * 16 + fr) * SC_LD + 32 * ks + 8 * fq);
                    a = __builtin_amdgcn_mfma_f32_16x16x32_bf16(B, A, a, 0, 0, 0); } }
            const int i = ti * 16 + fr, j0 = tj * 16 + 4 * fq;
#pragma unroll
            for (int r = 0; r < 4; ++r) a[r] = (j0 + r <= i) ? a[r] : 0.f;
            *(LAS v2u*)(sm + i * SC_LD + j0) = (v2u){pk2(a[0], a[1]), pk2(a[2], a[3])}; }
        LDS_BARRIER();
        }
        {
            bf16x8 bv[2];
#pragma unroll
            for (int ks = 0; ks < 2; ++ks) bv[ks] = *(const LAS bf16x8*)(vT + (16 * wid + fr) * SC_LD + 32 * ks + 8 * fq);
            if (!STATE_ONLY) {
            f32x4 o[4];
#pragma unroll
            for (int ib = 0; ib < 4; ++ib) { o[ib] = (f32x4){0.f, 0.f, 0.f, 0.f};
#pragma unroll
                for (int ks = 0; ks < 2; ++ks) { const bf16x8 A = *(const LAS bf16x8*)(sm + (ib * 16 + fr) * SC_LD + 32 * ks + 8 * fq); o[ib] = __builtin_amdgcn_mfma_f32_16x16x32_bf16(bv[ks], A, o[ib], 0, 0, 0); } }
#pragma unroll
            for (int ks = 0; ks < 2; ++ks) {
                v4u sw; sw.x = pk2(S[2 * ks][0], S[2 * ks][1]); sw.y = pk2(S[2 * ks][2], S[2 * ks][3]); sw.z = pk2(S[2 * ks + 1][0], S[2 * ks + 1][1]); sw.w = pk2(S[2 * ks + 1][2], S[2 * ks + 1][3]);
                const bf16x8 Bs = __builtin_bit_cast(bf16x8, sw);
#pragma unroll
                for (int ib = 0; ib < 4; ++ib) { const v2u lo = *(const LAS v2u*)(qb + (ib * 16 + fr) * SC_LD + 32 * ks + 4 * fq), hi = *(const LAS v2u*)(qb + (ib * 16 + fr) * SC_LD + 32 * ks + 16 + 4 * fq);
                    const bf16x8 A = __builtin_bit_cast(bf16x8, ((v4u){lo.x, lo.y, hi.x, hi.y})); o[ib] = __builtin_amdgcn_mfma_f32_16x16x32_bf16(Bs, A, o[ib], 0, 0, 0); } }
#pragma unroll
            for (int ib = 0; ib < 4; ++ib) { const int i = ib * 16 + fr;
                *(v2u*)(outb + (size_t)SC_ROW(c, i) * 512 + h * 128 + 16 * wid + 4 * fq) = (v2u){pk2(o[ib][0], o[ib][1]), pk2(o[ib][2], o[ib][3])}; }
            }
#pragma unroll
            for (int db = 0; db < 4; ++db) {
#pragma unroll
                for (int r = 0; r < 4; ++r) S[db][r] *= dec[db * 16 + 4 * fq + r];
#pragma unroll
                for (int ks = 0; ks < 2; ++ks) { const bf16x8 A = *(const LAS bf16x8*)(kdT + (db * 16 + fr) * SC_LD + 32 * ks + 8 * fq); S[db] = __builtin_amdgcn_mfma_f32_16x16x32_bf16(A, bv[ks], S[db], 0, 0, 0); } }
        }
      }
    }
    if (STATE_ONLY) {
#pragma unroll
        for (int db = 0; db < 4; ++db)
#pragma unroll
            for (int r = 0; r < 4; ++r) Fout[(db * 16 + 4 * fq + r) * 128 + 16 * wid + fr] = S[db][r];
        if (wid == 0) Dout[lane] = __expf(sumlog);
    }
    LDS_BARRIER();
#undef SC_ROW
#undef SC_LOAD
}

#define XB_TMO      128
#define XB_XCNT(j)  (256  + 64 * (j))
#define XB_XSUB(j)  (1280 + 64 * (j))
#define XB_XGEN(j)  (2304 + 64 * (j))
#define XB_TOP      3328
#define XB_TOPGEN   3392
#define XCD_BAR_WORDS 3456
#define XB_SPIN_CAP (1u << 18)

__device__ __forceinline__ unsigned xb_ld(unsigned* p)              { return __hip_atomic_load(p, __ATOMIC_RELAXED, __HIP_MEMORY_SCOPE_AGENT); }
__device__ __forceinline__ unsigned xb_add(unsigned* p, unsigned v) { return __hip_atomic_fetch_add(p, v, __ATOMIC_RELAXED, __HIP_MEMORY_SCOPE_AGENT); }
__device__ __forceinline__ unsigned xb_xcc_id() { return (unsigned)__builtin_amdgcn_s_getreg((3 << 11) | 20) & 0xFu; }
#define XB_SPIN(cond, bar) do { unsigned _sp = 0; while (cond) { __builtin_amdgcn_s_sleep(1); \
    if ((++_sp & 255u) == 0u) { if (xb_ld(&(bar)[XB_TMO])) break; if (_sp > XB_SPIN_CAP) { atomicAdd(&(bar)[XB_TMO], 1u); break; } } } } while (0)

struct XcdBarrier {
    unsigned* bar; unsigned x;
    volatile LAS unsigned* st;
};

__device__ __forceinline__ XcdBarrier xcd_barrier_post(unsigned* bar, volatile LAS unsigned* st) {
    XcdBarrier b; b.bar = bar; b.x = xb_xcc_id(); b.st = st;
    if (threadIdx.x == 0) (void)xb_add(&bar[XB_XCNT(b.x)], 1u);
    return b;
}
__device__ __forceinline__ void xcd_barrier_complete(unsigned* bar, unsigned x, unsigned& nloc, unsigned& nx) {
    const unsigned G = gridDim.x * gridDim.y * gridDim.z;
    unsigned sum, cnt, mine, sp = 0u;
    for (;;) {
        sum = 0u; cnt = 0u; mine = 0u;
#pragma unroll
        for (unsigned j = 0; j < 16; ++j) { const unsigned c = xb_ld(&bar[XB_XCNT(j)]); sum += c; cnt += (c > 0u) ? 1u : 0u; mine = (j == x) ? c : mine; }
        if (sum == G) break;
        __builtin_amdgcn_s_sleep(1);
        if ((++sp & 255u) == 0u) { if (xb_ld(&bar[XB_TMO])) break; if (sp > XB_SPIN_CAP) { atomicAdd(&bar[XB_TMO], 1u); break; } }
    }
    nloc = mine > 0u ? mine : 1u; nx = cnt > 0u ? cnt : 1u;
}

__device__ __forceinline__ void xcd_barrier(const XcdBarrier& b) {
    asm volatile("s_waitcnt vmcnt(0)" ::: "memory");
    __syncthreads();
    if (threadIdx.x == 0) {
        unsigned* bar = b.bar;
        __builtin_amdgcn_s_waitcnt(0);
        unsigned nloc = b.st[0], nx = b.st[1];
        if (nloc == 0u) { xcd_barrier_complete(bar, b.x, nloc, nx); b.st[0] = nloc; b.st[1] = nx; }
        const unsigned old = xb_add(&bar[XB_XSUB(b.x)], 1u);
        const unsigned gen = old / nloc;
        if (old + 1u == (gen + 1u) * nloc) {
            __builtin_amdgcn_fence(__ATOMIC_RELEASE, "agent");
            asm volatile("s_waitcnt vmcnt(0)" ::: "memory");
            const unsigned og = xb_add(&bar[XB_TOP], 1u);
            const unsigned tg = og / nx;
            if (og + 1u == (tg + 1u) * nx) xb_add(&bar[XB_TOPGEN], 1u);
            else XB_SPIN(xb_ld(&bar[XB_TOPGEN]) == tg, bar);
            __builtin_amdgcn_fence(__ATOMIC_ACQUIRE, "agent");
            xb_add(&bar[XB_XGEN(b.x)], 1u);
            asm volatile("s_waitcnt vmcnt(0)" ::: "memory");
        } else {
            XB_SPIN(xb_ld(&bar[XB_XGEN(b.x)]) == gen, bar);
            __builtin_amdgcn_fence(__ATOMIC_ACQUIRE, "agent");
            asm volatile("s_waitcnt vmcnt(0)" ::: "memory");
        }
    }
    __syncthreads();
}

struct Args { const float* in[16]; float* out; unsigned char* ws; };
__global__ void __launch_bounds__(NWAVES * 64, 2) hybrid_fwd(Args args) {
    extern __shared__ __attribute__((aligned(16))) unsigned char lds[];
    cg::grid_group grid = cg::this_grid();
    LAS unsigned char* L = (LAS unsigned char*)lds;
    volatile LAS unsigned* MISC = (volatile LAS unsigned*)(L + MISC_OFF);
    const int tid = threadIdx.x, lane = tid & 63, wave = __builtin_amdgcn_readfirstlane(tid >> 6);
    const int G = gridDim.x, bx = blockIdx.x;
    const int vcu = (G % 8 == 0) ? (bx % 8) * (G / 8) + bx / 8 : bx;
    const int gw = vcu * NWAVES + wave, NGW = G * NWAVES;
    unsigned char* ws = args.ws;
    unsigned* ctl = (unsigned*)(ws + WS_CTL);
    bf16* XN = (bf16*)(ws + WS_XN); bf16* PROJ = (bf16*)(ws + WS_PROJ); bf16* MERGED = (bf16*)(ws + WS_MERGED); bf16* OBUF = (bf16*)(ws + WS_OBUF);
    float* ACCF = (float*)(ws + WS_OBUF);
    float* SCF = (float*)(ws + WS_SCF); float* SCD = (float*)(ws + WS_SCD);
    float* out = args.out;
    for (int u = tid; u < (LDS_BYTES - RING_BYTES) / 4; u += NWAVES * 64) ((LAS unsigned*)(L + RING_BYTES))[u] = 0u;
    __syncthreads();
    XcdBarrier bar = xcd_barrier_post(ctl + CW_BAR, MISC + 8);

    {
        LAS float* scr = (LAS float*)(L + wave * 16384);
        for (int l = 0; l < DEPTH; ++l) {
            unsigned char* wl = ws + WS_W + (size_t)l * LW;
            const float* src[8] = {args.in[4] + (size_t)l * DM * INW, args.in[11] + (size_t)l * DM * 3 * DM, args.in[10] + (size_t)(l * 3 + 0) * 512 * DM, args.in[10] + (size_t)(l * 3 + 1) * 512 * DM,
                                   args.in[10] + (size_t)(l * 3 + 2) * 512 * DM, args.in[12] + (size_t)l * DM * DM, args.in[13] + (size_t)l * DM * FF, args.in[14] + (size_t)l * FF * DM};
            const int Ks[8] = {DM, DM, 512, 512, 512, DM, DM, FF}, Ns[8] = {INW, 3 * DM, DM, DM, DM, DM, FF, DM}, roff[8] = {0, 0, 0, DM, 2 * DM, 0, 0, 0};
            const size_t doff[8] = {OW_IN, OW_MERGE, OW_BR, OW_BR, OW_BR, OW_OUT, OW_UP, OW_DOWN};
#pragma unroll
            for (int mi = 0; mi < 8; ++mi) {
                const int nit = (Ks[mi] / 64) * (Ns[mi] / 32);
                for (int it = gw; it < nit; it += NGW) p0_transpose_item(src[mi], Ks[mi], Ns[mi], (bf16*)(wl + doff[mi]), roff[mi], scr, it, lane);
            }
            v4u* z = (v4u*)(wl + OW_IN + (size_t)INW * DM * 2);
            for (int i = gw * 64 + lane; i < (PW - INW) * DM * 2 / 16; i += NGW * 64) z[i] = (v4u){0u, 0u, 0u, 0u};
        }
    }
    grid.sync();

    for (int l = 0; l < DEPTH; ++l) {
        unsigned char* wl = ws + WS_W + (size_t)l * LW;
        const bf16* Win_t = (const bf16*)(wl + OW_IN); const bf16* Wmerge_t = (const bf16*)(wl + OW_MERGE); const bf16* Wbr_t = (const bf16*)(wl + OW_BR);
        const bf16* Wout_t = (const bf16*)(wl + OW_OUT); const bf16* Wup_t = (const bf16*)(wl + OW_UP); const bf16* Wdown_t = (const bf16*)(wl + OW_DOWN);
        for (int hf = 0; hf < 2; ++hf) {
            float* op = out + (size_t)hf * MP * DM; float* os = out + (size_t)(2 * MP + hf * SS) * DM;
            const float* xp = l == 0 ? args.in[0] + (size_t)hf * MP * DM : op; const float* xs = l == 0 ? args.in[1] + (size_t)hf * SS * DM : os;
            norm_rows(xp, xs, args.in[2] + l * DM, XN, gw, NGW, lane);
            xcd_barrier(bar);
            { pg8::Gemm g{XN, Win_t, MH, PW, DM, 1 << 30, 0}; pg8::StaticOrder S; S.init(MH, PW, G, bx);
              pg8::EpiBf16<0> E{PROJ, PW, 0, 0};
              pg8::gemm_phase<pg8::EpiBf16<0>, pg8::StaticOrder, true, true>(L, g, S, E); }
            xcd_barrier(bar);
            e1_rows(PROJ, args.in[5] + l * 64, args.in[6] + l * 64, gw, NGW, lane);
            xcd_barrier(bar);
            for (int pass = 0; pass < 2; ++pass) {
                unsigned* qctr = ctl + 64 * (1 + (l * 2 + hf) * 2 + pass);
                const int NU = pass == 0 ? 560 : 832;
                for (;;) {
                    if (tid == 0) MISC[0] = atomicAdd(qctr, 1u);
                    __syncthreads();
                    const int u = (int)MISC[0];
                    __syncthreads();
                    if (u >= NU) break;
                    int kind, r = 0, seg = 0, row0 = 0, len = 0, slot0 = 0, au = 0;
                    if (pass == 0) {
                        if (u < 256) { kind = 1; au = u; }
                        else if (u < 368) { kind = 0; r = (u - 256) / 7; seg = (u - 256) % 7; row0 = MP; len = SS; slot0 = r * 8; }
                        else if (u < 496) { kind = 0; const int s2 = u - 368; r = s2 & 15; seg = 0; row0 = (s2 >> 4) * SP; len = SP; slot0 = 128 + s2 * 2; }
                        else { kind = 1; au = 256 + (u - 496); }
                    } else {
                        if (u < 128) { kind = 0; r = u >> 3; seg = u & 7; row0 = MP; len = SS; slot0 = r * 8; }
                        else if (u < 384) { kind = 0; const int s2 = (u - 128) >> 1; r = s2 & 15; seg = (u - 128) & 1; row0 = (s2 >> 4) * SP; len = SP; slot0 = 128 + s2 * 2; }
                        else { kind = 1; au = 320 + (u - 384); }
                    }
#ifndef PROBE_SCAN_REPS
#define PROBE_SCAN_REPS 1
#endif
#ifndef PROBE_ATT_REPS
#define PROBE_ATT_REPS 1
#endif
                    if (kind == 0) {
                      for (int rep_ = 0; rep_ < PROBE_SCAN_REPS; ++rep_) {
                        const int mixer = r >> 3, h = (r >> 1) & 3, dir = r & 1;
                        float* Fs = SCF + (size_t)slot0 * 8192; float* Ds = SCD + (size_t)slot0 * 64;
                        const int c0 = seg * 16, c1 = c0 + 16;
                        if (mixer == 0) {
                            const float* wgp = args.in[7] + (size_t)(l * 2 + dir) * 16 * 256; const float* bgp = args.in[8] + (size_t)(l * 2 + dir) * 256; bf16* ob = OBUF + (size_t)(1 + 2 * dir) * OB1;
                            if (pass == 0) scan_unit<true, true>(L, PROJ, ob, row0, len, h, dir, wgp, bgp, 0.f, c0, c1, Fs, Ds, 0, Fs + (size_t)seg * 8192, Ds + seg * 64);
                            else scan_unit<true, false>(L, PROJ, ob, row0, len, h, dir, wgp, bgp, 0.f, c0, c1, Fs, Ds, seg, nullptr, nullptr);
                        } else {
                            const int hh = dir == 0 ? h : 3 - h; const float lg = __logf(1.0f - __builtin_amdgcn_exp2f(-5.0f - (float)hh)); bf16* ob = OBUF + (size_t)(2 + 2 * dir) * OB1;
                            if (pass == 0) scan_unit<false, true>(L, PROJ, ob, row0, len, h, dir, nullptr, nullptr, lg, c0, c1, Fs, Ds, 0, Fs + (size_t)seg * 8192, Ds + seg * 64);
                            else scan_unit<false, false>(L, PROJ, ob, row0, len, h, dir, nullptr, nullptr, lg, c0, c1, Fs, Ds, seg, nullptr, nullptr);
                        }
                      }
                    } else {
                        int nt, hk, qb, hq;
                        if (au < 256) { row0 = MP; nt = SS / 64; hk = au >> 7; qb = (au >> 2) & 31; hq = au & 3; }
                        else { const int a2 = au - 256, rr = a2 & 63; row0 = (a2 >> 6) * SP; nt = SP / 64; hk = rr >> 5; qb = (rr >> 2) & 7; hq = rr & 3; }
                        const int h = hk * 4 + hq;
                        const attn_body::bf16* P = (const attn_body::bf16*)PROJ;
                        for (int rep_ = 0; rep_ < PROBE_ATT_REPS; ++rep_)
                        attn_body::attn_unit<8>(P + (size_t)(row0 + qb * 256) * PW + C_AQ + h * 64, P + (size_t)row0 * PW + C_AK + hk * 64, P + (size_t)row0 * PW + C_AV + hk * 64,
                                                (attn_body::bf16*)OBUF + (size_t)(row0 + qb * 256) * 512 + h * 64, nt, (char*)lds);
                    }
                }
                xcd_barrier(bar);
            }
            e2_rows(PROJ, OBUF, args.in[9] + l * 128, gw, NGW, lane);
            xcd_barrier(bar);
            { pg8::Gemm g{OBUF, Wbr_t, MH, 3 * DM, 512, 4, OB1 * 2}; pg8::StaticOrder S; S.init(MH, 3 * DM, G, bx);
              pg8::EpiBf16<0> E{PROJ, DM, DM, (size_t)MH * DM};
              pg8::gemm_phase<pg8::EpiBf16<0>, pg8::StaticOrder, true, true>(L, g, S, E); }
            xcd_barrier(bar);
            { pg8::Gemm g{XN, Wmerge_t, MH, 3 * DM, DM, 1 << 30, 0}; pg8::MergeOrder S; S.init(MH, G, bx);
              pg8::EpiMerge E{PROJ, (size_t)MH * DM, ACCF, MERGED};
              pg8::gemm_phase<pg8::EpiMerge, pg8::MergeOrder, true, true>(L, g, S, E); }
            xcd_barrier(bar);
            { pg8::Gemm g{MERGED, Wout_t, MH, DM, DM, 1 << 30, 0}; pg8::StaticOrder S; S.init(MH, DM, G, bx);
              pg8::EpiRes E{xp, xs, op, os, DM / 64};
              pg8::gemm_phase<pg8::EpiRes, pg8::StaticOrder, true, true>(L, g, S, E); }
            xcd_barrier(bar);
            norm_rows(op, os, args.in[3] + l * DM, XN, gw, NGW, lane);
            xcd_barrier(bar);
            { pg8::Gemm g{XN, Wup_t, MH, FF, DM, 1 << 30, 0}; pg8::StaticOrder S; S.init(MH, FF, G, bx);
              pg8::EpiBf16<2> E{PROJ, FF, 0, 0};
              pg8::gemm_phase<pg8::EpiBf16<2>, pg8::StaticOrder, true, true>(L, g, S, E); }
            xcd_barrier(bar);
            { pg8::Gemm g{PROJ, Wdown_t, MH, DM, FF, 1 << 30, 0}; pg8::EpiRes E{op, os, op, os, FF / 64};
              pg8::StaticOrder S; S.init(MH, DM, G, bx); pg8::gemm_phase<pg8::EpiRes, pg8::StaticOrder, true, true>(L, g, S, E); }
            xcd_barrier(bar);
        }
    }
    final_norm(out, args.in[15], gw, NGW, lane);
}

extern "C" void kernel_launch(void* const* d_in, const int* in_sizes, int n_in, void* d_out, int out_size, void* d_ws, size_t ws_size, hipStream_t stream) {
    static int grid = 0;
    if (grid == 0) {
        if (n_in != 16 || out_size != 2 * MH * DM || ws_size < WS_END) { fprintf(stderr, "kernel_launch: unexpected shapes (n_in %d, out %d, ws %zu)\n", n_in, out_size, ws_size); grid = -1; return; }
        int dev = 0, cus = 0, per_cu = 0;
        if (hipGetDevice(&dev) != hipSuccess || hipDeviceGetAttribute(&cus, hipDeviceAttributeMultiprocessorCount, dev) != hipSuccess) { grid = -1; return; }
        if (hipFuncSetAttribute((const void*)hybrid_fwd, hipFuncAttributeMaxDynamicSharedMemorySize, LDS_BYTES) != hipSuccess) { fprintf(stderr, "kernel_launch: hipFuncSetAttribute failed\n"); grid = -1; return; }
        if (hipOccupancyMaxActiveBlocksPerMultiprocessor(&per_cu, (const void*)hybrid_fwd, NWAVES * 64, LDS_BYTES) != hipSuccess || per_cu < 1) { fprintf(stderr, "kernel_launch: occupancy query says %d\n", per_cu); per_cu = 1; }
        (void)hipGetLastError();
        grid = cus;
    }
    if (grid < 0) return;
    if (hipMemsetAsync((char*)d_ws + WS_CTL, 0, CTL_ZERO_BYTES, stream) != hipSuccess) { fprintf(stderr, "kernel_launch: memset failed\n"); return; }
    Args a{};
    for (int i = 0; i < 16; ++i) a.in[i] = (const float*)d_in[i];
    a.out = (float*)d_out; a.ws = (unsigned char*)d_ws;
    void* kargs[] = {&a};
    const hipError_t le = hipLaunchCooperativeKernel((const void*)hybrid_fwd, dim3(grid), dim3(NWAVES * 64), kargs, LDS_BYTES, stream);
    if (le != hipSuccess) fprintf(stderr, "kernel_launch: cooperative launch failed: %s (grid %d)\n", hipGetErrorName(le), grid);
}
```

```cpp
#include <hip/hip_runtime.h>
#include <hip/hip_cooperative_groups.h>
#include <cstdio>
#include <cstdint>
namespace cg = cooperative_groups;
namespace pg8 {
#define PG8_LAS __attribute__((address_space(3)))
typedef unsigned short bf16_t;
typedef short bf16x8 __attribute__((ext_vector_type(8)));
typedef float f32x4 __attribute__((ext_vector_type(4)));
typedef unsigned u32x4 __attribute__((ext_vector_type(4)));
constexpr int BM = 256, BK = 64, HALF = 128, HTB = HALF * BK * 2  , STAGE_BYTES = 8 * HTB, NXCD = 8, WGM = 8;

__host__ __device__ __forceinline__ int lds_byte(int r, int c) { const int st = (r >> 4) * 2 + (c >> 5), rr = r & 15, cc = c & 31, ob = rr * 64 + cc * 2; return st * 1024 + (ob ^ (((ob >> 9) & 1) << 5)); }
__host__ __device__ __forceinline__ void stage_rc(int b, int& R, int& C) { const int st = b / 1024, sb = b % 1024, swz = sb ^ (((sb >> 9) & 1) << 5); R = (st >> 1) * 16 + swz / 64; C = (st & 1) * 32 + (swz % 64) / 2; }
__host__ __device__ __forceinline__ int perm32(int rho) { const int n = rho >> 4, i = rho & 15; return 8 * (i >> 2) + 4 * n + (i & 3); }

struct Unit { int pm, pn, k0, nt; };
struct Gemm { const bf16_t* A; const bf16_t* Bt; int M, N, K; int a_grp; size_t a_grp_bytes; };

struct StaticOrder {
    int nM, nN, nwg, G, c;
    __host__ __device__ void init(int M, int N, int G_, int c_) { nM = M / BM; nN = N / BM; nwg = nM * nN; G = G_; c = c_; }
    __host__ __device__ bool next(int i, Unit& u) const {
        const long L = (long)i * G + c; if (L >= nwg) return false;
        int wgid = (int)L; { const int q = nwg / NXCD, r = nwg % NXCD, xcd = wgid % NXCD, off = wgid / NXCD; wgid = (xcd < r ? xcd * (q + 1) : r * (q + 1) + (xcd - r) * q) + off; }
        const int nig = WGM * nN, gid = wgid / nig, fm = gid * WGM, gsz = (nM - fm) < WGM ? (nM - fm) : WGM;
        u.pm = fm + ((wgid % nig) % gsz); u.pn = (wgid % nig) / gsz; u.k0 = 0; u.nt = 0; return true;
    }
    __device__ __forceinline__ void a_ready(const Unit&) const {}
    __device__ __forceinline__ void done(const Unit&) const {}
};

__device__ __forceinline__ unsigned cvt_pk_bf16(float lo, float hi) { unsigned r; asm volatile("v_cvt_pk_bf16_f32 %0, %1, %2" : "=v"(r) : "v"(lo), "v"(hi)); return r; }
typedef float f32x2 __attribute__((ext_vector_type(2)));
__device__ __forceinline__ float bflo(unsigned w) { return __builtin_bit_cast(float, w << 16); }
__device__ __forceinline__ float bfhi(unsigned w) { return __builtin_bit_cast(float, w & 0xffff0000u); }
template <int ACT> struct EpiBf16 {
    static constexpr bool PERM = true, AFTER_DRAIN = false;
    bf16_t* O; int ldc; int split_cols; size_t split_stride;
    __device__ __forceinline__ void operator()(const f32x4 (&acc)[2][2][4][2], const Unit& u, int wr, int wc, int fr, int fq) const {
        const int row0 = u.pm * BM + wr * 64 + fr; int colt = u.pn * BM; bf16_t* base = O;
        if (split_cols) { const int t = colt / split_cols; base += (size_t)t * split_stride; colt -= t * split_cols; }
        const int col0 = colt + wc * 32 + 8 * fq;
#pragma unroll
        for (int ai = 0; ai < 2; ++ai)
#pragma unroll
            for (int m = 0; m < 4; ++m) { bf16_t* rowp = base + (size_t)(row0 + ai * HALF + m * 16) * ldc + col0;
#pragma unroll
                for (int bj = 0; bj < 2; ++bj) { f32x4 v0 = acc[ai][bj][m][0], v1 = acc[ai][bj][m][1];
                    if (ACT == 2) {
#pragma unroll
                        for (int j = 0; j < 4; ++j) { const float a = fmaxf(v0[j], 0.f), b = fmaxf(v1[j], 0.f); v0[j] = a * a; v1[j] = b * b; } }
                    u32x4 w; w.x = cvt_pk_bf16(v0[0], v0[1]); w.y = cvt_pk_bf16(v0[2], v0[3]); w.z = cvt_pk_bf16(v1[0], v1[1]); w.w = cvt_pk_bf16(v1[2], v1[3]);
                    *(u32x4*)(rowp + bj * HALF) = w; } }
    }
};
struct EpiMerge {
    static constexpr bool PERM = true, AFTER_DRAIN = false;
    const bf16_t* Y; size_t ystride; float* accf; bf16_t* merged;
    __device__ __forceinline__ void operator()(const f32x4 (&acc)[2][2][4][2], const Unit& u, int wr, int wc, int fr, int fq) const {
        const int b = u.pn >> 2, ct = u.pn & 3;
        const int row0 = u.pm * BM + wr * 64 + fr, col0 = ct * BM + wc * 32 + 8 * fq;
        const bf16_t* Yb = Y + (size_t)b * ystride;
#pragma unroll
        for (int ai = 0; ai < 2; ++ai)
#pragma unroll
            for (int m = 0; m < 4; ++m) {
#pragma unroll
                for (int bj = 0; bj < 2; ++bj) { const size_t o = (size_t)(row0 + ai * HALF + m * 16) * 1024 + col0 + bj * HALF;
                    const u32x4 yv = *(const u32x4*)(Yb + o);
                    float y[8] = {bflo(yv.x), bfhi(yv.x), bflo(yv.y), bfhi(yv.y), bflo(yv.z), bfhi(yv.z), bflo(yv.w), bfhi(yv.w)};
                    float p[8];
#pragma unroll
                    for (int j = 0; j < 8; ++j) { const float a = j < 4 ? acc[ai][bj][m][0][j & 3] : acc[ai][bj][m][1][j & 3];
                        const float g = __builtin_amdgcn_rcpf(1.0f + __builtin_amdgcn_exp2f(-1.4426950408889634f * a)); p[j] = g * y[j]; }
                    if (b > 0) { const f32x4 c0 = *(const f32x4*)(accf + o), c1 = *(const f32x4*)(accf + o + 4);
#pragma unroll
                        for (int j = 0; j < 4; ++j) { p[j] += c0[j]; p[4 + j] += c1[j]; } }
                    if (b < 2) { *(f32x4*)(accf + o) = (f32x4){p[0], p[1], p[2], p[3]}; *(f32x4*)(accf + o + 4) = (f32x4){p[4], p[5], p[6], p[7]}; }
                    else { u32x4 w; w.x = cvt_pk_bf16(p[0], p[1]); w.y = cvt_pk_bf16(p[2], p[3]); w.z = cvt_pk_bf16(p[4], p[5]); w.w = cvt_pk_bf16(p[6], p[7]); *(u32x4*)(merged + o) = w; } } }
    }
};
struct EpiRes {
    static constexpr bool PERM = false, AFTER_DRAIN = false;
    const float* base_p; const float* base_s; float* out_p; float* out_s; int full_nt;
    __device__ __forceinline__ void operator()(const f32x4 (&acc)[2][2][4][2], const Unit& u, int wr, int wc, int fr, int fq) const {
        const bool smp = u.pm >= 64; const float* bs = smp ? base_s : base_p; float* ot = smp ? out_s : out_p;
        const int r0 = (smp ? u.pm - 64 : u.pm) * BM + wr * 64 + fr, col0 = u.pn * BM + wc * 32 + 4 * fq;
#pragma unroll
        for (int ai = 0; ai < 2; ++ai)
#pragma unroll
            for (int m = 0; m < 4; ++m) { const size_t off = (size_t)(r0 + ai * HALF + m * 16) * 1024 + col0;
#pragma unroll
                for (int bj = 0; bj < 2; ++bj)
#pragma unroll
                    for (int n = 0; n < 2; ++n) { const size_t o = off + bj * HALF + n * 16;
                        if (u.nt != full_nt) {
#pragma unroll
                            for (int j = 0; j < 4; ++j) unsafeAtomicAdd(ot + o + j, acc[ai][bj][m][n][j]);
                        } else { const f32x4 v = *(const f32x4*)(bs + o) + acc[ai][bj][m][n]; *(f32x4*)(ot + o) = v; } } }
    }
};
struct MergeOrder {
    int nM, nwg, G, c;
    __host__ __device__ void init(int M, int G_, int c_) { nM = M / BM; nwg = nM * 4; G = G_; c = c_; }
    __host__ __device__ bool next(int i, Unit& u) const {
        const int j = i / 3, b = i - 3 * j; const long L = (long)j * G + c; if (L >= nwg) return false;
        int wgid = (int)L; { const int q = nwg / NXCD, r = nwg % NXCD, xcd = wgid % NXCD, off = wgid / NXCD; wgid = (xcd < r ? xcd * (q + 1) : r * (q + 1) + (xcd - r) * q) + off; }
        const int nN = 4, nig = WGM * nN, gid = wgid / nig, fm = gid * WGM, gsz = (nM - fm) < WGM ? (nM - fm) : WGM;
        u.pm = fm + ((wgid % nig) % gsz); u.pn = b * 4 + (wgid % nig) / gsz; u.k0 = 0; u.nt = 0; return true;
    }
    __device__ __forceinline__ void a_ready(const Unit&) const {}
    __device__ __forceinline__ void done(const Unit&) const {}
};
struct SplitOrder {
    int nM, nN, nwg, G, c, ntk;
    __host__ __device__ void init(int M, int N, int K, int G_, int c_) { nM = M / BM; nN = N / BM; nwg = nM * nN; G = G_; c = c_; ntk = K / BK; }
    __host__ __device__ bool next(int i, Unit& u) const {
        long L;
        if (i == 0) { L = c; u.k0 = 0; u.nt = ntk; }
        else if (i == 1) { L = (long)G + (c >> 1); u.nt = ntk / 2; u.k0 = (c & 1) * (ntk / 2); }
        else return false;
        if (L >= nwg) return false;
        int wgid = (int)L; { const int q = nwg / NXCD, r = nwg % NXCD, xcd = wgid % NXCD, off = wgid / NXCD; wgid = (xcd < r ? xcd * (q + 1) : r * (q + 1) + (xcd - r) * q) + off; }
        const int nig = WGM * nN, gid = wgid / nig, fm = gid * WGM, gsz = (nM - fm) < WGM ? (nM - fm) : WGM;
        u.pm = fm + ((wgid % nig) % gsz); u.pn = (wgid % nig) / gsz; return true;
    }
    __device__ __forceinline__ void a_ready(const Unit&) const {}
    __device__ __forceinline__ void done(const Unit&) const {}
};
template <class Epi, class Sched, bool ALIGN_EPI = false, bool SP2 = false>
__device__ __forceinline__ void gemm_phase(PG8_LAS unsigned char* lds, const Gemm g, const Sched& S, const Epi& E) {
    int tid_ = threadIdx.x; asm volatile("" : "+v"(tid_)); const int tid = tid_, wid = __builtin_amdgcn_readfirstlane(tid >> 6), lane = tid & 63, wr = wid >> 2, wc = wid & 3, fr = lane & 15, fq = lane >> 4;
    const int K = g.K, nt = K / BK;
    unsigned voffA[2], voffB[2];
#pragma unroll
    for (int i = 0; i < 2; ++i) { int R, C; stage_rc(tid * 16 + i * 8192, R, C); const int Rb = Epi::PERM ? ((R & ~31) + perm32(R & 31)) : R;
        voffA[i] = (unsigned)(R * K + C) * 2u; voffB[i] = (unsigned)(Rb * K + C) * 2u; }
    const size_t kstep = (size_t)(BK * 2);
    const size_t hstep = (size_t)HALF * K * 2;
    const size_t tstep = 2 * hstep;
    const unsigned ldsw = (unsigned)wid * 1024u;
    const int aoff = lds_byte(wr * 64 + fr, fq * 8), boff = lds_byte(wc * 32 + fr, fq * 8);
#define PG8_SA(b, h) (((b) * 2 + (h)) * HTB)
#define PG8_SB(b, h) ((4 + (b) * 2 + (h)) * HTB)
#define PG8_STAGE(bufoff, gbase, voff) do { _Pragma("unroll") for (int _i = 0; _i < 2; ++_i) \
        __builtin_amdgcn_global_load_lds((const unsigned*)((const char*)(gbase) + (voff)[_i]), (PG8_LAS unsigned*)(lds + (bufoff) + ldsw + _i * 8192), 16, 0, 0); } while (0)
#define PG8_LDA(dst, b, h) do { _Pragma("unroll") for (int m = 0; m < 4; ++m) _Pragma("unroll") for (int k = 0; k < 2; ++k) dst[m][k] = *(const PG8_LAS bf16x8*)(lds + PG8_SA(b, h) + aoff + m * 2048 + k * 1024); } while (0)
#define PG8_LDB(dst, b, h) do { _Pragma("unroll") for (int n = 0; n < 2; ++n) _Pragma("unroll") for (int k = 0; k < 2; ++k) dst[n][k] = *(const PG8_LAS bf16x8*)(lds + PG8_SB(b, h) + boff + n * 2048 + k * 1024); } while (0)
#define PG8_MMA(ai, bj, At, Bt) do { __builtin_amdgcn_s_setprio(1); _Pragma("unroll") for (int m = 0; m < 4; ++m) _Pragma("unroll") for (int n = 0; n < 2; ++n) _Pragma("unroll") for (int k = 0; k < 2; ++k) \
        acc[ai][bj][m][n] = __builtin_amdgcn_mfma_f32_16x16x32_bf16(Bt[n][k], At[m][k], acc[ai][bj][m][n], 0, 0, 0); __builtin_amdgcn_s_setprio(0); } while (0)
#define PG8_WAIT_V(n) asm volatile("s_waitcnt vmcnt(" #n ")" ::: "memory")
#define PG8_WAIT_L(n) asm volatile("s_waitcnt lgkmcnt(" #n ")" ::: "memory")
#define PG8_BAR __builtin_amdgcn_s_barrier()
#define PG8_SCHED __builtin_amdgcn_sched_barrier(0)
    Unit cur, nxt; int ui = 0;
    if (!S.next(0, cur)) return;
    if (cur.nt == 0) cur.nt = nt;
    f32x4 acc[2][2][4][2];
#pragma unroll
    for (int a = 0; a < 2; ++a)
#pragma unroll
        for (int b = 0; b < 2; ++b)
#pragma unroll
            for (int m = 0; m < 4; ++m)
#pragma unroll
                for (int n = 0; n < 2; ++n) acc[a][b][m][n] = (f32x4){0.f, 0.f, 0.f, 0.f};
    bf16x8 At[4][2], B0[2][2], B1[2][2];
    const char* cA = (const char*)g.A + (size_t)(cur.pn / g.a_grp) * g.a_grp_bytes + (size_t)cur.pm * tstep + (size_t)cur.k0 * kstep; const char* cB = (const char*)g.Bt + (size_t)cur.pn * tstep + (size_t)cur.k0 * kstep;
    S.a_ready(cur);
    if constexpr (SP2) {
        PG8_STAGE(PG8_SB(0, 0), cB, voffB); PG8_STAGE(PG8_SB(0, 1), cB + hstep, voffB); PG8_STAGE(PG8_SA(0, 0), cA, voffA); PG8_STAGE(PG8_SA(0, 1), cA + hstep, voffA);
        if (wr == 1) PG8_BAR;
        PG8_WAIT_V(2); PG8_BAR;
        PG8_STAGE(PG8_SB(1, 0), cB + kstep, voffB); PG8_STAGE(PG8_SA(1, 0), cA + kstep, voffA); PG8_STAGE(PG8_SB(1, 1), cB + hstep + kstep, voffB);
        PG8_WAIT_V(6); PG8_BAR;
    } else {
        PG8_STAGE(PG8_SB(0, 0), cB, voffB); PG8_STAGE(PG8_SA(0, 0), cA, voffA); PG8_STAGE(PG8_SB(0, 1), cB + hstep, voffB); PG8_STAGE(PG8_SA(0, 1), cA + hstep, voffA);
        if (wr == 1) PG8_BAR;
        PG8_WAIT_V(4); PG8_BAR;
        PG8_STAGE(PG8_SB(1, 0), cB + kstep, voffB); PG8_STAGE(PG8_SA(1, 0), cA + kstep, voffA); PG8_STAGE(PG8_SB(1, 1), cB + hstep + kstep, voffB);
        PG8_WAIT_V(6); PG8_BAR;
    }
    for (;;) {
        const bool has_next = S.next(ui + 1, nxt);
        if (has_next && nxt.nt == 0) nxt.nt = nt;
        const char* nA = has_next ? (const char*)g.A + (size_t)(nxt.pn / g.a_grp) * g.a_grp_bytes + (size_t)nxt.pm * tstep + (size_t)nxt.k0 * kstep : cA; const char* nB = has_next ? (const char*)g.Bt + (size_t)nxt.pn * tstep + (size_t)nxt.k0 * kstep : cB;
        const int unt = cur.nt;
        for (int t = 0; t < unt; t += 2) {
            const bool last = (t == unt - 2);
            const char* a1 = cA + (size_t)(t + 1) * kstep;
            const char* a2 = last ? nA : cA + (size_t)(t + 2) * kstep; const char* b2 = last ? nB : cB + (size_t)(t + 2) * kstep;
            const char* a3 = a2 + kstep; const char* b3 = b2 + kstep;
            if (last && has_next) S.a_ready(nxt);
            if constexpr (SP2) {
            PG8_LDB(B0, 0, 0); PG8_LDB(B1, 0, 1); PG8_SCHED; PG8_LDA(At, 0, 0); PG8_STAGE(PG8_SA(1, 1), a1 + hstep, voffA);
            PG8_WAIT_V(8); PG8_WAIT_L(0); PG8_BAR; PG8_MMA(0, 0, At, B0); PG8_MMA(0, 1, At, B1); PG8_BAR; PG8_SCHED;
            PG8_LDA(At, 0, 1); PG8_STAGE(PG8_SB(0, 0), b2, voffB); PG8_STAGE(PG8_SB(0, 1), b2 + hstep, voffB); PG8_STAGE(PG8_SA(0, 0), a2, voffA);
            PG8_WAIT_V(8); PG8_WAIT_L(0); PG8_BAR; PG8_MMA(1, 0, At, B0); PG8_MMA(1, 1, At, B1); PG8_BAR; PG8_SCHED;
            PG8_LDB(B0, 1, 0); PG8_LDB(B1, 1, 1); PG8_SCHED; PG8_LDA(At, 1, 0); PG8_STAGE(PG8_SA(0, 1), a2 + hstep, voffA);
            PG8_WAIT_V(8); PG8_WAIT_L(0); PG8_BAR; PG8_MMA(0, 0, At, B0); PG8_MMA(0, 1, At, B1); PG8_BAR; PG8_SCHED;
            PG8_LDA(At, 1, 1); PG8_STAGE(PG8_SB(1, 0), b3, voffB); PG8_STAGE(PG8_SB(1, 1), b3 + hstep, voffB); PG8_STAGE(PG8_SA(1, 0), a3, voffA);
            PG8_WAIT_V(8); PG8_WAIT_L(0); PG8_BAR; PG8_MMA(1, 0, At, B0); PG8_MMA(1, 1, At, B1); PG8_BAR; PG8_SCHED;
            } else {
            PG8_LDB(B0, 0, 0); PG8_SCHED; PG8_LDA(At, 0, 0); PG8_STAGE(PG8_SA(1, 1), a1 + hstep, voffA);
            PG8_WAIT_L(8); PG8_BAR; PG8_WAIT_L(0); PG8_MMA(0, 0, At, B0); PG8_BAR; PG8_SCHED;
            PG8_LDB(B1, 0, 1); PG8_STAGE(PG8_SB(0, 0), b2, voffB);
            PG8_BAR; PG8_WAIT_L(0); PG8_MMA(0, 1, At, B1); PG8_BAR;
            PG8_LDA(At, 0, 1); PG8_STAGE(PG8_SA(0, 0), a2, voffA);
            PG8_BAR; PG8_WAIT_L(0); PG8_MMA(1, 0, At, B0); PG8_BAR; PG8_SCHED;
            PG8_STAGE(PG8_SB(0, 1), b2 + hstep, voffB);
            PG8_WAIT_V(6); PG8_BAR; PG8_MMA(1, 1, At, B1); PG8_BAR;
            PG8_LDB(B0, 1, 0); PG8_SCHED; PG8_LDA(At, 1, 0); PG8_STAGE(PG8_SA(0, 1), a2 + hstep, voffA);
            PG8_WAIT_L(8); PG8_BAR; PG8_WAIT_L(0); PG8_MMA(0, 0, At, B0); PG8_BAR; PG8_SCHED;
            PG8_LDB(B1, 1, 1); PG8_STAGE(PG8_SB(1, 0), b3, voffB);
            PG8_BAR; PG8_WAIT_L(0); PG8_MMA(0, 1, At, B1); PG8_BAR;
            PG8_LDA(At, 1, 1); PG8_STAGE(PG8_SA(1, 0), a3, voffA);
            PG8_BAR; PG8_WAIT_L(0); PG8_MMA(1, 0, At, B0); PG8_BAR; PG8_SCHED;
            PG8_STAGE(PG8_SB(1, 1), b3 + hstep, voffB);
            PG8_WAIT_V(6); PG8_BAR; PG8_MMA(1, 1, At, B1); PG8_BAR;
            }
        }
        if constexpr (ALIGN_EPI) { if (wr == 0) PG8_BAR; }
        if constexpr (!Epi::AFTER_DRAIN) { E(acc, cur, wr, wc, fr, fq); S.done(cur); }
        if (!has_next) break;
#pragma unroll
        for (int a = 0; a < 2; ++a)
#pragma unroll
            for (int b = 0; b < 2; ++b)
#pragma unroll
                for (int m = 0; m < 4; ++m)
#pragma unroll
                    for (int n = 0; n < 2; ++n) acc[a][b][m][n] = (f32x4){0.f, 0.f, 0.f, 0.f};
        cur = nxt; cA = nA; cB = nB; ++ui;
        if constexpr (ALIGN_EPI) { if (wr == 1) PG8_BAR; }
    }
    PG8_WAIT_V(0);
    if constexpr (!ALIGN_EPI) { if (wr == 0) PG8_BAR; }
    PG8_BAR;
    if constexpr (Epi::AFTER_DRAIN) { E.fused(acc, cur, wr, wc, fr, fq, lds, wid, lane); S.done(cur); }
#undef PG8_SA
#undef PG8_SB
#undef PG8_STAGE
#undef PG8_LDA
#undef PG8_LDB
#undef PG8_MMA
#undef PG8_WAIT_V
#undef PG8_WAIT_L
#undef PG8_BAR
#undef PG8_SCHED
}
}
#include <hip/hip_bf16.h>
#include <cmath>
namespace attn_body {
using bf16=__hip_bfloat16;
using bf16x8=__attribute__((ext_vector_type(8)))short;
using s16x4=__attribute__((ext_vector_type(4)))short;
using f32x16=__attribute__((ext_vector_type(16)))float;
using u32x4=__attribute__((ext_vector_type(4)))unsigned;
constexpr int D=64,PQ=4096,PO=512;
constexpr int NW=8,QBLK=32,QB=QBLK*NW,KVBLK=64;
__device__ __forceinline__ int crow(int r,int hi){return (r&3)+8*(r>>2)+4*hi;}
#define SBAR() __builtin_amdgcn_sched_barrier(0)
constexpr int NSLOT=3, SLOTB=8192;
constexpr int LDS_K=0, LDS_V=NSLOT*SLOTB, LDS_WS=2*NSLOT*SLOTB, LDS_OST=LDS_WS+NW*64*4, LDS_BYTES=LDS_OST+NW*4096;
constexpr float C2=0.125f*1.4426950408889634f;
__device__ __forceinline__ void glds16(const void*gsrc,unsigned lds_dst){unsigned keep;
  asm volatile("s_mov_b32 %0, m0\n\ts_mov_b32 m0, %2\n\ts_nop 0\n\tglobal_load_lds_dwordx4 %1, off\n\ts_mov_b32 m0, %0":"=&s"(keep):"v"(gsrc),"s"(lds_dst):"memory");}
__device__ __forceinline__ float max3f(float a,float b,float c){float r;asm("v_max3_f32 %0, %1, %2, %3":"=v"(r):"v"(a),"v"(b),"v"(c));return r;}
__device__ __forceinline__ float max2f(float a,float b){float r;asm("v_max_f32_e32 %0, %1, %2":"=v"(r):"v"(a),"v"(b));return r;}
__device__ __forceinline__ float fadd_s(float a,float b){float r;asm("v_add_f32_e32 %0, %1, %2":"=v"(r):"v"(a),"v"(b));return r;}
__device__ __forceinline__ float fsub_s(float a,float b){float r;asm("v_sub_f32_e32 %0, %1, %2":"=v"(r):"v"(a),"v"(b));return r;}
typedef float f32x2_t __attribute__((ext_vector_type(2))); typedef __bf16 bf16x2_t __attribute__((ext_vector_type(2)));
__device__ __forceinline__ unsigned cvtpk_s(float lo,float hi){f32x2_t v={lo,hi};bf16x2_t b=__builtin_convertvector(v,bf16x2_t);return __builtin_bit_cast(unsigned,b);}
#define WAIT_BAR(N) asm volatile("s_waitcnt vmcnt(" #N ") lgkmcnt(0)\n\ts_barrier":::"memory")

__device__ __forceinline__ void qkt(f32x16&p0,f32x16&p1,const char*Kslot,const bf16x8*qr,const f32x16&negm,int r32,int hi){
  const char*kb=Kslot+hi*1024+r32*16;
  #pragma unroll
  for(int d0=0;d0<4;++d0){
    const bf16x8 b0=*reinterpret_cast<const bf16x8*>(kb+d0*2048);
    const bf16x8 b1=*reinterpret_cast<const bf16x8*>(kb+d0*2048+512);
    if(d0==0){p0=__builtin_amdgcn_mfma_f32_32x32x16_bf16(b0,qr[0],negm,0,0,0);p1=__builtin_amdgcn_mfma_f32_32x32x16_bf16(b1,qr[0],negm,0,0,0);}
    else{p0=__builtin_amdgcn_mfma_f32_32x32x16_bf16(b0,qr[d0],p0,0,0,0);p1=__builtin_amdgcn_mfma_f32_32x32x16_bf16(b1,qr[d0],p1,0,0,0);}}
}
typedef __attribute__((address_space(3))) const char* lds_cptr;
typedef short v4i16_t __attribute__((ext_vector_type(4)));
__device__ __forceinline__ void kload8(bf16x8*kf,lds_cptr kp){
  kf[0]=*(const __attribute__((address_space(3))) bf16x8*)(kp);      kf[1]=*(const __attribute__((address_space(3))) bf16x8*)(kp+512);
  kf[2]=*(const __attribute__((address_space(3))) bf16x8*)(kp+2048); kf[3]=*(const __attribute__((address_space(3))) bf16x8*)(kp+2560);
  kf[4]=*(const __attribute__((address_space(3))) bf16x8*)(kp+4096); kf[5]=*(const __attribute__((address_space(3))) bf16x8*)(kp+4608);
  kf[6]=*(const __attribute__((address_space(3))) bf16x8*)(kp+6144); kf[7]=*(const __attribute__((address_space(3))) bf16x8*)(kp+6656);
}
__device__ __forceinline__ void kload2(bf16x8*kf,lds_cptr kp,int j){ kf[2*j]=*(const __attribute__((address_space(3))) bf16x8*)(kp+j*2048); kf[2*j+1]=*(const __attribute__((address_space(3))) bf16x8*)(kp+j*2048+512); }
__device__ __forceinline__ s16x4 vtr(lds_cptr p){ return __builtin_bit_cast(s16x4,__builtin_amdgcn_ds_read_tr16_b64_v4i16((__attribute__((address_space(3))) v4i16_t*)p)); }
__device__ __forceinline__ float rowmax(const f32x16&p0,const f32x16&p1){
  float a=max3f(p0[0],p0[1],p1[0]),b=max3f(p0[2],p0[3],p1[1]);a=max3f(a,p1[2],p1[3]);
  #pragma unroll
  for(int r=4;r<16;r+=4){a=max3f(a,p0[r],p0[r+1]);b=max3f(b,p0[r+2],p0[r+3]);a=max3f(a,p1[r],p1[r+1]);b=max3f(b,p1[r+2],p1[r+3]);}
  const float m=max2f(a,b);
  auto rr=__builtin_amdgcn_permlane32_swap(__float_as_uint(m),__float_as_uint(m),false,false);
  return max2f(__uint_as_float(rr[0]),__uint_as_float(rr[1]));
}
__device__ __forceinline__ void pv(f32x16*o,int vb,bf16x8 pa0,bf16x8 pa1,bf16x8 pa2,bf16x8 pa3){
  #pragma unroll
  for(int d0=0;d0<2;++d0){s16x4 lo[4],hi[4];
    #pragma unroll
    for(int ks=0;ks<4;++ks){
      asm volatile("ds_read_b64_tr_b16 %0,%1 offset:%c2":"=&v"(lo[ks]):"v"(vb),"i"(d0*4096+ks*1024):"memory");
      asm volatile("ds_read_b64_tr_b16 %0,%1 offset:%c2":"=&v"(hi[ks]):"v"(vb),"i"(d0*4096+ks*1024+512):"memory");}
    asm volatile("s_waitcnt lgkmcnt(0)":::"memory");SBAR();
    #define PK(k) (bf16x8){lo[k][0],lo[k][1],lo[k][2],lo[k][3],hi[k][0],hi[k][1],hi[k][2],hi[k][3]}
    o[d0]=__builtin_amdgcn_mfma_f32_32x32x16_bf16(pa0,PK(0),o[d0],0,0,0);
    o[d0]=__builtin_amdgcn_mfma_f32_32x32x16_bf16(pa1,PK(1),o[d0],0,0,0);
    o[d0]=__builtin_amdgcn_mfma_f32_32x32x16_bf16(pa2,PK(2),o[d0],0,0,0);
    o[d0]=__builtin_amdgcn_mfma_f32_32x32x16_bf16(pa3,PK(3),o[d0],0,0,0);
    #undef PK
  }
}

#ifndef ATTN_STORE16
#define ATTN_STORE16(p,v) (*(u32x4*)(p)=(v))
#endif
template<int THRL> __device__ __forceinline__ void attn_unit(const bf16*Qu,const bf16*__restrict__ Kh,const bf16*__restrict__ Vh,bf16*Ou,const int NT,char*shm){
  int tid_=threadIdx.x; asm volatile("":"+v"(tid_)); const int tid=tid_,lane=tid&63,r32=lane&31,hi=lane>>5; const int wid=__builtin_amdgcn_readfirstlane(tid>>6);
  const bf16*Qw=Qu+(long)(wid*QBLK)*PQ;
  const unsigned lds0=(unsigned)(uintptr_t)shm;
  float*wsf=(float*)(shm+LDS_WS)+wid*64;
  const bf16*ksrc=Kh+(long)lane*PQ+wid*8;
  const bf16*vsrc=Vh+(long)(16*(wid&3)+(lane>>2))*PQ+(wid>>2)*32+(lane&3)*8;
  const unsigned kdst=lds0+LDS_K+wid*1024, vdst=lds0+LDS_V+wid*1024;
  #define DMA_K(t,slot) glds16(ksrc+(long)(t)*KVBLK*PQ,(unsigned)__builtin_amdgcn_readfirstlane(kdst+(slot)))
  #define DMA_V(t,slot) glds16(vsrc+(long)(t)*KVBLK*PQ,(unsigned)__builtin_amdgcn_readfirstlane(vdst+(slot)))
  const int vb0=(int)(lds0+LDS_V)+((lane>>4)&1)*32+(lane&3)*8+(4*hi+((lane&15)>>2))*64;
  const char*Kbase=shm+LDS_K; bf16x8 kf[8];
  const lds_cptr shm3=(lds_cptr)shm; const lds_cptr kp0=shm3+LDS_K+hi*1024+r32*16; const lds_cptr vp0=shm3+LDS_V+((lane>>4)&1)*32+(lane&3)*8+(4*hi+((lane&15)>>2))*64;
  DMA_K(0,0);DMA_V(0,0);DMA_K(1,SLOTB);
  bf16x8 qr[4];
  #pragma unroll
  for(int d0=0;d0<4;++d0)qr[d0]=*reinterpret_cast<const bf16x8*>(&Qw[(long)r32*PQ+d0*16+hi*8]);
  float mhat=0.f,l_reg=0.f;f32x16 o[2];o[0]=f32x16{};o[1]=f32x16{};f32x16 negm=f32x16{};asm volatile("":"+v"(negm));
  #define CMASK(P0,P1,t) do{}while(0)
  bool resc=false;
  #define START(P0,P1) do{ const float rm=rowmax(P0,P1); resc=false; \
    { const float dl=rm; mhat=fadd_s(mhat,dl); \
      _Pragma("unroll") for(int r=0;r<16;++r){P0[r]=fsub_s(P0[r],dl);P1[r]=fsub_s(P1[r],dl);} \
      _Pragma("unroll") for(int r=0;r<16;++r)negm[r]=-mhat; asm volatile("":"+v"(negm)); } \
    _Pragma("unroll") for(int r=0;r<16;++r)P0[r]=__builtin_amdgcn_exp2f(P0[r]); }while(0)
  #define RESC() do{ if(resc){ asm volatile("s_waitcnt lgkmcnt(0)":::"memory"); \
      _Pragma("unroll") for(int d_=0;d_<2;++d_) _Pragma("unroll") for(int r=0;r<16;++r)o[d_][r]*=wsf[crow(r,hi)]; } }while(0)
  f32x16 pA0,pA1,pB0,pB1;
  int sl_prev=0,sl_cur=0,sl_next=SLOTB;
  #define ROT() do{sl_prev=sl_cur;sl_cur=sl_next;sl_next=(sl_next==(NSLOT-1)*SLOTB)?0:sl_next+SLOTB;}while(0)
  DMA_K(2,2*SLOTB);
  WAIT_BAR(3);
  qkt(pA0,pA1,Kbase,qr,negm,r32,hi);asm volatile("s_nop 15\n\ts_nop 7":"+v"(pA0),"+v"(pA1));CMASK(pA0,pA1,0);
  START(pA0,pA1);
  _Pragma("unroll") for(int r=0;r<16;++r)pA1[r]=__builtin_amdgcn_exp2f(pA1[r]);
  WAIT_BAR(0);
  DMA_K(3,0);DMA_V(1,SLOTB);
  ROT();
  kload8(kf,kp0+sl_cur);
  WAIT_BAR(2);
  s16x4 vlo[8],vhi[8]; u32x4 pw0,pw1,pw2,pw3;
  #define PKW(P,B) cvtpk_s(P[B],P[B+1])
  #define PAF(k) __builtin_bit_cast(bf16x8,pw##k)
  #define VFR(i) (bf16x8){vlo[i][0],vlo[i][1],vlo[i][2],vlo[i][3],vhi[i][0],vhi[i][1],vhi[i][2],vhi[i][3]}
  #define PIN(x) asm volatile("":"+v"(x))
  #define MX3(a,b,c) __builtin_fmaxf(__builtin_fmaxf((a),(b)),(c))
  #define GAPA(MF,A0,A1,A2,A3,W0,W1,PW) do{ MF; sacc+=A0; sacc+=A1; sacc+=A2; sacc+=A3; PIN(sacc); W0; W1; PIN(PW); SBAR(); }while(0)
  #define EX(v) __builtin_amdgcn_exp2f(v)
  #define GAPB(MF,X,B) do{ MF; X[B]=EX(X[B]); X[B+1]=EX(X[B+1]); X[B+2]=EX(X[B+2]); X[B+3]=EX(X[B+3]); PIN(X); SBAR(); }while(0)
  #define VRD(i) do{ vlo[i]=vtr(vp_+(((i)>>2)*4096+((i)&3)*1024)); vhi[i]=vtr(vp_+(((i)>>2)*4096+((i)&3)*1024+512)); }while(0)
  #define KRD(G,j) do{ if(G){ kload2(kf,kp0+sl_next,j); SBAR(); } }while(0)
  #define STEP(C0,C1,P0,P1,t,GK,GV,GL) do{ SBAR(); \
    const lds_cptr vp_=vp0+sl_prev; \
    VRD(0); SBAR(); float sacc=(P0[0]+P0[1]); \
    GAPA(C0=__builtin_amdgcn_mfma_f32_32x32x16_bf16(kf[0],qr[0],negm,0,0,0), P0[2],P0[3],P0[4],P0[5],     pw0[0]=PKW(P0,0), pw0[1]=PKW(P0,2), pw0); \
    VRD(4); SBAR(); GAPA(C1=__builtin_amdgcn_mfma_f32_32x32x16_bf16(kf[1],qr[0],negm,0,0,0), P0[6],P0[7],P0[8],P0[9],     pw0[2]=PKW(P0,4), pw0[3]=PKW(P0,6), pw0); \
    VRD(1); SBAR(); GAPA(C0=__builtin_amdgcn_mfma_f32_32x32x16_bf16(kf[2],qr[1],C0,0,0,0),   P0[10],P0[11],P0[12],P0[13], pw1[0]=PKW(P0,8), pw1[1]=PKW(P0,10), pw1); \
    VRD(5); SBAR(); GAPA(C1=__builtin_amdgcn_mfma_f32_32x32x16_bf16(kf[3],qr[1],C1,0,0,0),   P0[14],P0[15],P1[0],P1[1],   pw1[2]=PKW(P0,12),pw1[3]=PKW(P0,14), pw1); \
    VRD(2); SBAR(); GAPA(C0=__builtin_amdgcn_mfma_f32_32x32x16_bf16(kf[4],qr[2],C0,0,0,0),   P1[2],P1[3],P1[4],P1[5],     pw2[0]=PKW(P1,0), pw2[1]=PKW(P1,2), pw2); \
    VRD(6); SBAR(); GAPA(C1=__builtin_amdgcn_mfma_f32_32x32x16_bf16(kf[5],qr[2],C1,0,0,0),   P1[6],P1[7],P1[8],P1[9],     pw2[2]=PKW(P1,4), pw2[3]=PKW(P1,6), pw2); \
    VRD(3); SBAR(); GAPA(C0=__builtin_amdgcn_mfma_f32_32x32x16_bf16(kf[6],qr[3],C0,0,0,0),   P1[10],P1[11],P1[12],P1[13], pw3[0]=PKW(P1,8), pw3[1]=PKW(P1,10), pw3); \
    VRD(7); SBAR(); GAPA(C1=__builtin_amdgcn_mfma_f32_32x32x16_bf16(kf[7],qr[3],C1,0,0,0),   P1[14],P1[15],0.f,0.f,       pw3[2]=PKW(P1,12),pw3[3]=PKW(P1,14), pw3); \
    l_reg+=sacc; \
    if(GK){DMA_K((t)+3,sl_cur);} if(GV){DMA_V((t)+1,sl_next);} \
    CMASK(C0,C1,t); \
    { float a=MX3(C0[0],C0[1],C1[0]),b=MX3(C0[2],C0[3],C1[1]); a=MX3(a,C1[2],C1[3]); \
      _Pragma("unroll") for(int r=4;r<16;r+=4){a=MX3(a,C0[r],C0[r+1]);b=MX3(b,C0[r+2],C0[r+3]);a=MX3(a,C1[r],C1[r+1]);b=MX3(b,C1[r+2],C1[r+3]);} \
      float rm=__builtin_fmaxf(a,b); { auto rr=__builtin_amdgcn_permlane32_swap(__float_as_uint(rm),__float_as_uint(rm),false,false); rm=__builtin_fmaxf(__uint_as_float(rr[0]),__uint_as_float(rr[1])); } \
      resc=false; \
      if(__builtin_expect(__any(rm>(float)THRL),0)){ const float dl=__builtin_fmaxf(rm,0.f); mhat+=dl; \
        _Pragma("unroll") for(int r=0;r<16;++r){C0[r]-=dl;C1[r]-=dl;} \
        _Pragma("unroll") for(int r=0;r<16;++r)negm[r]=-mhat; asm volatile("":"+v"(negm)); \
        const float f=__builtin_amdgcn_exp2f(-dl); l_reg*=f; if(hi==0)wsf[r32]=f; resc=true; } } \
    SBAR(); \
    GAPB(o[0]=__builtin_amdgcn_mfma_f32_32x32x16_bf16(PAF(0),VFR(0),o[0],0,0,0), C0,0); \
    GAPB(o[1]=__builtin_amdgcn_mfma_f32_32x32x16_bf16(PAF(0),VFR(4),o[1],0,0,0), C0,4); \
    KRD(GL,0); GAPB(o[0]=__builtin_amdgcn_mfma_f32_32x32x16_bf16(PAF(1),VFR(1),o[0],0,0,0), C0,8); \
    KRD(GL,1); GAPB(o[1]=__builtin_amdgcn_mfma_f32_32x32x16_bf16(PAF(1),VFR(5),o[1],0,0,0), C0,12); \
    KRD(GL,2); GAPB(o[0]=__builtin_amdgcn_mfma_f32_32x32x16_bf16(PAF(2),VFR(2),o[0],0,0,0), C1,0); \
    KRD(GL,3); GAPB(o[1]=__builtin_amdgcn_mfma_f32_32x32x16_bf16(PAF(2),VFR(6),o[1],0,0,0), C1,4); \
    GAPB(o[0]=__builtin_amdgcn_mfma_f32_32x32x16_bf16(PAF(3),VFR(3),o[0],0,0,0), C1,8); \
    GAPB(o[1]=__builtin_amdgcn_mfma_f32_32x32x16_bf16(PAF(3),VFR(7),o[1],0,0,0), C1,12); \
    }while(0)
  int t=1;
  #undef CMASK
  #define CMASK(P0,P1,t) do{}while(0)
  for(;t+5<NT;t+=2){
    STEP(pB0,pB1,pA0,pA1,t,true,true,true);     WAIT_BAR(2); RESC(); ROT();
    STEP(pA0,pA1,pB0,pB1,t+1,true,true,true);   WAIT_BAR(2); RESC(); ROT();
  }
  #undef CMASK
  #define CMASK(P0,P1,t) do{}while(0)
  #define ENDW(tt) do{ if((tt)+3<NT){WAIT_BAR(2);} else if((tt)+2<NT){WAIT_BAR(1);} else {WAIT_BAR(0);} }while(0)
  for(;t+1<NT;t+=2){
    STEP(pB0,pB1,pA0,pA1,t,(t+3<NT),(t+1<NT),(t+1<NT));       ENDW(t);   RESC(); ROT();
    STEP(pA0,pA1,pB0,pB1,t+1,(t+4<NT),(t+2<NT),(t+2<NT));     ENDW(t+1); RESC(); ROT();
  }
  STEP(pB0,pB1,pA0,pA1,NT-1,false,false,false); RESC();
  { float sacc=pB0[0]+pB0[1]; _Pragma("unroll") for(int r=2;r<16;++r)sacc+=pB0[r]; _Pragma("unroll") for(int r=0;r<16;++r)sacc+=pB1[r]; l_reg+=sacc;
    pw0=(u32x4){PKW(pB0,0),PKW(pB0,2),PKW(pB0,4),PKW(pB0,6)};pw1=(u32x4){PKW(pB0,8),PKW(pB0,10),PKW(pB0,12),PKW(pB0,14)};pw2=(u32x4){PKW(pB1,0),PKW(pB1,2),PKW(pB1,4),PKW(pB1,6)};pw3=(u32x4){PKW(pB1,8),PKW(pB1,10),PKW(pB1,12),PKW(pB1,14)};
    SBAR(); pv(o,vb0+sl_cur,PAF(0),PAF(1),PAF(2),PAF(3)); }
  #undef PKW
  #undef PAF
  #undef VFR
  #undef PIN
  #undef MX3
  #undef GAPA
  #undef GAPB
  #undef EX
  #undef VRD
  #undef KRD
  #undef STEP
  #undef ENDW
  {auto rr=__builtin_amdgcn_permlane32_swap(__float_as_uint(l_reg),__float_as_uint(l_reg),false,false);l_reg=__uint_as_float(rr[0])+__uint_as_float(rr[1]);}
  if(hi==0)wsf[32+r32]=l_reg;asm volatile("s_waitcnt lgkmcnt(0)":::"memory");
  float rli[16];
  #pragma unroll
  for(int r=0;r<16;++r)rli[r]=__builtin_amdgcn_rcpf(wsf[32+crow(r,hi)]);
  bf16*Ow=Ou+(long)(wid*QBLK)*PO;
  { bf16*stg=(bf16*)(shm+LDS_OST)+wid*2048;
    #pragma unroll
    for(int r=0;r<16;++r){const int orow=crow(r,hi);
      #pragma unroll
      for(int d0=0;d0<2;++d0)stg[orow*64+d0*32+r32]=__float2bfloat16(o[d0][r]*rli[r]);}
    asm volatile("s_waitcnt lgkmcnt(0)":::"memory");
    #pragma unroll
    for(int i=0;i<4;++i){const int row=i*8+(lane>>3),ch=lane&7; const u32x4 v=*(const u32x4*)(stg+row*64+ch*8); ATTN_STORE16(Ow+(long)row*PO+ch*8,v);} }
  asm volatile("s_waitcnt lgkmcnt(0)\n\ts_barrier":::"memory");
  #undef DMA_K
  #undef DMA_V
  #undef CMASK
  #undef START
  #undef RESC
  #undef ROT
}
constexpr int ATTN_LDS_BYTES=LDS_BYTES;
#undef SBAR
#undef WAIT_BAR
}
#define GAS __attribute__((address_space(1)))
#define LAS __attribute__((address_space(3)))
typedef unsigned short bf16;
typedef unsigned v4u __attribute__((ext_vector_type(4)));
typedef unsigned v2u __attribute__((ext_vector_type(2)));
typedef float f32x4 __attribute__((ext_vector_type(4)));
typedef short bf16x8 __attribute__((ext_vector_type(8)));
#define LDS_WAIT() asm volatile("s_waitcnt lgkmcnt(0)" ::: "memory")
#define LDS_BARRIER() do { asm volatile("s_waitcnt lgkmcnt(0)" ::: "memory"); __builtin_amdgcn_s_barrier(); asm volatile("" ::: "memory"); } while (0)

constexpr int NWAVES = 8;
constexpr int DM = 1024, FF = 4096, DEPTH = 2;
constexpr int MH = 16384, MP = MH, MTOT = 49152;
constexpr int SP = 2048, SS = 8192;
constexpr int PW = 4096, INW = 3872;
constexpr int C_AQ = 0, C_AK = 512, C_AV = 640, C_GQ = 768, C_GK = 1024, C_GV = 1280, C_GA = 1792, C_GG = 1824, C_RQ = 2336, C_RK = 2592, C_RV = 2848, C_RG = 3360;
constexpr float EPS = 1e-6f;
constexpr float ATT_C2 = 0.125f * 1.4426950408889634f;

constexpr size_t MiB = 1u << 20;
constexpr size_t WS_CTL = 0, CTL_ZERO_BYTES = 65536;
constexpr int CW_BAR = 4096;
constexpr size_t WS_W = 1 * MiB, LW = 35 * MiB;
constexpr size_t OW_IN = 0, OW_MERGE = 8 * MiB, OW_BR = 14 * MiB, OW_OUT = 17 * MiB, OW_UP = 19 * MiB, OW_DOWN = 27 * MiB;
constexpr size_t WS_XN = 71 * MiB;
constexpr size_t WS_PROJ = 119 * MiB;
constexpr size_t WS_MERGED = WS_PROJ + 144 * MiB;
constexpr size_t WS_OBUF = 311 * MiB;
constexpr size_t OB1 = (size_t)MH * 512;
constexpr size_t WS_SCF = 431 * MiB, WS_SCD = 443 * MiB;
constexpr size_t WS_END = 444 * MiB;

constexpr int RING_BYTES = 131072, MISC_OFF = RING_BYTES + 320, LDS_BYTES = 147456;

__device__ __forceinline__ unsigned f2bf(float f) { unsigned u = __builtin_bit_cast(unsigned, f); return (u + 0x7fffu + ((u >> 16) & 1u)) >> 16; }
typedef float f32x2_t_ __attribute__((ext_vector_type(2))); typedef __bf16 bf16x2_t_ __attribute__((ext_vector_type(2)));
__device__ __forceinline__ unsigned pk2(float lo, float hi) { const f32x2_t_ v = {lo, hi}; const bf16x2_t_ b = __builtin_convertvector(v, bf16x2_t_); return __builtin_bit_cast(unsigned, b); }
__device__ __forceinline__ float bf_lo(unsigned w) { return __builtin_bit_cast(float, w << 16); }
__device__ __forceinline__ float bf_hi(unsigned w) { return __builtin_bit_cast(float, w & 0xffff0000u); }
__device__ __forceinline__ float bf1(unsigned short h) { return __builtin_bit_cast(float, (unsigned)h << 16); }
__device__ __forceinline__ void unpack8(const v4u w, float (&v)[8]) { v[0] = bf_lo(w.x); v[1] = bf_hi(w.x); v[2] = bf_lo(w.y); v[3] = bf_hi(w.y); v[4] = bf_lo(w.z); v[5] = bf_hi(w.z); v[6] = bf_lo(w.w); v[7] = bf_hi(w.w); }
__device__ __forceinline__ v4u pack8(const float (&v)[8]) { v4u w; w.x = pk2(v[0], v[1]); w.y = pk2(v[2], v[3]); w.z = pk2(v[4], v[5]); w.w = pk2(v[6], v[7]); return w; }
__device__ __forceinline__ float wave_sum(float v) {
#pragma unroll
    for (int o = 1; o < 64; o <<= 1) v += __shfl_xor(v, o);
    return v;
}
__device__ __forceinline__ float sigmoidf_fast(float a) { return __builtin_amdgcn_rcpf(1.0f + __builtin_amdgcn_exp2f(-1.4426950408889634f * a)); }

__device__ __forceinline__ void p0_transpose_item(const float* W, int K, int N, bf16* WT, int row_off, LAS float* scr, int item, int lane) {
    const int nblk = N / 32, kb = item / nblk, nb = item % nblk, k0 = 64 * kb, n0 = 32 * nb;
#pragma unroll 8
    for (int i = 0; i < 32; ++i) { const int kk = 2 * i + (lane >> 5); scr[kk * 33 + (lane & 31)] = W[(size_t)(k0 + kk) * N + n0 + (lane & 31)]; }
    LDS_WAIT(); asm volatile("" ::: "memory");
    const int c = lane & 7;
#pragma unroll
    for (int j = 0; j < 4; ++j) { const int n = (lane >> 3) + 8 * j; const LAS float* s = scr + (8 * c) * 33 + n;
        v4u o; o.x = pk2(s[0 * 33], s[1 * 33]); o.y = pk2(s[2 * 33], s[3 * 33]); o.z = pk2(s[4 * 33], s[5 * 33]); o.w = pk2(s[6 * 33], s[7 * 33]);
        *(v4u*)(WT + (size_t)(row_off + n0 + n) * K + k0 + 8 * c) = o; }
    LDS_WAIT(); asm volatile("" ::: "memory");
}

__device__ __forceinline__ void norm_rows(const float* xp, const float* xs, const float* gain, bf16* XN, int gw, int NGW, int lane_in) {
    int lane = lane_in; asm volatile("" : "+v"(lane)); asm volatile("" : "+s"(gw));
    f32x4 g[4];
#pragma unroll
    for (int j = 0; j < 4; ++j) g[j] = *((const f32x4*)gain + lane + 64 * j);
    for (int m0 = gw; m0 < MH; m0 += 4 * NGW) {
        f32x4 v[4][4]; float s[4];
#pragma unroll
        for (int r = 0; r < 4; ++r) { const int m = m0 + r * NGW; s[r] = 0.f;
            if (m < MH) { const float* xrow = m < MP ? xp + (size_t)m * DM : xs + (size_t)(m - MP) * DM; const f32x4* xr = (const f32x4*)xrow + lane;
#pragma unroll
                for (int j = 0; j < 4; ++j) v[r][j] = xr[64 * j]; } }
#pragma unroll
        for (int r = 0; r < 4; ++r) { const int m = m0 + r * NGW;
            if (m < MH) {
#pragma unroll
                for (int j = 0; j < 4; ++j) s[r] += (v[r][j].x * v[r][j].x + v[r][j].y * v[r][j].y) + (v[r][j].z * v[r][j].z + v[r][j].w * v[r][j].w);
                const float rstd = 1.0f / sqrtf(wave_sum(s[r]) * (1.f / DM) + EPS);
                unsigned long long* o8 = (unsigned long long*)(XN + (size_t)m * DM) + lane;
#pragma unroll
                for (int j = 0; j < 4; ++j) { const f32x4 y = v[r][j] * rstd * g[j]; o8[64 * j] = (unsigned long long)pk2(y.x, y.y) | ((unsigned long long)pk2(y.z, y.w) << 32); } } }
    }
}
__device__ __forceinline__ void final_norm(float* out, const float* gain, int gw, int NGW, int lane_in) {
    int lane = lane_in; asm volatile("" : "+v"(lane)); asm volatile("" : "+s"(gw));
    f32x4 g[4];
#pragma unroll
    for (int j = 0; j < 4; ++j) g[j] = *((const f32x4*)gain + lane + 64 * j);
    for (int m0 = gw; m0 < MTOT; m0 += 4 * NGW) {
        f32x4 v[4][4]; float s[4];
#pragma unroll
        for (int r = 0; r < 4; ++r) { const int m = m0 + r * NGW; s[r] = 0.f;
            if (m < MTOT) { const f32x4* xr = (const f32x4*)(out + (size_t)m * DM) + lane;
#pragma unroll
                for (int j = 0; j < 4; ++j) v[r][j] = xr[64 * j]; } }
#pragma unroll
        for (int r = 0; r < 4; ++r) { const int m = m0 + r * NGW;
            if (m < MTOT) { f32x4* xr = (f32x4*)(out + (size_t)m * DM) + lane;
#pragma unroll
                for (int j = 0; j < 4; ++j) s[r] += (v[r][j].x * v[r][j].x + v[r][j].y * v[r][j].y) + (v[r][j].z * v[r][j].z + v[r][j].w * v[r][j].w);
                const float rstd = 1.0f / sqrtf(wave_sum(s[r]) * (1.f / DM) + EPS);
#pragma unroll
                for (int j = 0; j < 4; ++j) xr[64 * j] = v[r][j] * rstd * g[j]; } }
    }
}

__device__ __forceinline__ void rope8(float (&v)[8], int lane, int t) {
    const int sub = lane & 7;
    const float pos = (float)((sub & 4) ? (t & 63) : (t >> 6));
    const bool upper = (sub & 2) != 0;
    const int i0 = 8 * (sub & 1);
#pragma unroll
    for (int e = 0; e < 8; ++e) {
        const float partner = __shfl_xor(v[e], 2);
        const float inv = __builtin_amdgcn_exp2f(-(float)(i0 + e) * 0.8304820237218406f);
        const float ang = pos * inv, s = __sinf(ang), c = __cosf(ang);
        v[e] = v[e] * c + (upper ? partner : -partner) * s;
    }
}
__device__ __forceinline__ float sum8lanes(float s) { s += __shfl_xor(s, 1); s += __shfl_xor(s, 2); s += __shfl_xor(s, 4); return s; }
__device__ __forceinline__ void e1_rows(bf16* proj, const float* qg, const float* kg, int seqmask, int gw, int NGW, int lane_in) {
    int lane = lane_in; asm volatile("" : "+v"(lane)); asm volatile("" : "+s"(gw));
    float gq[8], gk[8];
#pragma unroll
    for (int e = 0; e < 8; ++e) { gq[e] = qg[8 * (lane & 7) + e]; gk[e] = kg[8 * (lane & 7) + e]; }
    for (int m0 = gw; m0 < MH; m0 += 2 * NGW) {
        v4u wq[2], wk[2], wg2[2], wr[2];
#pragma unroll
        for (int rr = 0; rr < 2; ++rr) { const int m = (m0 + rr * NGW) < MH ? (m0 + rr * NGW) : m0; bf16* row = proj + (size_t)m * PW;
            wq[rr] = *(const v4u*)(row + C_AQ + 8 * lane); wk[rr] = *(const v4u*)(row + C_AK + 8 * (lane & 15));
            wg2[rr] = *(const v4u*)(row + C_GQ + 8 * (lane & 31)); wr[rr] = *(const v4u*)(row + (lane < 32 ? C_RQ : C_RK) + 8 * (lane & 31)); }
#pragma unroll
        for (int rr = 0; rr < 2; ++rr) { const int m = m0 + rr * NGW; if (m >= MH) break;
        const int t = m & seqmask;
        bf16* row = proj + (size_t)m * PW;
        { float v[8]; unpack8(wq[rr], v);
          float s = 0.f;
#pragma unroll
          for (int e = 0; e < 8; ++e) s += v[e] * v[e];
          const float rstd = 1.0f / sqrtf(sum8lanes(s) * (1.f / 64.f) + EPS);
#pragma unroll
          for (int e = 0; e < 8; ++e) v[e] = v[e] * rstd * gq[e];
          rope8(v, lane, t);
#pragma unroll
          for (int e = 0; e < 8; ++e) v[e] *= ATT_C2;
          *(v4u*)(row + C_AQ + 8 * lane) = pack8(v); }
        { const int l2 = lane & 15; float v[8]; unpack8(wk[rr], v);
          float s = 0.f;
#pragma unroll
          for (int e = 0; e < 8; ++e) s += v[e] * v[e];
          const float rstd = 1.0f / sqrtf(sum8lanes(s) * (1.f / 64.f) + EPS);
#pragma unroll
          for (int e = 0; e < 8; ++e) v[e] = v[e] * rstd * gk[e];
          rope8(v, lane, t);
          if (lane < 16) *(v4u*)(row + C_AK + 8 * l2) = pack8(v); }
        { const int l2 = lane & 31;
          if (lane < 32) { float v[8]; unpack8(wg2[rr], v);
#pragma unroll
              for (int e = 0; e < 8; ++e) v[e] *= 0.125f;
              *(v4u*)(row + C_GQ + 8 * l2) = pack8(v); }
          bf16* p = row + (lane < 32 ? C_RQ : C_RK) + 8 * l2;
          float v[8]; unpack8(wr[rr], v);
          rope8(v, lane, t);
          const float sc = lane < 32 ? 1.0f : 0.125f;
#pragma unroll
          for (int e = 0; e < 8; ++e) v[e] *= sc;
          *(v4u*)p = pack8(v); }
        }
    }
}

__device__ __forceinline__ float sum16lanes(float s) { s += __shfl_xor(s, 1); s += __shfl_xor(s, 2); s += __shfl_xor(s, 4); s += __shfl_xor(s, 8); return s; }
__device__ __forceinline__ void e2_rows(const bf16* proj, bf16* obuf, const float* ggain, int gw, int NGW, int lane_in) {
    int lane = lane_in; asm volatile("" : "+v"(lane)); asm volatile("" : "+s"(gw));
    float gn[8];
#pragma unroll
    for (int e = 0; e < 8; ++e) gn[e] = ggain[8 * (lane & 15) + e];
    for (int m0 = gw; m0 < MH; m0 += 2 * NGW) {
        v4u la_[2], lb_[2], lg_[2], ra_[2], rb_[2], rg_[2];
#pragma unroll
        for (int rr = 0; rr < 2; ++rr) { const int m = (m0 + rr * NGW) < MH ? (m0 + rr * NGW) : m0; const bf16* prow = proj + (size_t)m * PW; const size_t o = (size_t)m * 512 + 8 * lane;
            la_[rr] = *(const v4u*)(obuf + 1 * OB1 + o); lb_[rr] = *(const v4u*)(obuf + 3 * OB1 + o); lg_[rr] = *(const v4u*)(prow + C_GG + 8 * lane);
            ra_[rr] = *(const v4u*)(obuf + 2 * OB1 + o); rb_[rr] = *(const v4u*)(obuf + 4 * OB1 + o); rg_[rr] = *(const v4u*)(prow + C_RG + 8 * lane); }
#pragma unroll
        for (int rr = 0; rr < 2; ++rr) { const int m = m0 + rr * NGW; if (m >= MH) break;
        const size_t o = (size_t)m * 512 + 8 * lane;
        { float a[8], b[8], g[8]; unpack8(la_[rr], a); unpack8(lb_[rr], b); unpack8(lg_[rr], g);
          float s = 0.f;
#pragma unroll
          for (int e = 0; e < 8; ++e) { a[e] += b[e]; s += a[e] * a[e]; }
          const float rstd = 1.0f / sqrtf(sum16lanes(s) * (1.f / 128.f) + EPS);
#pragma unroll
          for (int e = 0; e < 8; ++e) a[e] = a[e] * rstd * gn[e] * (g[e] * sigmoidf_fast(g[e]));
          *(v4u*)(obuf + 1 * OB1 + o) = pack8(a); }
        { float a[8], b[8], g[8]; unpack8(ra_[rr], a); unpack8(rb_[rr], b); unpack8(rg_[rr], g);
          float s = 0.f;
#pragma unroll
          for (int e = 0; e < 8; ++e) { a[e] += b[e]; s += a[e]; }
          const float mu = sum16lanes(s) * (1.f / 128.f); float q = 0.f;
#pragma unroll
          for (int e = 0; e < 8; ++e) { a[e] -= mu; q += a[e] * a[e]; }
          const float rstd = 1.0f / sqrtf(sum16lanes(q) * (1.f / 128.f) + EPS);
#pragma unroll
          for (int e = 0; e < 8; ++e) a[e] = a[e] * rstd * (g[e] * sigmoidf_fast(g[e]));
          *(v4u*)(obuf + 2 * OB1 + o) = pack8(a); }
        }
    }
}

constexpr int SC_LD = 72;
constexpr int SC_QIN = 0, SC_KIN = 9216, SC_QB = 18432, SC_KDT = 27648, SC_SM = 36864, SC_VT = 46080, SC_TOT = 64512, SC_DEC = 66560, SC_ZS = 66816, SC_END = 70912;
template <bool GLA, bool STATE_ONLY> __device__ __forceinline__ void scan_unit(LAS unsigned char* shm, const bf16* proj, bf16* outb, int row0, int len, int h, int dir,
                                                              const float* wg, const float* bg, float lgam, int c0, int c1, const float* Fprev, const float* Dprev, int nprev, float* Fout, float* Dout) {
    int tid_ = threadIdx.x; asm volatile("" : "+v"(tid_)); const int tid = tid_, lane = tid & 63, wid = __builtin_amdgcn_readfirstlane(tid >> 6), fr = lane & 15, fq = lane >> 4;
    const int cq = (GLA ? C_GQ : C_RQ) + h * 64, ck = (GLA ? C_GK : C_RK) + h * 64, cv = (GLA ? C_GV : C_RV) + h * 128, cz = C_GA + dir * 16;
    LAS bf16* qin = (LAS bf16*)(shm + SC_QIN); LAS bf16* kin = (LAS bf16*)(shm + SC_KIN); LAS bf16* qb = (LAS bf16*)(shm + SC_QB);
    LAS bf16* kdT = (LAS bf16*)(shm + SC_KDT); LAS bf16* sm = (LAS bf16*)(shm + SC_SM); LAS bf16* vT = (LAS bf16*)(shm + SC_VT);
    LAS float* tot = (LAS float*)(shm + SC_TOT); LAS float* dec = (LAS float*)(shm + SC_DEC); LAS float* zs = (LAS float*)(shm + SC_ZS);
    float w[16]; float bias = 0.f;
    if (GLA) {
#pragma unroll
        for (int r = 0; r < 16; ++r) w[r] = wg[r * 256 + h * 64 + lane];
        bias = bg[h * 64 + lane];
    }
    f32x4 S[4];
#pragma unroll
    for (int i = 0; i < 4; ++i) S[i] = (f32x4){0.f, 0.f, 0.f, 0.f};
    if (!STATE_ONLY) {
        for (int s = 0; s < nprev; ++s) {
#pragma unroll
            for (int db = 0; db < 4; ++db)
#pragma unroll
                for (int r = 0; r < 4; ++r) { const int d = db * 16 + 4 * fq + r; S[db][r] = S[db][r] * Dprev[s * 64 + d] + Fprev[(size_t)s * 8192 + d * 128 + 16 * wid + fr]; }
        }
    }
    float sumlog = 0.f;
    unsigned short qr[8], kr[8]; v4u vr0, vr1, zr;
    unsigned short qn[8], kn[8]; v4u vn0, vn1, zn;
    unsigned short qm[8], km[8]; v4u vm0, vm1, zm;
#define SC_ROW(c, i) (dir == 0 ? row0 + (c) * 64 + (i) : row0 + len - 1 - ((c) * 64 + (i)))
#define SC_LOAD(c, Q, K, V0, V1, Z) do { \
        _Pragma("unroll") for (int e = 0; e < 8; ++e) { const bf16* rp = proj + (size_t)SC_ROW(c, 8 * wid + e) * PW; if (!STATE_ONLY) Q[e] = rp[cq + lane]; K[e] = rp[ck + lane]; } \
        { const bf16* rp = proj + (size_t)SC_ROW(c, lane) * PW + cv + 16 * wid; V0 = *(const v4u*)rp; V1 = *(const v4u*)(rp + 8); } \
        if (GLA) { if (tid < 128) Z = *(const v4u*)(proj + (size_t)SC_ROW(c, tid >> 1) * PW + cz + 8 * (tid & 1)); } } while (0)
    zr = (v4u){0u, 0u, 0u, 0u}; zn = zr; zm = zr; vn0 = zr; vn1 = zr; vm0 = zr; vm1 = zr;
#pragma unroll
    for (int e = 0; e < 8; ++e) { qr[e] = 0; qn[e] = 0; qm[e] = 0; kn[e] = 0; km[e] = 0; }
    SC_LOAD(c0, qr, kr, vr0, vr1, zr);
    if (c0 + 1 < c1) SC_LOAD(c0 + 1, qn, kn, vn0, vn1, zn);
    for (int cb = c0; cb < c1; cb += 3) {
      { const int c = cb;
        float la[8];
        if (GLA) {
            if (tid < 128) { float z[8]; unpack8(zr, z); LAS float* zp = zs + (tid >> 1) * 16 + 8 * (tid & 1);
                *(LAS f32x4*)zp = (f32x4){z[0], z[1], z[2], z[3]}; *(LAS f32x4*)(zp + 4) = (f32x4){z[4], z[5], z[6], z[7]}; }
            LDS_BARRIER();
#pragma unroll
            for (int e = 0; e < 8; ++e) { const LAS f32x4* zp = (const LAS f32x4*)(zs + (8 * wid + e) * 16); float a = bias;
#pragma unroll
                for (int r4 = 0; r4 < 4; ++r4) { const f32x4 zz = zp[r4]; a += zz.x * w[4 * r4] + zz.y * w[4 * r4 + 1] + zz.z * w[4 * r4 + 2] + zz.w * w[4 * r4 + 3]; }
                la[e] = (fminf(a, 0.f) - __logf(1.0f + __expf(-fabsf(a)))) * 0.0625f; }
        } else {
#pragma unroll
            for (int e = 0; e < 8; ++e) la[e] = lgam;
        }
        float p[8]; p[0] = la[0];
#pragma unroll
        for (int e = 1; e < 8; ++e) p[e] = p[e - 1] + la[e];
        tot[wid * 64 + lane] = p[7];
        LDS_BARRIER();
        float off = 0.f, bref = 0.f, blast = 0.f;
#pragma unroll
        for (int g = 0; g < 8; ++g) { const float tg = tot[g * 64 + lane]; if (g < wid) off += tg; if (g < 4) bref += tg; blast += tg; }
        {
            const float ebref = __expf(bref), eblr = __expf(blast - bref);
            const bool odd = (lane & 1) != 0; const int prow = odd ? 1 : 0, pcol = lane & ~1;
            float kdv[8];
#pragma unroll
            for (int e = 0; e < 8; e += 2) {
                float xq[2], xk[2], xb[2];
#pragma unroll
                for (int u = 0; u < 2; ++u) { const float bb = off + p[e + u], q = bf1(qr[e + u]), k = bf1(kr[e + u]);
                    const float E = __expf(bb - bref), R = __builtin_amdgcn_rcpf(E);
                    xq[u] = q * E; xk[u] = k * R; xb[u] = q * (E * ebref); kdv[e + u] = k * (R * eblr); }
                if (!STATE_ONLY) {
                    const int o32 = (8 * wid + e + prow) * SC_LD + pcol;
                    { const unsigned w2 = pk2(xq[0], xq[1]), rv = (unsigned)__builtin_amdgcn_mov_dpp((int)w2, 0xB1, 0xF, 0xF, false);
                      *(LAS unsigned*)(qin + o32) = odd ? ((rv >> 16) | (w2 & 0xffff0000u)) : ((w2 & 0xffffu) | (rv << 16)); }
                    { const unsigned w2 = pk2(xk[0], xk[1]), rv = (unsigned)__builtin_amdgcn_mov_dpp((int)w2, 0xB1, 0xF, 0xF, false);
                      *(LAS unsigned*)(kin + o32) = odd ? ((rv >> 16) | (w2 & 0xffff0000u)) : ((w2 & 0xffffu) | (rv << 16)); }
                    { const unsigned w2 = pk2(xb[0], xb[1]), rv = (unsigned)__builtin_amdgcn_mov_dpp((int)w2, 0xB1, 0xF, 0xF, false);
                      *(LAS unsigned*)(qb + o32) = odd ? ((rv >> 16) | (w2 & 0xffff0000u)) : ((w2 & 0xffffu) | (rv << 16)); }
                }
            }
            *(LAS v4u*)(kdT + lane * SC_LD + 8 * wid) = (v4u){pk2(kdv[0], kdv[1]), pk2(kdv[2], kdv[3]), pk2(kdv[4], kdv[5]), pk2(kdv[6], kdv[7])};
            if (wid == 0) dec[lane] = ebref * eblr;
            sumlog += blast;
            const unsigned vw[8] = {vr0.x, vr0.y, vr0.z, vr0.w, vr1.x, vr1.y, vr1.z, vr1.w};
#pragma unroll
            for (int e = 0; e < 8; ++e) { const unsigned w2 = vw[e], rv = (unsigned)__builtin_amdgcn_mov_dpp((int)w2, 0xB1, 0xF, 0xF, false);
                *(LAS unsigned*)(vT + (16 * wid + 2 * e + prow) * SC_LD + pcol) = odd ? ((rv >> 16) | (w2 & 0xffff0000u)) : ((w2 & 0xffffu) | (rv << 16)); }
        }
        LDS_BARRIER();
        if (c + 2 < c1) SC_LOAD(c + 2, qm, km, vm0, vm1, zm);
        if (!STATE_ONLY) {
#pragma unroll
        for (int tt = 0; tt < 2; ++tt) { const int idx = 2 * wid + tt, ti = idx >> 2, tj = idx & 3;
            f32x4 a = (f32x4){0.f, 0.f, 0.f, 0.f};
            if (tj <= ti) {
#pragma unroll
                for (int ks = 0; ks < 2; ++ks) { const bf16x8 A = *(const LAS bf16x8*)(qin + (ti * 16 + fr) * SC_LD + 32 * ks + 8 * fq), B = *(const LAS bf16x8*)(kin + (tj * 16 + fr) * SC_LD + 32 * ks + 8 * fq);
                    a = __builtin_amdgcn_mfma_f32_16x16x32_bf16(B, A, a, 0, 0, 0); } }
            const int i = ti * 16 + fr, j0 = tj * 16 + 4 * fq;
#pragma unroll
            for (int r = 0; r < 4; ++r) a[r] = (j0 + r <= i) ? a[r] : 0.f;
            *(LAS v2u*)(sm + i * SC_LD + j0) = (v2u){pk2(a[0], a[1]), pk2(a[2], a[3])}; }
        LDS_BARRIER();
        }
        {
            bf16x8 bv[2];
#pragma unroll
            for (int ks = 0; ks < 2; ++ks) bv[ks] = *(const LAS bf16x8*)(vT + (16 * wid + fr) * SC_LD + 32 * ks + 8 * fq);
            if (!STATE_ONLY) {
            f32x4 o[4];
#pragma unroll
            for (int ib = 0; ib < 4; ++ib) { o[ib] = (f32x4){0.f, 0.f, 0.f, 0.f};
#pragma unroll
                for (int ks = 0; ks < 2; ++ks) { const bf16x8 A = *(const LAS bf16x8*)(sm + (ib * 16 + fr) * SC_LD + 32 * ks + 8 * fq); o[ib] = __builtin_amdgcn_mfma_f32_16x16x32_bf16(bv[ks], A, o[ib], 0, 0, 0); } }
#pragma unroll
            for (int ks = 0; ks < 2; ++ks) {
                v4u sw; sw.x = pk2(S[2 * ks][0], S[2 * ks][1]); sw.y = pk2(S[2 * ks][2], S[2 * ks][3]); sw.z = pk2(S[2 * ks + 1][0], S[2 * ks + 1][1]); sw.w = pk2(S[2 * ks + 1][2], S[2 * ks + 1][3]);
                const bf16x8 Bs = __builtin_bit_cast(bf16x8, sw);
#pragma unroll
                for (int ib = 0; ib < 4; ++ib) { const v2u lo = *(const LAS v2u*)(qb + (ib * 16 + fr) * SC_LD + 32 * ks + 4 * fq), hi = *(const LAS v2u*)(qb + (ib * 16 + fr) * SC_LD + 32 * ks + 16 + 4 * fq);
                    const bf16x8 A = __builtin_bit_cast(bf16x8, ((v4u){lo.x, lo.y, hi.x, hi.y})); o[ib] = __builtin_amdgcn_mfma_f32_16x16x32_bf16(Bs, A, o[ib], 0, 0, 0); } }
#pragma unroll
            for (int ib = 0; ib < 4; ++ib) { const int i = ib * 16 + fr;
                *(v2u*)(outb + (size_t)SC_ROW(c, i) * 512 + h * 128 + 16 * wid + 4 * fq) = (v2u){pk2(o[ib][0], o[ib][1]), pk2(o[ib][2], o[ib][3])}; }
            }
#pragma unroll
            for (int db = 0; db < 4; ++db) {
#pragma unroll
                for (int r = 0; r < 4; ++r) S[db][r] *= dec[db * 16 + 4 * fq + r];
#pragma unroll
                for (int ks = 0; ks < 2; ++ks) { const bf16x8 A = *(const LAS bf16x8*)(kdT + (db * 16 + fr) * SC_LD + 32 * ks + 8 * fq); S[db] = __builtin_amdgcn_mfma_f32_16x16x32_bf16(A, bv[ks], S[db], 0, 0, 0); } }
        }
      }
      if (cb + 1 < c1) { const int c = cb + 1;
        float la[8];
        if (GLA) {
            if (tid < 128) { float z[8]; unpack8(zn, z); LAS float* zp = zs + (tid >> 1) * 16 + 8 * (tid & 1);
                *(LAS f32x4*)zp = (f32x4){z[0], z[1], z[2], z[3]}; *(LAS f32x4*)(zp + 4) = (f32x4){z[4], z[5], z[6], z[7]}; }
            LDS_BARRIER();
#pragma unroll
            for (int e = 0; e < 8; ++e) { const LAS f32x4* zp = (const LAS f32x4*)(zs + (8 * wid + e) * 16); float a = bias;
#pragma unroll
                for (int r4 = 0; r4 < 4; ++r4) { const f32x4 zz = zp[r4]; a += zz.x * w[4 * r4] + zz.y * w[4 * r4 + 1] + zz.z * w[4 * r4 + 2] + zz.w * w[4 * r4 + 3]; }
                la[e] = (fminf(a, 0.f) - __logf(1.0f + __expf(-fabsf(a)))) * 0.0625f; }
        } else {
#pragma unroll
            for (int e = 0; e < 8; ++e) la[e] = lgam;
        }
        float p[8]; p[0] = la[0];
#pragma unroll
        for (int e = 1; e < 8; ++e) p[e] = p[e - 1] + la[e];
        tot[wid * 64 + lane] = p[7];
        LDS_BARRIER();
        float off = 0.f, bref = 0.f, blast = 0.f;
#pragma unroll
        for (int g = 0; g < 8; ++g) { const float tg = tot[g * 64 + lane]; if (g < wid) off += tg; if (g < 4) bref += tg; blast += tg; }
        {
            const float ebref = __expf(bref), eblr = __expf(blast - bref);
            const bool odd = (lane & 1) != 0; const int prow = odd ? 1 : 0, pcol = lane & ~1;
            float kdv[8];
#pragma unroll
            for (int e = 0; e < 8; e += 2) {
                float xq[2], xk[2], xb[2];
#pragma unroll
                for (int u = 0; u < 2; ++u) { const float bb = off + p[e + u], q = bf1(qn[e + u]), k = bf1(kn[e + u]);
                    const float E = __expf(bb - bref), R = __builtin_amdgcn_rcpf(E);
                    xq[u] = q * E; xk[u] = k * R; xb[u] = q * (E * ebref); kdv[e + u] = k * (R * eblr); }
                if (!STATE_ONLY) {
                    const int o32 = (8 * wid + e + prow) * SC_LD + pcol;
                    { const unsigned w2 = pk2(xq[0], xq[1]), rv = (unsigned)__builtin_amdgcn_mov_dpp((int)w2, 0xB1, 0xF, 0xF, false);
                      *(LAS unsigned*)(qin + o32) = odd ? ((rv >> 16) | (w2 & 0xffff0000u)) : ((w2 & 0xffffu) | (rv << 16)); }
                    { const unsigned w2 = pk2(xk[0], xk[1]), rv = (unsigned)__builtin_amdgcn_mov_dpp((int)w2, 0xB1, 0xF, 0xF, false);
                      *(LAS unsigned*)(kin + o32) = odd ? ((rv >> 16) | (w2 & 0xffff0000u)) : ((w2 & 0xffffu) | (rv << 16)); }
                    { const unsigned w2 = pk2(xb[0], xb[1]), rv = (unsigned)__builtin_amdgcn_mov_dpp((int)w2, 0xB1, 0xF, 0xF, false);
                      *(LAS unsigned*)(qb + o32) = odd ? ((rv >> 16) | (w2 & 0xffff0000u)) : ((w2 & 0xffffu) | (rv << 16)); }
                }
            }
            *(LAS v4u*)(kdT + lane * SC_LD + 8 * wid) = (v4u){pk2(kdv[0], kdv[1]), pk2(kdv[2], kdv[3]), pk2(kdv[4], kdv[5]), pk2(kdv[6], kdv[7])};
            if (wid == 0) dec[lane] = ebref * eblr;
            sumlog += blast;
            const unsigned vw[8] = {vn0.x, vn0.y, vn0.z, vn0.w, vn1.x, vn1.y, vn1.z, vn1.w};
#pragma unroll
            for (int e = 0; e < 8; ++e) { const unsigned w2 = vw[e], rv = (unsigned)__builtin_amdgcn_mov_dpp((int)w2, 0xB1, 0xF, 0xF, false);
                *(LAS unsigned*)(vT + (16 * wid + 2 * e + prow) * SC_LD + pcol) = odd ? ((rv >> 16) | (w2 & 0xffff0000u)) : ((w2 & 0xffffu) | (rv << 16)); }
        }
        LDS_BARRIER();
        if (c + 2 < c1) SC_LOAD(c + 2, qr, kr, vr0, vr1, zr);
        if (!STATE_ONLY) {
#pragma unroll
        for (int tt = 0; tt < 2; ++tt) { const int idx = 2 * wid + tt, ti = idx >> 2, tj = idx & 3;
            f32x4 a = (f32x4){0.f, 0.f, 0.f, 0.f};
            if (tj <= ti) {
#pragma unroll
                for (int ks = 0; ks < 2; ++ks) { const bf16x8 A = *(const LAS bf16x8*)(qin + (ti * 16 + fr) * SC_LD + 32 * ks + 8 * fq), B = *(const LAS bf16x8*)(kin + (tj * 16 + fr) * SC_LD + 32 * ks + 8 * fq);
                    a = __builtin_amdgcn_mfma_f32_16x16x32_bf16(B, A, a, 0, 0, 0); } }
            const int i = ti * 16 + fr, j0 = tj * 16 + 4 * fq;
#pragma unroll
            for (int r = 0; r < 4; ++r) a[r] = (j0 + r <= i) ? a[r] : 0.f;
            *(LAS v2u*)(sm + i * SC_LD + j0) = (v2u){pk2(a[0], a[1]), pk2(a[2], a[3])}; }
        LDS_BARRIER();
        }
        {
            bf16x8 bv[2];
#pragma unroll
            for (int ks = 0; ks < 2; ++ks) bv[ks] = *(const LAS bf16x8*)(vT + (16 * wid + fr) * SC_LD + 32 * ks + 8 * fq);
            if (!STATE_ONLY) {
            f32x4 o[4];
#pragma unroll
            for (int ib = 0; ib < 4; ++ib) { o[ib] = (f32x4){0.f, 0.f, 0.f, 0.f};
#pragma unroll
                for (int ks = 0; ks < 2; ++ks) { const bf16x8 A = *(const LAS bf16x8*)(sm + (ib * 16 + fr) * SC_LD + 32 * ks + 8 * fq); o[ib] = __builtin_amdgcn_mfma_f32_16x16x32_bf16(bv[ks], A, o[ib], 0, 0, 0); } }
#pragma unroll
            for (int ks = 0; ks < 2; ++ks) {
                v4u sw; sw.x = pk2(S[2 * ks][0], S[2 * ks][1]); sw.y = pk2(S[2 * ks][2], S[2 * ks][3]); sw.z = pk2(S[2 * ks + 1][0], S[2 * ks + 1][1]); sw.w = pk2(S[2 * ks + 1][2], S[2 * ks + 1][3]);
                const bf16x8 Bs = __builtin_bit_cast(bf16x8, sw);
#pragma unroll
                for (int ib = 0; ib < 4; ++ib) { const v2u lo = *(const LAS v2u*)(qb + (ib * 16 + fr) * SC_LD + 32 * ks + 4 * fq), hi = *(const LAS v2u*)(qb + (ib * 16 + fr) * SC_LD + 32 * ks + 16 + 4 * fq);
                    const bf16x8 A = __builtin_bit_cast(bf16x8, ((v4u){lo.x, lo.y, hi.x, hi.y})); o[ib] = __builtin_amdgcn_mfma_f32_16x16x32_bf16(Bs, A, o[ib], 0, 0, 0); } }
#pragma unroll
            for (int ib = 0; ib < 4; ++ib) { const int i = ib * 16 + fr;
                *(v2u*)(outb + (size_t)SC_ROW(c, i) * 512 + h * 128 + 16 * wid + 4 * fq) = (v2u){pk2(o[ib][0], o[ib][1]), pk2(o[ib][2], o[ib][3])}; }
            }
#pragma unroll
            for (int db = 0; db < 4; ++db) {
#pragma unroll
                for (int r = 0; r < 4; ++r) S[db][r] *= dec[db * 16 + 4 * fq + r];
#pragma unroll
                for (int ks = 0; ks < 2; ++ks) { const bf16x8 A = *(const LAS bf16x8*)(kdT + (db * 16 + fr) * SC_LD + 32 * ks + 8 * fq); S[db] = __builtin_amdgcn_mfma_f32_16x16x32_bf16(A, bv[ks], S[db], 0, 0, 0); } }
        }
      }
      if (cb + 2 < c1) { const int c = cb + 2;
        float la[8];
        if (GLA) {
            if (tid < 128) { float z[8]; unpack8(zm, z); LAS float* zp = zs + (tid >> 1) * 16 + 8 * (tid & 1);
                *(LAS f32x4*)zp = (f32x4){z[0], z[1], z[2], z[3]}; *(LAS f32x4*)(zp + 4) = (f32x4){z[4], z[5], z[6], z[7]}; }
            LDS_BARRIER();
#pragma unroll
            for (int e = 0; e < 8; ++e) { const LAS f32x4* zp = (const LAS f32x4*)(zs + (8 * wid + e) * 16); float a = bias;
#pragma unroll
                for (int r4 = 0; r4 < 4; ++r4) { const f32x4 zz = zp[r4]; a += zz.x * w[4 * r4] + zz.y * w[4 * r4 + 1] + zz.z * w[4 * r4 + 2] + zz.w * w[4 * r4 + 3]; }
                la[e] = (fminf(a, 0.f) - __logf(1.0f + __expf(-fabsf(a)))) * 0.0625f; }
        } else {
#pragma unroll
            for (int e = 0; e < 8; ++e) la[e] = lgam;
        }
        float p[8]; p[0] = la[0];
#pragma unroll
        for (int e = 1; e < 8; ++e) p[e] = p[e - 1] + la[e];
        tot[wid * 64 + lane] = p[7];
        LDS_BARRIER();
        float off = 0.f, bref = 0.f, blast = 0.f;
#pragma unroll
        for (int g = 0; g < 8; ++g) { const float tg = tot[g * 64 + lane]; if (g < wid) off += tg; if (g < 4) bref += tg; blast += tg; }
        {
            const float ebref = __expf(bref), eblr = __expf(blast - bref);
            const bool odd = (lane & 1) != 0; const int prow = odd ? 1 : 0, pcol = lane & ~1;
            float kdv[8];
#pragma unroll
            for (int e = 0; e < 8; e += 2) {
                float xq[2], xk[2], xb[2];
#pragma unroll
                for (int u = 0; u < 2; ++u) { const float bb = off + p[e + u], q = bf1(qm[e + u]), k = bf1(km[e + u]);
                    const float E = __expf(bb - bref), R = __builtin_amdgcn_rcpf(E);
                    xq[u] = q * E; xk[u] = k * R; xb[u] = q * (E * ebref); kdv[e + u] = k * (R * eblr); }
                if (!STATE_ONLY) {
                    const int o32 = (8 * wid + e + prow) * SC_LD + pcol;
                    { const unsigned w2 = pk2(xq[0], xq[1]), rv = (unsigned)__builtin_amdgcn_mov_dpp((int)w2, 0xB1, 0xF, 0xF, false);
                      *(LAS unsigned*)(qin + o32) = odd ? ((rv >> 16) | (w2 & 0xffff0000u)) : ((w2 & 0xffffu) | (rv << 16)); }
                    { const unsigned w2 = pk2(xk[0], xk[1]), rv = (unsigned)__builtin_amdgcn_mov_dpp((int)w2, 0xB1, 0xF, 0xF, false);
                      *(LAS unsigned*)(kin + o32) = odd ? ((rv >> 16) | (w2 & 0xffff0000u)) : ((w2 & 0xffffu) | (rv << 16)); }
                    { const unsigned w2 = pk2(xb[0], xb[1]), rv = (unsigned)__builtin_amdgcn_mov_dpp((int)w2, 0xB1, 0xF, 0xF, false);
                      *(LAS unsigned*)(qb + o32) = odd ? ((rv >> 16) | (w2 & 0xffff0000u)) : ((w2 & 0xffffu) | (rv << 16)); }
                }
            }
            *(LAS v4u*)(kdT + lane * SC_LD + 8 * wid) = (v4u){pk2(kdv[0], kdv[1]), pk2(kdv[2], kdv[3]), pk2(kdv[4], kdv[5]), pk2(kdv[6], kdv[7])};
            if (wid == 0) dec[lane] = ebref * eblr;
            sumlog += blast;
            const unsigned vw[8] = {vm0.x, vm0.y, vm0.z, vm0.w, vm1.x, vm1.y, vm1.z, vm1.w};
#pragma unroll
            for (int e = 0; e < 8; ++e) { const unsigned w2 = vw[e], rv = (unsigned)__builtin_amdgcn_mov_dpp((int)w2, 0xB1, 0xF, 0xF, false);
                *(LAS unsigned*)(vT + (16 * wid + 2 * e + prow) * SC_LD + pcol) = odd ? ((rv >> 16) | (w2 & 0xffff0000u)) : ((w2 & 0xffffu) | (rv << 16)); }
        }
        LDS_BARRIER();
        if (c + 2 < c1) SC_LOAD(c + 2, qn, kn, vn0, vn1, zn);
        if (!STATE_ONLY) {
#pragma unroll
        for (int tt = 0; tt < 2; ++tt) { const int idx = 2 * wid + tt, ti = idx >> 2, tj = idx & 3;
            f32x4 a = (f32x4){0.f, 0.f, 0.f, 0.f};
            if (tj <= ti) {
#pragma unroll
                for (int ks = 0; ks < 2; ++ks) { const bf16x8 A = *(const LAS bf16x8*)(qin + (ti * 16 + fr) * SC_LD + 32 * ks + 8 * fq), B = *(const LAS bf16x8*)(kin + (tj * 16 + fr) * SC_LD + 32 * ks + 8 * fq);
                    a = __builtin_amdgcn_mfma_f32_16x16x32_bf16(B, A, a, 0, 0, 0); } }
            const int i = ti * 16 + fr, j0 = tj * 16 + 4 * fq;
#pragma unroll
            for (int r = 0; r < 4; ++r) a[r] = (j0 + r <= i) ? a[r] : 0.f;
            *(LAS v2u*)(sm + i * SC_LD + j0) = (v2u){pk2(a[0], a[1]), pk2(a[2], a[3])}; }
        LDS_BARRIER();
        }
        {
            bf16x8 bv[2];
#pragma unroll
            for (int ks = 0; ks < 2; ++ks) bv[ks] = *(const LAS bf16x8*)(vT + (16 * wid + fr) * SC_LD + 32 * ks + 8 * fq);
            if (!STATE_ONLY) {
            f32x4 o[4];
#pragma unroll
            for (int ib = 0; ib < 4; ++ib) { o[ib] = (f32x4){0.f, 0.f, 0.f, 0.f};
#pragma unroll
                for (int ks = 0; ks < 2; ++ks) { const bf16x8 A = *(const LAS bf16x8*)(sm + (ib * 16 + fr) * SC_LD + 32 * ks + 8 * fq); o[ib] = __builtin_amdgcn_mfma_f32_16x16x32_bf16(bv[ks], A, o[ib], 0, 0, 0); } }
#pragma unroll
            for (int ks = 0; ks < 2; ++ks) {
                v4u sw; sw.x = pk2(S[2 * ks][0], S[2 * ks][1]); sw.y = pk2(S[2 * ks][2], S[2 * ks][3]); sw.z = pk2(S[2 * ks + 1][0], S[2 * ks + 1][1]); sw.w = pk2(S[2 * ks + 1][2], S[2 * ks + 1][3]);
                const bf16x8 Bs = __builtin_bit_cast(bf16x8, sw);
#pragma unroll
                for (int ib = 0; ib < 4; ++ib) { const v2u lo = *(const LAS v2u*)(qb + (ib * 16 + fr) * SC_LD + 32 * ks + 4 * fq), hi = *(const LAS v2u*)(qb + (ib * 16 + fr) * SC_LD + 32 * ks + 16 + 4 * fq);
                    const bf16x8 A = __builtin_bit_cast(bf16x8, ((v4u){lo.x, lo.y, hi.x, hi.y})); o[ib] = __builtin_amdgcn_mfma_f32_16x16x32_bf16(Bs, A, o[ib], 0, 0, 0); } }
#pragma unroll
            for (int ib = 0; ib < 4; ++ib) { const int i = ib * 16 + fr;
                *(v2u*)(outb + (size_t)SC_ROW(c, i) * 512 + h * 128 + 16 * wid + 4 * fq) = (v2u){pk2(o[ib][0], o[ib][1]), pk2(o[ib][2], o[ib][3])}; }
            }
#pragma unroll
            for (int db = 0; db < 4; ++db) {
#pragma unroll
                for (int r = 0; r < 4; ++r) S[db][r] *= dec[db * 16 + 4 * fq + r];
#pragma unroll
                for (int ks = 0; ks < 2; ++ks) { const bf16x8 A = *(const LAS bf16x8*)(kdT + (db * 16 + fr) * SC_LD + 32 * ks + 8 * fq); S[db] = __builtin_amdgcn_mfma_f32_16x16x32_bf16(A, bv[ks], S[db], 0, 0, 0); } }
        }
      }
    }
    if (STATE_ONLY) {
#pragma unroll
        for (int db = 0; db < 4; ++db)
#pragma unroll
            for (int r = 0; r < 4; ++r) Fout[(db * 16 + 4 * fq + r) * 128 + 16 * wid + fr] = S[db][r];
        if (wid == 0) Dout[lane] = __expf(sumlog);
    }
    LDS_BARRIER();
#undef SC_ROW
#undef SC_LOAD
}

#define XB_TMO      128
#define XB_XCNT(j)  (256  + 64 * (j))
#define XB_XSUB(j)  (1280 + 64 * (j))
#define XB_XGEN(j)  (2304 + 64 * (j))
#define XB_TOP      3328
#define XB_TOPGEN   3392
#define XCD_BAR_WORDS 3456
#define XB_SPIN_CAP (1u << 18)

__device__ __forceinline__ unsigned xb_ld(unsigned* p)              { return __hip_atomic_load(p, __ATOMIC_RELAXED, __HIP_MEMORY_SCOPE_AGENT); }
__device__ __forceinline__ unsigned xb_add(unsigned* p, unsigned v) { return __hip_atomic_fetch_add(p, v, __ATOMIC_RELAXED, __HIP_MEMORY_SCOPE_AGENT); }
__device__ __forceinline__ unsigned xb_xcc_id() { return (unsigned)__builtin_amdgcn_s_getreg((3 << 11) | 20) & 0xFu; }
#define XB_SPIN(cond, bar) do { unsigned _sp = 0; while (cond) { __builtin_amdgcn_s_sleep(1); \
    if ((++_sp & 255u) == 0u) { if (xb_ld(&(bar)[XB_TMO])) break; if (_sp > XB_SPIN_CAP) { atomicAdd(&(bar)[XB_TMO], 1u); break; } } } } while (0)

struct XcdBarrier {
    unsigned* bar; unsigned x;
    volatile LAS unsigned* st;
};

__device__ __forceinline__ XcdBarrier xcd_barrier_post(unsigned* bar, volatile LAS unsigned* st) {
    XcdBarrier b; b.bar = bar; b.x = xb_xcc_id(); b.st = st;
    if (threadIdx.x == 0) (void)xb_add(&bar[XB_XCNT(b.x)], 1u);
    return b;
}
__device__ __forceinline__ void xcd_barrier_complete(unsigned* bar, unsigned x, unsigned& nloc, unsigned& nx) {
    const unsigned G = gridDim.x * gridDim.y * gridDim.z;
    unsigned sum, cnt, mine, sp = 0u;
    for (;;) {
        sum = 0u; cnt = 0u; mine = 0u;
#pragma unroll
        for (unsigned j = 0; j < 16; ++j) { const unsigned c = xb_ld(&bar[XB_XCNT(j)]); sum += c; cnt += (c > 0u) ? 1u : 0u; mine = (j == x) ? c : mine; }
        if (sum == G) break;
        __builtin_amdgcn_s_sleep(1);
        if ((++sp & 255u) == 0u) { if (xb_ld(&bar[XB_TMO])) break; if (sp > XB_SPIN_CAP) { atomicAdd(&bar[XB_TMO], 1u); break; } }
    }
    nloc = mine > 0u ? mine : 1u; nx = cnt > 0u ? cnt : 1u;
}

__device__ __forceinline__ void xcd_barrier(const XcdBarrier& b) {
    asm volatile("s_waitcnt vmcnt(0)" ::: "memory");
    __syncthreads();
    if (threadIdx.x == 0) {
        unsigned* bar = b.bar;
        __builtin_amdgcn_s_waitcnt(0);
        unsigned nloc = b.st[0], nx = b.st[1];
        if (nloc == 0u) { xcd_barrier_complete(bar, b.x, nloc, nx); b.st[0] = nloc; b.st[1] = nx; }
        const unsigned old = xb_add(&bar[XB_XSUB(b.x)], 1u);
        const unsigned gen = old / nloc;
        if (old + 1u == (gen + 1u) * nloc) {
            __builtin_amdgcn_fence(__ATOMIC_RELEASE, "agent");
            asm volatile("s_waitcnt vmcnt(0)" ::: "memory");
            const unsigned og = xb_add(&bar[XB_TOP], 1u);
            const unsigned tg = og / nx;
            if (og + 1u == (tg + 1u) * nx) xb_add(&bar[XB_TOPGEN], 1u);
            else XB_SPIN(xb_ld(&bar[XB_TOPGEN]) == tg, bar);
            __builtin_amdgcn_fence(__ATOMIC_ACQUIRE, "agent");
            xb_add(&bar[XB_XGEN(b.x)], 1u);
            asm volatile("s_waitcnt vmcnt(0)" ::: "memory");
        } else {
            XB_SPIN(xb_ld(&bar[XB_XGEN(b.x)]) == gen, bar);
            __builtin_amdgcn_fence(__ATOMIC_ACQUIRE, "agent");
            asm volatile("s_waitcnt vmcnt(0)" ::: "memory");
        }
    }
    __syncthreads();
}

struct Args { const float* in[16]; float* out; unsigned char* ws; };
__global__ void __launch_bounds__(NWAVES * 64, 2) hybrid_fwd(Args args) {
    extern __shared__ __attribute__((aligned(16))) unsigned char lds[];
    cg::grid_group grid = cg::this_grid();
    LAS unsigned char* L = (LAS unsigned char*)lds;
    volatile LAS unsigned* MISC = (volatile LAS unsigned*)(L + MISC_OFF);
    const int tid = threadIdx.x, lane = tid & 63, wave = __builtin_amdgcn_readfirstlane(tid >> 6);
    const int G = gridDim.x, bx = blockIdx.x;
    const int vcu = (G % 8 == 0) ? (bx % 8) * (G / 8) + bx / 8 : bx;
    const int gw = vcu * NWAVES + wave, NGW = G * NWAVES;
    unsigned char* ws = args.ws;
    unsigned* ctl = (unsigned*)(ws + WS_CTL);
    bf16* XN = (bf16*)(ws + WS_XN); bf16* PROJ = (bf16*)(ws + WS_PROJ); bf16* MERGED = (bf16*)(ws + WS_MERGED); bf16* OBUF = (bf16*)(ws + WS_OBUF);
    float* ACCF = (float*)(ws + WS_OBUF);
    float* SCF = (float*)(ws + WS_SCF); float* SCD = (float*)(ws + WS_SCD);
    float* out = args.out;
    for (int u = tid; u < (LDS_BYTES - RING_BYTES) / 4; u += NWAVES * 64) ((LAS unsigned*)(L + RING_BYTES))[u] = 0u;
    __syncthreads();
    XcdBarrier bar = xcd_barrier_post(ctl + CW_BAR, MISC + 8);

    {
        LAS float* scr = (LAS float*)(L + wave * 16384);
        for (int l = 0; l < DEPTH; ++l) {
            unsigned char* wl = ws + WS_W + (size_t)l * LW;
            const float* src[8] = {args.in[4] + (size_t)l * DM * INW, args.in[11] + (size_t)l * DM * 3 * DM, args.in[10] + (size_t)(l * 3 + 0) * 512 * DM, args.in[10] + (size_t)(l * 3 + 1) * 512 * DM,
                                   args.in[10] + (size_t)(l * 3 + 2) * 512 * DM, args.in[12] + (size_t)l * DM * DM, args.in[13] + (size_t)l * DM * FF, args.in[14] + (size_t)l * FF * DM};
            const int Ks[8] = {DM, DM, 512, 512, 512, DM, DM, FF}, Ns[8] = {INW, 3 * DM, DM, DM, DM, DM, FF, DM}, roff[8] = {0, 0, 0, DM, 2 * DM, 0, 0, 0};
            const size_t doff[8] = {OW_IN, OW_MERGE, OW_BR, OW_BR, OW_BR, OW_OUT, OW_UP, OW_DOWN};
#pragma unroll
            for (int mi = 0; mi < 8; ++mi) {
                const int nit = (Ks[mi] / 64) * (Ns[mi] / 32);
                for (int it = gw; it < nit; it += NGW) p0_transpose_item(src[mi], Ks[mi], Ns[mi], (bf16*)(wl + doff[mi]), roff[mi], scr, it, lane);
            }
            v4u* z = (v4u*)(wl + OW_IN + (size_t)INW * DM * 2);
            for (int i = gw * 64 + lane; i < (PW - INW) * DM * 2 / 16; i += NGW * 64) z[i] = (v4u){0u, 0u, 0u, 0u};
        }
    }
    grid.sync();

    for (int l = 0; l < DEPTH; ++l) {
        unsigned char* wl = ws + WS_W + (size_t)l * LW;
        const bf16* Win_t = (const bf16*)(wl + OW_IN); const bf16* Wmerge_t = (const bf16*)(wl + OW_MERGE); const bf16* Wbr_t = (const bf16*)(wl + OW_BR);
        const bf16* Wout_t = (const bf16*)(wl + OW_OUT); const bf16* Wup_t = (const bf16*)(wl + OW_UP); const bf16* Wdown_t = (const bf16*)(wl + OW_DOWN);
        for (int hf = 0; hf < 3; ++hf) {
            const bool smp = hf == 2; const int seqmask = smp ? SS - 1 : SP - 1;
            float* op = out + (size_t)hf * MH * DM; float* os = op;
            const float* xp = l == 0 ? (smp ? args.in[1] : args.in[0] + (size_t)hf * MH * DM) : op; const float* xs = xp;
            norm_rows(xp, xs, args.in[2] + l * DM, XN, gw, NGW, lane);
            xcd_barrier(bar);
            { pg8::Gemm g{XN, Win_t, MH, PW, DM, 1 << 30, 0}; pg8::StaticOrder S; S.init(MH, PW, G, bx);
              pg8::EpiBf16<0> E{PROJ, PW, 0, 0};
              pg8::gemm_phase<pg8::EpiBf16<0>, pg8::StaticOrder, true, true>(L, g, S, E); }
            xcd_barrier(bar);
            e1_rows(PROJ, args.in[5] + l * 64, args.in[6] + l * 64, seqmask, gw, NGW, lane);
            xcd_barrier(bar);
            for (int pass = 0; pass < 2; ++pass) {
                unsigned* qctr = ctl + 64 * (1 + (l * 3 + hf) * 2 + pass);
                const int NU = smp ? (pass == 0 ? 480 : 512) : (pass == 0 ? 512 : 384);
                for (;;) {
                    if (tid == 0) MISC[0] = atomicAdd(qctr, 1u);
                    __syncthreads();
                    const int u = (int)MISC[0];
                    __syncthreads();
                    if (u >= NU) break;
                    int kind, key = 0, seg = 0, au = 0;
                    if (smp) {
                        if (pass == 0) { if (u < 256) { kind = 1; au = u; } else { kind = 0; key = (u - 256) / 7; seg = (u - 256) % 7; } }
                        else { if (u < 256) { kind = 1; au = 256 + u; } else { kind = 0; key = (u - 256) >> 3; seg = (u - 256) & 7; } }
                    } else {
                        if (pass == 0) { if (u < 128) { kind = 0; key = u; seg = 0; } else { kind = 1; au = u - 128; } }
                        else { if (u < 256) { kind = 0; key = u >> 1; seg = u & 1; } else { kind = 1; au = 384 + (u - 256); } }
                    }
                    const int len = smp ? SS : SP, nseg = smp ? 8 : 2;
                    const int r = key & 15; int row0 = (key >> 4) * len; const int slot0 = key * nseg;
#ifndef PROBE_SCAN_REPS
#define PROBE_SCAN_REPS 1
#endif
#ifndef PROBE_ATT_REPS
#define PROBE_ATT_REPS 1
#endif
                    if (kind == 0) {
                      for (int rep_ = 0; rep_ < PROBE_SCAN_REPS; ++rep_) {
                        const int mixer = r >> 3, h = (r >> 1) & 3, dir = r & 1;
                        float* Fs = SCF + (size_t)slot0 * 8192; float* Ds = SCD + (size_t)slot0 * 64;
                        const int c0 = seg * 16, c1 = c0 + 16;
                        if (mixer == 0) {
                            const float* wgp = args.in[7] + (size_t)(l * 2 + dir) * 16 * 256; const float* bgp = args.in[8] + (size_t)(l * 2 + dir) * 256; bf16* ob = OBUF + (size_t)(1 + 2 * dir) * OB1;
                            if (pass == 0) scan_unit<true, true>(L, PROJ, ob, row0, len, h, dir, wgp, bgp, 0.f, c0, c1, Fs, Ds, 0, Fs + (size_t)seg * 8192, Ds + seg * 64);
                            else scan_unit<true, false>(L, PROJ, ob, row0, len, h, dir, wgp, bgp, 0.f, c0, c1, Fs, Ds, seg, nullptr, nullptr);
                        } else {
                            const int hh = dir == 0 ? h : 3 - h; const float lg = __logf(1.0f - __builtin_amdgcn_exp2f(-5.0f - (float)hh)); bf16* ob = OBUF + (size_t)(2 + 2 * dir) * OB1;
                            if (pass == 0) scan_unit<false, true>(L, PROJ, ob, row0, len, h, dir, nullptr, nullptr, lg, c0, c1, Fs, Ds, 0, Fs + (size_t)seg * 8192, Ds + seg * 64);
                            else scan_unit<false, false>(L, PROJ, ob, row0, len, h, dir, nullptr, nullptr, lg, c0, c1, Fs, Ds, seg, nullptr, nullptr);
                        }
                      }
                    } else {
                        int nt, hk, qb, hq;
                        if (smp) { const int rr = au & 255; row0 = (au >> 8) * SS; nt = SS / 64; hk = rr >> 7; qb = (rr >> 2) & 31; hq = rr & 3; }
                        else { const int rr = au & 63; row0 = (au >> 6) * SP; nt = SP / 64; hk = rr >> 5; qb = (rr >> 2) & 7; hq = rr & 3; }
                        const int h = hk * 4 + hq;
                        const attn_body::bf16* P = (const attn_body::bf16*)PROJ;
                        for (int rep_ = 0; rep_ < PROBE_ATT_REPS; ++rep_)
                        attn_body::attn_unit<8>(P + (size_t)(row0 + qb * 256) * PW + C_AQ + h * 64, P + (size_t)row0 * PW + C_AK + hk * 64, P + (size_t)row0 * PW + C_AV + hk * 64,
                                                (attn_body::bf16*)OBUF + (size_t)(row0 + qb * 256) * 512 + h * 64, nt, (char*)lds);
                    }
                }
                xcd_barrier(bar);
            }
            e2_rows(PROJ, OBUF, args.in[9] + l * 128, gw, NGW, lane);
            xcd_barrier(bar);
            { pg8::Gemm g{OBUF, Wbr_t, MH, 3 * DM, 512, 4, OB1 * 2}; pg8::StaticOrder S; S.init(MH, 3 * DM, G, bx);
              pg8::EpiBf16<0> E{PROJ, DM, DM, (size_t)MH * DM};
              pg8::gemm_phase<pg8::EpiBf16<0>, pg8::StaticOrder, true, true>(L, g, S, E); }
            xcd_barrier(bar);
            { pg8::Gemm g{XN, Wmerge_t, MH, 3 * DM, DM, 1 << 30, 0}; pg8::MergeOrder S; S.init(MH, G, bx);
              pg8::EpiMerge E{PROJ, (size_t)MH * DM, ACCF, MERGED};
              pg8::gemm_phase<pg8::EpiMerge, pg8::MergeOrder, true, true>(L, g, S, E); }
            xcd_barrier(bar);
            { pg8::Gemm g{MERGED, Wout_t, MH, DM, DM, 1 << 30, 0}; pg8::StaticOrder S; S.init(MH, DM, G, bx);
              pg8::EpiRes E{xp, xs, op, os, DM / 64};
              pg8::gemm_phase<pg8::EpiRes, pg8::StaticOrder, true, true>(L, g, S, E); }
            xcd_barrier(bar);
            norm_rows(op, os, args.in[3] + l * DM, XN, gw, NGW, lane);
            xcd_barrier(bar);
            { pg8::Gemm g{XN, Wup_t, MH, FF, DM, 1 << 30, 0}; pg8::StaticOrder S; S.init(MH, FF, G, bx);
              pg8::EpiBf16<2> E{PROJ, FF, 0, 0};
              pg8::gemm_phase<pg8::EpiBf16<2>, pg8::StaticOrder, true, true>(L, g, S, E); }
            xcd_barrier(bar);
            { pg8::Gemm g{PROJ, Wdown_t, MH, DM, FF, 1 << 30, 0}; pg8::EpiRes E{op, os, op, os, FF / 64};
              pg8::StaticOrder S; S.init(MH, DM, G, bx); pg8::gemm_phase<pg8::EpiRes, pg8::StaticOrder, true, true>(L, g, S, E); }
            xcd_barrier(bar);
        }
    }
    final_norm(out, args.in[15], gw, NGW, lane);
}

extern "C" void kernel_launch(void* const* d_in, const int* in_sizes, int n_in, void* d_out, int out_size, void* d_ws, size_t ws_size, hipStream_t stream) {
    static int grid = 0;
    if (grid == 0) {
        if (n_in != 16 || out_size != MTOT * DM || ws_size < WS_END) { fprintf(stderr, "kernel_launch: unexpected shapes (n_in %d, out %d, ws %zu)\n", n_in, out_size, ws_size); grid = -1; return; }
        int dev = 0, cus = 0, per_cu = 0;
        if (hipGetDevice(&dev) != hipSuccess || hipDeviceGetAttribute(&cus, hipDeviceAttributeMultiprocessorCount, dev) != hipSuccess) { grid = -1; return; }
        if (hipFuncSetAttribute((const void*)hybrid_fwd, hipFuncAttributeMaxDynamicSharedMemorySize, LDS_BYTES) != hipSuccess) { fprintf(stderr, "kernel_launch: hipFuncSetAttribute failed\n"); grid = -1; return; }
        if (hipOccupancyMaxActiveBlocksPerMultiprocessor(&per_cu, (const void*)hybrid_fwd, NWAVES * 64, LDS_BYTES) != hipSuccess || per_cu < 1) { fprintf(stderr, "kernel_launch: occupancy query says %d\n", per_cu); per_cu = 1; }
        (void)hipGetLastError();
        grid = cus;
    }
    if (grid < 0) return;
    if (hipMemsetAsync((char*)d_ws + WS_CTL, 0, CTL_ZERO_BYTES, stream) != hipSuccess) { fprintf(stderr, "kernel_launch: memset failed\n"); return; }
    Args a{};
    for (int i = 0; i < 16; ++i) a.in[i] = (const float*)d_in[i];
    a.out = (float*)d_out; a.ws = (unsigned char*)d_ws;
    void* kargs[] = {&a};
    const hipError_t le = hipLaunchCooperativeKernel((const void*)hybrid_fwd, dim3(grid), dim3(NWAVES * 64), kargs, LDS_BYTES, stream);
    if (le != hipSuccess) fprintf(stderr, "kernel_launch: cooperative launch failed: %s (grid %d)\n", hipGetErrorName(le), grid);
}
```
